# Optimizing an MI355X kernel written in HIP

```python
import jax, jax.numpy as jnp
from jax import lax
import numpy as np

D_MODEL = 2048
BATCH = 16
SEQ = 2048
DEPTH = 4
DEC_BATCH = 32
DEC_SEQ = 64
PAST_LEN = 2048

CHUNK = 64
N_A_LAYERS = DEPTH // 2
N_B_LAYERS = DEPTH - N_A_LAYERS
D_RNN = D_MODEL
RG_BLOCKS = 8
RG_BLOCK_W = D_RNN // RG_BLOCKS
CONV_W = 4
RG_C = 8.0
N_HEADS = 16
HEAD_DIM = D_MODEL // N_HEADS
LEFT_CHUNKS = 8
LEFT = LEFT_CHUNKS * CHUNK
BAND = LEFT + CHUNK
REL_CLIP = 128
D_FF = ((8 * D_MODEL // 3 + 255) // 256) * 256
EPS = 1e-6

kernel_name = "hawk_yoco_chunk_band_stream_step"


def _rms_norm(x, g):
    xf = x.astype(jnp.float32)
    y = xf * lax.rsqrt(jnp.mean(xf * xf, axis=-1, keepdims=True) + EPS)
    return (y * g.astype(jnp.float32)).astype(x.dtype)


def _modulate(x, shift, scale):
    return x * (1 + scale[:, None, :]) + shift[:, None, :]


def _causal_conv(x, prev, w, b):
    if prev is None:
        prev = jnp.zeros((x.shape[0], CONV_W - 1, x.shape[2]), x.dtype)
    xp = jnp.concatenate([prev.astype(x.dtype), x], axis=1)
    S = x.shape[1]
    y = b + xp[:, 0:S] * w[0]
    for k in range(1, CONV_W):
        y = y + xp[:, k:k + S] * w[k]
    return y, xp[:, -(CONV_W - 1):]


def _lru_combine(left, right):
    a1, b1 = left
    a2, b2 = right
    return a1 * a2, a2 * b1 + b2


def _rg_lru(x, h0, w_a, b_a, w_i, b_i, lam, pos0):
    B, S, C = x.shape
    xb = x.reshape(B, S, RG_BLOCKS, RG_BLOCK_W)
    r = jax.nn.sigmoid(jnp.einsum('bsni,nij->bsnj', xb, w_a).reshape(B, S, C) + b_a)
    i = jax.nn.sigmoid(jnp.einsum('bsni,nij->bsnj', xb, w_i).reshape(B, S, C) + b_i)
    log_a = -RG_C * r.astype(jnp.float32) * jax.nn.softplus(-lam.astype(jnp.float32))
    a = jnp.exp(log_a)
    mult = jnp.sqrt(-jnp.expm1(2.0 * log_a))
    pos = pos0 + jnp.arange(S)
    mult = jnp.where((pos == 0)[None, :, None], 1.0, mult)
    u = mult * (i * x).astype(jnp.float32)
    a_cum, h = lax.associative_scan(_lru_combine, (a, u), axis=1)
    if h0 is not None:
        h = h + a_cum * h0.astype(jnp.float32)[:, None, :]
    return h.astype(x.dtype), h[:, -1]


def _recurrent_block(xn, conv_prev, h0, p, a, pos0):
    gate = jax.nn.gelu(xn @ p['rg_w_gate'][a])
    xb = xn @ p['rg_w_in'][a]
    xc, conv_new = _causal_conv(xb, conv_prev, p['rg_conv_w'][a], p['rg_conv_b'][a])
    h, h_last = _rg_lru(xc, h0, p['rg_w_a'][a], p['rg_b_a'][a], p['rg_w_i'][a], p['rg_b_i'][a],
                        p['rg_lambda'][a], pos0)
    return (h * gate) @ p['rg_w_out'][a], conv_new, h_last


def _band_attention(q, k_new, v_new, k_past, v_past, rel_table):
    B, S, H, Dh = q.shape
    n_chunks = -(-S // CHUNK)
    s_pad = n_chunks * CHUNK
    if k_past is not None:
        k_past = k_past[:, -LEFT:]
        v_past = v_past[:, -LEFT:]
    n_past = 0 if k_past is None else k_past.shape[1]

    def assemble(new, past):
        parts = [jnp.zeros((B, LEFT - n_past, H, Dh), new.dtype)]
        if past is not None:
            parts.append(past.astype(new.dtype))
        parts += [new, jnp.zeros((B, s_pad - S, H, Dh), new.dtype)]
        return jnp.concatenate(parts, axis=1)

    k_full = assemble(k_new, k_past)
    v_full = assemble(v_new, v_past)
    rows = jnp.arange(LEFT + s_pad)
    valid = (rows >= LEFT - n_past) & (rows < LEFT + S)
    q_blocks = jnp.pad(q, ((0, 0), (0, s_pad - S), (0, 0), (0, 0)))
    q_blocks = q_blocks.reshape(B, n_chunks, CHUNK, H, Dh).transpose(1, 0, 2, 3, 4)
    qi = jnp.arange(CHUNK)[:, None]
    kj = jnp.arange(BAND)[None, :]
    rel_idx = jnp.clip(LEFT + qi - kj, -REL_CLIP, REL_CLIP) + REL_CLIP
    bias = rel_table[rel_idx].astype(jnp.float32).transpose(2, 0, 1)
    scale = HEAD_DIM ** -0.5

    def one_chunk(args):
        qb, c = args
        start = c * CHUNK
        kb = lax.dynamic_slice_in_dim(k_full, start, BAND, axis=1)
        vb = lax.dynamic_slice_in_dim(v_full, start, BAND, axis=1)
        vmask = lax.dynamic_slice_in_dim(valid, start, BAND, axis=0)
        s = jnp.einsum('bqhd,bkhd->bhqk', qb, kb).astype(jnp.float32) * scale + bias
        s = jnp.where(vmask, s, -1e30)
        pr = jax.nn.softmax(s, axis=-1).astype(vb.dtype)
        return jnp.einsum('bhqk,bkhd->bqhd', pr, vb)

    out = lax.map(one_chunk, (q_blocks, jnp.arange(n_chunks)))
    return out.transpose(1, 0, 2, 3, 4).reshape(B, s_pad, H, Dh)[:, :S]


def _trunk(x, c, pos0, conv_state, rnn_state, k_cache, v_cache, p):
    B, S, _ = x.shape
    cs = jax.nn.silu(c)
    conv_out, rnn_out = [], []
    k_new = None
    v_new = None
    for layer in range(DEPTH):
        mod = cs @ p['ada_w'][layer] + p['ada_b'][layer]
        sh1, sc1, g1, sh2, sc2, g2 = jnp.split(mod, 6, axis=-1)
        if layer == N_A_LAYERS:
            kvn = _rms_norm(x, p['g_kv'])
            k_new = (kvn @ p['w_k']).reshape(B, S, N_HEADS, HEAD_DIM)
            v_new = (kvn @ p['w_v']).reshape(B, S, N_HEADS, HEAD_DIM)
        hn = _modulate(_rms_norm(x, p['g_mix'][layer]), sh1, sc1)
        if layer < N_A_LAYERS:
            cp = None if conv_state is None else conv_state[layer]
            h0 = None if rnn_state is None else rnn_state[layer]
            out, cst, hst = _recurrent_block(hn, cp, h0, p, layer, pos0)
            conv_out.append(cst)
            rnn_out.append(hst)
        else:
            bl = layer - N_A_LAYERS
            q = (hn @ p['w_q'][bl]).reshape(B, S, N_HEADS, HEAD_DIM)
            o = _band_attention(q, k_new, v_new, k_cache, v_cache, p['rel_bias'][bl])
            out = o.reshape(B, S, N_HEADS * HEAD_DIM) @ p['w_o'][bl]
        x = x + g1[:, None, :] * out
        hf = _modulate(_rms_norm(x, p['g_ffn'][layer]), sh2, sc2)
        ff = (jax.nn.silu(hf @ p['ffn_w1'][layer]) * (hf @ p['ffn_w3'][layer])) @ p['ffn_w2'][layer]
        x = x + g2[:, None, :] * ff
    y = _rms_norm(x, p['g_final'])
    return y, jnp.stack(conv_out), jnp.stack(rnn_out), k_new, v_new


def setup_inputs(seed: int = 0) -> dict:
    key = jax.random.key(seed)
    ks = iter(jax.random.split(key, 40))
    f32 = jnp.float32

    def nrm(shape, scale):
        return jax.random.normal(next(ks), shape, f32) * scale

    D = D_MODEL
    HHD = N_HEADS * HEAD_DIM
    l_cache = min(LEFT, PAST_LEN)
    u = jax.random.uniform(next(ks), (N_A_LAYERS, D_RNN), f32, 0.9, 0.999)
    a0 = u ** (1.0 / RG_C)
    rg_lambda = jnp.log(a0) - jnp.log1p(-a0)
    return {
        'x_prompt': nrm((BATCH, SEQ, D), 1.0),
        'x_sample': nrm((DEC_BATCH, DEC_SEQ, D), 1.0),
        'c_prompt': nrm((BATCH, D), 1.0),
        'c_sample': nrm((DEC_BATCH, D), 1.0),
        'state_conv': nrm((N_A_LAYERS, DEC_BATCH, CONV_W - 1, D_RNN), 1.0),
        'state_rnn': nrm((N_A_LAYERS, DEC_BATCH, D_RNN), 0.5),
        'cache_k': nrm((DEC_BATCH, l_cache, N_HEADS, HEAD_DIM), 1.0),
        'cache_v': nrm((DEC_BATCH, l_cache, N_HEADS, HEAD_DIM), 1.0),
        'ada_w': nrm((DEPTH, D, 6 * D), D ** -0.5),
        'ada_b': nrm((DEPTH, 6 * D), 0.02),
        'g_mix': 1.0 + nrm((DEPTH, D), 0.02),
        'g_ffn': 1.0 + nrm((DEPTH, D), 0.02),
        'rg_w_in': nrm((N_A_LAYERS, D, D_RNN), D ** -0.5),
        'rg_w_gate': nrm((N_A_LAYERS, D, D_RNN), D ** -0.5),
        'rg_conv_w': nrm((N_A_LAYERS, CONV_W, D_RNN), CONV_W ** -0.5),
        'rg_conv_b': nrm((N_A_LAYERS, D_RNN), 0.02),
        'rg_w_a': nrm((N_A_LAYERS, RG_BLOCKS, RG_BLOCK_W, RG_BLOCK_W), RG_BLOCK_W ** -0.5),
        'rg_b_a': nrm((N_A_LAYERS, D_RNN), 0.02),
        'rg_w_i': nrm((N_A_LAYERS, RG_BLOCKS, RG_BLOCK_W, RG_BLOCK_W), RG_BLOCK_W ** -0.5),
        'rg_b_i': nrm((N_A_LAYERS, D_RNN), 0.02),
        'rg_lambda': rg_lambda,
        'rg_w_out': nrm((N_A_LAYERS, D_RNN, D), D_RNN ** -0.5),
        'g_kv': 1.0 + nrm((D,), 0.02),
        'w_k': nrm((D, HHD), D ** -0.5),
        'w_v': nrm((D, HHD), D ** -0.5),
        'w_q': nrm((N_B_LAYERS, D, HHD), D ** -0.5),
        'w_o': nrm((N_B_LAYERS, HHD, D), HHD ** -0.5),
        'rel_bias': nrm((N_B_LAYERS, 2 * REL_CLIP + 1, N_HEADS), 0.5),
        'ffn_w1': nrm((DEPTH, D, D_FF), D ** -0.5),
        'ffn_w3': nrm((DEPTH, D, D_FF), D ** -0.5),
        'ffn_w2': nrm((DEPTH, D_FF, D), D_FF ** -0.5),
        'g_final': 1.0 + nrm((D,), 0.02),
    }


def reference(x_prompt, x_sample, c_prompt, c_sample, state_conv, state_rnn, cache_k, cache_v,
              ada_w, ada_b, g_mix, g_ffn, rg_w_in, rg_w_gate, rg_conv_w, rg_conv_b, rg_w_a, rg_b_a,
              rg_w_i, rg_b_i, rg_lambda, rg_w_out, g_kv, w_k, w_v, w_q, w_o, rel_bias,
              ffn_w1, ffn_w3, ffn_w2, g_final):
    p = {
        'ada_w': ada_w, 'ada_b': ada_b, 'g_mix': g_mix, 'g_ffn': g_ffn,
        'rg_w_in': rg_w_in, 'rg_w_gate': rg_w_gate, 'rg_conv_w': rg_conv_w, 'rg_conv_b': rg_conv_b,
        'rg_w_a': rg_w_a, 'rg_b_a': rg_b_a, 'rg_w_i': rg_w_i, 'rg_b_i': rg_b_i,
        'rg_lambda': rg_lambda, 'rg_w_out': rg_w_out, 'g_kv': g_kv, 'w_k': w_k, 'w_v': w_v,
        'w_q': w_q, 'w_o': w_o, 'rel_bias': rel_bias,
        'ffn_w1': ffn_w1, 'ffn_w3': ffn_w3, 'ffn_w2': ffn_w2, 'g_final': g_final,
    }
    y_prompt, conv_prompt, rnn_prompt, k_p, v_p = _trunk(x_prompt, c_prompt, 0, None, None, None, None, p)
    keep = min(LEFT, x_prompt.shape[1])
    k_prompt = k_p[:, -keep:]
    v_prompt = v_p[:, -keep:]
    y_sample, conv_sample, rnn_sample, k_sample, v_sample = _trunk(
        x_sample, c_sample, PAST_LEN, state_conv, state_rnn, cache_k, cache_v, p)
    return (y_prompt, y_sample, conv_prompt, rnn_prompt, k_prompt, v_prompt,
            conv_sample, rnn_sample, k_sample, v_sample)
```

```cpp
#include <hip/hip_runtime.h>
#include <stdint.h>

namespace {
typedef unsigned short bf16_t;
typedef short bf16x8 __attribute__((ext_vector_type(8)));
typedef float f32x4 __attribute__((ext_vector_type(4)));
typedef unsigned u32x2 __attribute__((ext_vector_type(2)));
typedef unsigned u32x4 __attribute__((ext_vector_type(4)));

constexpr int D = 2048, DFF = 5632, NH = 16, HD = 128;
constexpr int PB = 16, PS = 2048, SB = 32, SS = 64;
constexpr int TP = PB * PS;
constexpr int TS = SB * SS;
constexpr int T = TP + TS;
constexpr int NBB = PB + SB;
constexpr int MODW = 6 * D;
constexpr int LEFT = 512, BAND = 576, RELC = 128;
constexpr float EPS = 1e-6f;

constexpr size_t O_Y = 0;
constexpr size_t O_CONVP = (size_t)T * D;
constexpr size_t O_RNNP = O_CONVP + 2 * PB * 3 * D;
constexpr size_t O_KP = O_RNNP + 2 * PB * D;
constexpr size_t O_VP = O_KP + (size_t)PB * LEFT * D;
constexpr size_t O_CONVS = O_VP + (size_t)PB * LEFT * D;
constexpr size_t O_RNNS = O_CONVS + 2 * SB * 3 * D;
constexpr size_t O_KS = O_RNNS + 2 * SB * D;
constexpr size_t O_VS = O_KS + (size_t)SB * SS * D;
constexpr size_t O_END = O_VS + (size_t)SB * SS * D;
static_assert(O_END == 114032640, "output size");

constexpr size_t MiB = 1u << 20;
constexpr size_t WS_CTL = 0;
constexpr size_t WS_MOD = 1 * MiB;
constexpr size_t WS_WGI = 10 * MiB;
constexpr size_t WS_WRGO = 42 * MiB;
constexpr size_t WS_WAI = 58 * MiB;
constexpr size_t WS_WKV = 62 * MiB;
constexpr size_t WS_WQ = 78 * MiB;
constexpr size_t WS_WO = 94 * MiB;
constexpr size_t WS_W13 = 110 * MiB;
constexpr size_t WS_W2 = 286 * MiB;
constexpr size_t WS_HN = 374 * MiB;
constexpr size_t WS_BA = 510 * MiB;
constexpr size_t WS_BB = 646 * MiB;
constexpr size_t WS_BC = 782 * MiB;
constexpr size_t WS_HID = 918 * MiB;
constexpr size_t WS_END = 1292 * MiB;

__device__ __forceinline__ float bf2f(bf16_t b) { return __uint_as_float(((unsigned)b) << 16); }
__device__ __forceinline__ unsigned f2bf(float f) { unsigned u = __float_as_uint(f); return (u + 0x7fffu + ((u >> 16) & 1u)) >> 16; }
__device__ __forceinline__ unsigned pk2(float lo, float hi) { return f2bf(lo) | (f2bf(hi) << 16); }
__device__ __forceinline__ int row_bb(int m) { return m < TP ? (m >> 11) : PB + ((m - TP) >> 6); }
__device__ __forceinline__ float sigmoidf_(float x) { return 1.0f / (1.0f + __expf(-x)); }
__device__ __forceinline__ float gelu_tanh(float x) { const float u = 0.7978845608028654f * (x + 0.044715f * x * x * x); return 0.5f * x * (1.0f + tanhf(u)); }

__global__ __launch_bounds__(256) void k_transpose_cvt(const float* __restrict__ W, int K, int N, bf16_t* __restrict__ dst, int row_off, int row_mul, int ldd) {
    __shared__ float tile[32][33];
    const int n0 = blockIdx.x * 32, k0 = blockIdx.y * 32, tx = threadIdx.x & 31, ty = threadIdx.x >> 5;
    for (int i = ty; i < 32; i += 8) tile[i][tx] = W[(size_t)(k0 + i) * N + n0 + tx];
    __syncthreads();
    for (int i = ty; i < 32; i += 8) dst[(size_t)(row_off + (n0 + i) * row_mul) * ldd + k0 + tx] = (bf16_t)f2bf(tile[tx][i]);
}

__global__ __launch_bounds__(256) void k_mod(const float* __restrict__ c_p, const float* __restrict__ c_s, const float* __restrict__ ada_w, const float* __restrict__ ada_b, float* __restrict__ mod) {
    __shared__ float cs[64][NBB];
    const int l = blockIdx.y, j = blockIdx.x * 256 + threadIdx.x;
    float acc[NBB];
#pragma unroll
    for (int bb = 0; bb < NBB; ++bb) acc[bb] = 0.f;
    for (int k0 = 0; k0 < D; k0 += 64) {
        __syncthreads();
        for (int idx = threadIdx.x; idx < 64 * NBB; idx += 256) { const int kk = idx / NBB, bb = idx % NBB; const float c = bb < PB ? c_p[bb * D + k0 + kk] : c_s[(bb - PB) * D + k0 + kk]; cs[kk][bb] = c / (1.0f + __expf(-c)); }
        __syncthreads();
        for (int kk = 0; kk < 64; ++kk) { const float w = ada_w[((size_t)l * D + k0 + kk) * MODW + j];
#pragma unroll
            for (int bb = 0; bb < NBB; ++bb) acc[bb] += cs[kk][bb] * w; }
    }
    const float bj = ada_b[l * MODW + j];
#pragma unroll
    for (int bb = 0; bb < NBB; ++bb) mod[((size_t)l * NBB + bb) * MODW + j] = acc[bb] + bj;
}

__global__ __launch_bounds__(256) void k_norm(const float* X, const float* __restrict__ g, const float* __restrict__ modl, int shoff, int scoff, bf16_t* __restrict__ out, float* outf, int mode) {
    __shared__ float red[4];
    const int m = blockIdx.x, tid = threadIdx.x, c0 = tid * 8;
    const f32x4 a = *(const f32x4*)(X + (size_t)m * D + c0), b = *(const f32x4*)(X + (size_t)m * D + c0 + 4);
    float ss = a[0] * a[0] + a[1] * a[1] + a[2] * a[2] + a[3] * a[3] + b[0] * b[0] + b[1] * b[1] + b[2] * b[2] + b[3] * b[3];
#pragma unroll
    for (int o = 1; o < 64; o <<= 1) ss += __shfl_xor(ss, o);
    if ((tid & 63) == 0) red[tid >> 6] = ss;
    __syncthreads();
    const float tot = (red[0] + red[1]) + (red[2] + red[3]);
    const float rstd = rsqrtf(tot * (1.0f / D) + EPS);
    float v[8] = {a[0], a[1], a[2], a[3], b[0], b[1], b[2], b[3]};
    const int bb = row_bb(m);
#pragma unroll
    for (int e = 0; e < 8; ++e) { float y = v[e] * rstd * g[c0 + e]; if (mode == 0) y = y * (1.0f + modl[(size_t)bb * MODW + scoff + c0 + e]) + modl[(size_t)bb * MODW + shoff + c0 + e]; v[e] = y; }
    if (mode == 2) { *(f32x4*)(outf + (size_t)m * D + c0) = (f32x4){v[0], v[1], v[2], v[3]}; *(f32x4*)(outf + (size_t)m * D + c0 + 4) = (f32x4){v[4], v[5], v[6], v[7]}; }
    else { u32x4 w; w.x = pk2(v[0], v[1]); w.y = pk2(v[2], v[3]); w.z = pk2(v[4], v[5]); w.w = pk2(v[6], v[7]); *(u32x4*)(out + (size_t)m * D + c0) = w; }
}

template <class Epi>
__global__ __launch_bounds__(256) void k_gemm(const bf16_t* __restrict__ A, int lda, size_t a_zs, const bf16_t* __restrict__ Bt, int ldb, size_t b_zs, int K, Epi epi) {
    const int z = blockIdx.z;
    A += (size_t)z * a_zs; Bt += (size_t)z * b_zs;
    const int lane = threadIdx.x & 63, wid = threadIdx.x >> 6, wr = wid >> 1, wc = wid & 1, fr = lane & 15, fq = lane >> 4;
    const int row0 = blockIdx.y * 128 + wr * 64, col0 = blockIdx.x * 128 + wc * 64;
    f32x4 acc[4][4];
#pragma unroll
    for (int i = 0; i < 4; ++i)
#pragma unroll
        for (int j = 0; j < 4; ++j) acc[i][j] = (f32x4){0.f, 0.f, 0.f, 0.f};
    const bf16_t* ap = A + (size_t)(row0 + fr) * lda + fq * 8;
    const bf16_t* bp = Bt + (size_t)(col0 + fr) * ldb + fq * 8;
    for (int k0 = 0; k0 < K; k0 += 32) {
        bf16x8 a[4], b[4];
#pragma unroll
        for (int i = 0; i < 4; ++i) a[i] = *(const bf16x8*)(ap + (size_t)(16 * i) * lda + k0);
#pragma unroll
        for (int j = 0; j < 4; ++j) b[j] = *(const bf16x8*)(bp + (size_t)(16 * j) * ldb + k0);
#pragma unroll
        for (int i = 0; i < 4; ++i)
#pragma unroll
            for (int j = 0; j < 4; ++j) acc[i][j] = __builtin_amdgcn_mfma_f32_16x16x32_bf16(b[j], a[i], acc[i][j], 0, 0, 0);
    }
#pragma unroll
    for (int i = 0; i < 4; ++i)
#pragma unroll
        for (int j = 0; j < 4; ++j) epi(z, row0 + 16 * i + fr, col0 + 16 * j + 4 * fq, acc[i][j]);
}

__device__ __forceinline__ void store_bf16x4(bf16_t* p, f32x4 v) { u32x2 w; w.x = pk2(v[0], v[1]); w.y = pk2(v[2], v[3]); *(u32x2*)p = w; }

struct EpiGateIn {
    bf16_t* gate; bf16_t* xb; float* convp; float* convs;
    __device__ __forceinline__ void operator()(int, int row, int col, f32x4 v) const {
        if (col < D) { f32x4 g; g[0] = gelu_tanh(v[0]); g[1] = gelu_tanh(v[1]); g[2] = gelu_tanh(v[2]); g[3] = gelu_tanh(v[3]); store_bf16x4(gate + (size_t)row * D + col, g); }
        else { const int c = col - D; store_bf16x4(xb + (size_t)row * D + c, v);
            if (row < TP) { const int b = row >> 11, t = row & (PS - 1); if (t >= PS - 3) *(f32x4*)(convp + ((size_t)b * 3 + (t - (PS - 3))) * D + c) = v; }
            else { const int mm = row - TP, b = mm >> 6, t = mm & (SS - 1); if (t >= SS - 3) *(f32x4*)(convs + ((size_t)b * 3 + (t - (SS - 3))) * D + c) = v; } }
    }
};
struct EpiGates {
    bf16_t* ri;
    __device__ __forceinline__ void operator()(int z, int row, int col, f32x4 v) const { store_bf16x4(ri + (size_t)row * (2 * D) + z * 512 + col, v); }
};
struct EpiResid {
    float* x; const float* gvec;
    __device__ __forceinline__ void operator()(int, int row, int col, f32x4 v) const {
        const int bb = row_bb(row); const f32x4 g = *(const f32x4*)(gvec + (size_t)bb * MODW + col); float* p = x + (size_t)row * D + col; f32x4 o = *(f32x4*)p; o = o + g * v; *(f32x4*)p = o; }
};
struct EpiFfn13 {
    bf16_t* hid;
    __device__ __forceinline__ void operator()(int, int row, int col, f32x4 v) const {
        const float h0 = v[0] * sigmoidf_(v[0]) * v[1], h1 = v[2] * sigmoidf_(v[2]) * v[3]; *(unsigned*)(hid + (size_t)row * DFF + (col >> 1)) = pk2(h0, h1); }
};
struct EpiKV {
    bf16_t* kb; bf16_t* vb; float* out;
    __device__ __forceinline__ void operator()(int, int row, int col, f32x4 v) const {
        const bool isv = col >= D; const int c = isv ? col - D : col;
        store_bf16x4((isv ? vb : kb) + (size_t)row * D + c, v);
        if (row < TP) { const int b = row >> 11, t = row & (PS - 1); if (t >= PS - LEFT) *(f32x4*)(out + (isv ? O_VP : O_KP) + ((size_t)b * LEFT + (t - (PS - LEFT))) * D + c) = v; }
        else { *(f32x4*)(out + (isv ? O_VS : O_KS) + (size_t)(row - TP) * D + c) = v; }
    }
};
struct EpiQ {
    bf16_t* q;
    __device__ __forceinline__ void operator()(int, int row, int col, f32x4 v) const { store_bf16x4(q + (size_t)row * D + col, v); }
};

__global__ __launch_bounds__(256) void k_conv(const bf16_t* __restrict__ xb, const float* __restrict__ cw, const float* __restrict__ cb, const float* __restrict__ sconv  , bf16_t* __restrict__ xc) {
    const int m = blockIdx.x; int b, t; const bool samp = m >= TP; if (!samp) { b = m >> 11; t = m & (PS - 1); } else { b = (m - TP) >> 6; t = (m - TP) & (SS - 1); }
    for (int ch = threadIdx.x; ch < D; ch += 256) {
        float y = cb[ch];
#pragma unroll
        for (int k = 0; k < 4; ++k) { const int tt = t - 3 + k; float xv;
            if (tt >= 0) xv = bf2f(xb[(size_t)(m - 3 + k) * D + ch]); else xv = samp ? sconv[((size_t)b * 3 + (tt + 3)) * D + ch] : 0.f;
            y += cw[k * D + ch] * xv; }
        xc[(size_t)m * D + ch] = (bf16_t)f2bf(y);
    }
}
__global__ __launch_bounds__(256) void k_scan(const bf16_t* __restrict__ xb, const bf16_t* __restrict__ ri, bf16_t* __restrict__ gate_hg, const float* __restrict__ cw, const float* __restrict__ cb,
                                              const float* __restrict__ b_a, const float* __restrict__ b_i, const float* __restrict__ lam, const float* __restrict__ sconv, const float* __restrict__ srnn,
                                              float* __restrict__ rnnp, float* __restrict__ rnns) {
    const int ch = blockIdx.x * 256 + threadIdx.x, bb = blockIdx.y;
    const bool samp = bb >= PB; const int b = samp ? bb - PB : bb; const int S = samp ? SS : PS; const size_t m0 = samp ? (size_t)TP + (size_t)b * SS : (size_t)b * PS;
    const float w0 = cw[ch], w1 = cw[D + ch], w2 = cw[2 * D + ch], w3 = cw[3 * D + ch], bias = cb[ch], ba = b_a[ch], bi = b_i[ch];
    const float l = lam[ch]; const float sp = (l > 0.f) ? log1pf(__expf(-l)) : (-l + log1pf(__expf(l)));
    float x0 = 0.f, x1 = 0.f, x2 = 0.f, h = 0.f;
    if (samp) { x0 = sconv[((size_t)b * 3 + 0) * D + ch]; x1 = sconv[((size_t)b * 3 + 1) * D + ch]; x2 = sconv[((size_t)b * 3 + 2) * D + ch]; h = srnn[(size_t)b * D + ch]; }
    for (int t = 0; t < S; ++t) {
        const size_t m = m0 + t;
        const float x3 = bf2f(xb[m * D + ch]);
        const float xcv = bias + w0 * x0 + w1 * x1 + w2 * x2 + w3 * x3;
        x0 = x1; x1 = x2; x2 = x3;
        const unsigned pr = *(const unsigned*)(ri + m * (2 * D) + 2 * ch);
        const float r = sigmoidf_(bf2f((bf16_t)(pr & 0xffffu)) + ba), ig = sigmoidf_(bf2f((bf16_t)(pr >> 16)) + bi);
        const float log_a = -8.0f * r * sp; const float a = __expf(log_a);
        float mult = sqrtf(-expm1f(2.0f * log_a)); if (!samp && t == 0) mult = 1.0f;
        h = a * h + mult * (ig * xcv);
        const float g = bf2f(gate_hg[m * D + ch]);
        gate_hg[m * D + ch] = (bf16_t)f2bf(h * g);
    }
    (samp ? rnns : rnnp)[(size_t)b * D + ch] = h;
}

__global__ __launch_bounds__(256) void k_attn(bf16_t* __restrict__ qo, const bf16_t* __restrict__ kb, const bf16_t* __restrict__ vb, const float* __restrict__ cache_k, const float* __restrict__ cache_v, const float* __restrict__ relb) {
    __shared__ float qs[4][HD]; __shared__ float ps[4][BAND];
    const int h = blockIdx.x, cu = blockIdx.y, lane = threadIdx.x & 63, wid = threadIdx.x >> 6;
    const bool samp = cu >= PB * 32; int b, c; size_t rowbase;
    if (!samp) { b = cu >> 5; c = cu & 31; rowbase = (size_t)b * PS + (size_t)c * 64; } else { b = cu - PB * 32; c = 0; rowbase = (size_t)TP + (size_t)b * SS; }
    const int jstart = samp ? 0 : (c >= 8 ? 0 : LEFT - c * 64);
    const float scale = 0.08838834764831845f;
    for (int qi = 0; qi < 16; ++qi) {
        const int i = qi * 4 + wid; const size_t m = rowbase + i;
        qs[wid][lane] = bf2f(qo[m * D + h * HD + lane]); qs[wid][lane + 64] = bf2f(qo[m * D + h * HD + lane + 64]);
        __builtin_amdgcn_s_waitcnt(0); __builtin_amdgcn_wave_barrier();
        float s[9]; float mx = -3.0e38f;
#pragma unroll
        for (int jj = 0; jj < 9; ++jj) { const int j = jj * 64 + lane; float dot = 0.f; const bool valid = j >= jstart;
            if (valid) {
                if (samp && j < LEFT) { const float* kp = cache_k + (((size_t)b * LEFT + j) * NH + h) * HD;
                    for (int d = 0; d < HD; d += 4) { const f32x4 kv = *(const f32x4*)(kp + d); dot += qs[wid][d] * kv[0] + qs[wid][d + 1] * kv[1] + qs[wid][d + 2] * kv[2] + qs[wid][d + 3] * kv[3]; } }
                else { const size_t krow = samp ? (size_t)TP + (size_t)b * SS + (j - LEFT) : (size_t)b * PS + (size_t)(c * 64 - LEFT + j); const bf16_t* kp = kb + krow * D + h * HD;
                    for (int d = 0; d < HD; d += 8) { const bf16x8 kv = *(const bf16x8*)(kp + d);
#pragma unroll
                        for (int e = 0; e < 8; ++e) dot += qs[wid][d + e] * bf2f((bf16_t)kv[e]); } }
            }
            int rel = LEFT + i - j; rel = rel < -RELC ? -RELC : (rel > RELC ? RELC : rel);
            const float sv = valid ? dot * scale + relb[(rel + RELC) * NH + h] : -1.0e30f;
            s[jj] = sv; mx = fmaxf(mx, sv); }
#pragma unroll
        for (int o = 1; o < 64; o <<= 1) mx = fmaxf(mx, __shfl_xor(mx, o));
        float sum = 0.f;
#pragma unroll
        for (int jj = 0; jj < 9; ++jj) { const float p = __expf(s[jj] - mx); sum += p; ps[wid][jj * 64 + lane] = p; }
#pragma unroll
        for (int o = 1; o < 64; o <<= 1) sum += __shfl_xor(sum, o);
        __builtin_amdgcn_s_waitcnt(0); __builtin_amdgcn_wave_barrier();
        float o0 = 0.f, o1 = 0.f;
        for (int j = jstart; j < BAND; ++j) { const float p = ps[wid][j]; float v0, v1;
            if (samp && j < LEFT) { const float* vp = cache_v + (((size_t)b * LEFT + j) * NH + h) * HD; v0 = vp[lane]; v1 = vp[lane + 64]; }
            else { const size_t vrow = samp ? (size_t)TP + (size_t)b * SS + (j - LEFT) : (size_t)b * PS + (size_t)(c * 64 - LEFT + j); const bf16_t* vp = vb + vrow * D + h * HD; v0 = bf2f(vp[lane]); v1 = bf2f(vp[lane + 64]); }
            o0 += p * v0; o1 += p * v1; }
        const float inv = 1.0f / sum;
        qo[m * D + h * HD + lane] = (bf16_t)f2bf(o0 * inv); qo[m * D + h * HD + lane + 64] = (bf16_t)f2bf(o1 * inv);
        __builtin_amdgcn_s_waitcnt(0); __builtin_amdgcn_wave_barrier();
    }
}
}

extern "C" void kernel_launch(void* const* d_in, const int* in_sizes, int n_in, void* d_out, int out_size, void* d_ws, size_t ws_size, hipStream_t stream) {
    (void)in_sizes; (void)n_in; (void)out_size; (void)ws_size;
    const float* x_prompt = (const float*)d_in[0]; const float* x_sample = (const float*)d_in[1]; const float* c_prompt = (const float*)d_in[2]; const float* c_sample = (const float*)d_in[3];
    const float* state_conv = (const float*)d_in[4]; const float* state_rnn = (const float*)d_in[5]; const float* cache_k = (const float*)d_in[6]; const float* cache_v = (const float*)d_in[7];
    const float* ada_w = (const float*)d_in[8]; const float* ada_b = (const float*)d_in[9]; const float* g_mix = (const float*)d_in[10]; const float* g_ffn = (const float*)d_in[11];
    const float* rg_w_in = (const float*)d_in[12]; const float* rg_w_gate = (const float*)d_in[13]; const float* rg_conv_w = (const float*)d_in[14]; const float* rg_conv_b = (const float*)d_in[15];
    const float* rg_w_a = (const float*)d_in[16]; const float* rg_b_a = (const float*)d_in[17]; const float* rg_w_i = (const float*)d_in[18]; const float* rg_b_i = (const float*)d_in[19];
    const float* rg_lambda = (const float*)d_in[20]; const float* rg_w_out = (const float*)d_in[21]; const float* g_kv = (const float*)d_in[22]; const float* w_k = (const float*)d_in[23];
    const float* w_v = (const float*)d_in[24]; const float* w_q = (const float*)d_in[25]; const float* w_o = (const float*)d_in[26]; const float* rel_bias = (const float*)d_in[27];
    const float* ffn_w1 = (const float*)d_in[28]; const float* ffn_w3 = (const float*)d_in[29]; const float* ffn_w2 = (const float*)d_in[30]; const float* g_final = (const float*)d_in[31];
    float* out = (float*)d_out; unsigned char* ws = (unsigned char*)d_ws;
    float* X = out + O_Y;
    float* MOD = (float*)(ws + WS_MOD);
    bf16_t* WGI = (bf16_t*)(ws + WS_WGI); bf16_t* WRGO = (bf16_t*)(ws + WS_WRGO); bf16_t* WAI = (bf16_t*)(ws + WS_WAI); bf16_t* WKV = (bf16_t*)(ws + WS_WKV);
    bf16_t* WQ = (bf16_t*)(ws + WS_WQ); bf16_t* WO = (bf16_t*)(ws + WS_WO); bf16_t* W13 = (bf16_t*)(ws + WS_W13); bf16_t* W2 = (bf16_t*)(ws + WS_W2);
    bf16_t* HN = (bf16_t*)(ws + WS_HN); bf16_t* BA = (bf16_t*)(ws + WS_BA); bf16_t* BB = (bf16_t*)(ws + WS_BB); bf16_t* BC = (bf16_t*)(ws + WS_BC); bf16_t* HID = (bf16_t*)(ws + WS_HID);

    (void)hipMemcpyAsync(X, x_prompt, (size_t)TP * D * 4, hipMemcpyDeviceToDevice, stream);
    (void)hipMemcpyAsync(X + (size_t)TP * D, x_sample, (size_t)TS * D * 4, hipMemcpyDeviceToDevice, stream);

    auto tc = [&](const float* W, int K, int N, bf16_t* dst, int row_off, int row_mul, int ldd) { k_transpose_cvt<<<dim3(N / 32, K / 32), 256, 0, stream>>>(W, K, N, dst, row_off, row_mul, ldd); };
    for (int l = 0; l < 2; ++l) {
        tc(rg_w_gate + (size_t)l * D * D, D, D, WGI + (size_t)l * 2 * D * D, 0, 1, D);
        tc(rg_w_in + (size_t)l * D * D, D, D, WGI + (size_t)l * 2 * D * D, D, 1, D);
        tc(rg_w_out + (size_t)l * D * D, D, D, WRGO + (size_t)l * D * D, 0, 1, D);
        for (int n = 0; n < 8; ++n) {
            tc(rg_w_a + ((size_t)l * 8 + n) * 256 * 256, 256, 256, WAI + ((size_t)l * 8 + n) * 512 * 256, 0, 2, 256);
            tc(rg_w_i + ((size_t)l * 8 + n) * 256 * 256, 256, 256, WAI + ((size_t)l * 8 + n) * 512 * 256, 1, 2, 256);
        }
        tc(w_q + (size_t)l * D * D, D, D, WQ + (size_t)l * D * D, 0, 1, D);
        tc(w_o + (size_t)l * D * D, D, D, WO + (size_t)l * D * D, 0, 1, D);
    }
    tc(w_k, D, D, WKV, 0, 1, D);
    tc(w_v, D, D, WKV, D, 1, D);
    for (int l = 0; l < 4; ++l) {
        tc(ffn_w1 + (size_t)l * D * DFF, D, DFF, W13 + (size_t)l * 2 * DFF * D, 0, 2, D);
        tc(ffn_w3 + (size_t)l * D * DFF, D, DFF, W13 + (size_t)l * 2 * DFF * D, 1, 2, D);
        tc(ffn_w2 + (size_t)l * DFF * D, DFF, D, W2 + (size_t)l * D * DFF, 0, 1, DFF);
    }
    k_mod<<<dim3(MODW / 256, 4), 256, 0, stream>>>(c_prompt, c_sample, ada_w, ada_b, MOD);

    for (int l = 0; l < 4; ++l) {
        const float* modl = MOD + (size_t)l * NBB * MODW;
        if (l == 2) {
            bf16_t* KVN = HID;
            k_norm<<<T, 256, 0, stream>>>(X, g_kv, modl, 0, 0, KVN, nullptr, 1);
            k_gemm<EpiKV><<<dim3(2 * D / 128, T / 128, 1), 256, 0, stream>>>(KVN, D, 0, WKV, D, 0, D, EpiKV{BB, BC, out});
        }
        k_norm<<<T, 256, 0, stream>>>(X, g_mix + (size_t)l * D, modl, 0, D, HN, nullptr, 0);
        if (l < 2) {
            k_gemm<EpiGateIn><<<dim3(2 * D / 128, T / 128, 1), 256, 0, stream>>>(HN, D, 0, WGI + (size_t)l * 2 * D * D, D, 0, D,
                EpiGateIn{BA, BB, out + O_CONVP + (size_t)l * PB * 3 * D, out + O_CONVS + (size_t)l * SB * 3 * D});
            k_conv<<<T, 256, 0, stream>>>(BB, rg_conv_w + (size_t)l * 4 * D, rg_conv_b + (size_t)l * D, state_conv + (size_t)l * SB * 3 * D, BC);
            bf16_t* RI = HID;
            k_gemm<EpiGates><<<dim3(512 / 128, T / 128, 8), 256, 0, stream>>>(BC, D, 256, WAI + (size_t)l * 8 * 512 * 256, 256, (size_t)512 * 256, 256, EpiGates{RI});
            k_scan<<<dim3(D / 256, NBB), 256, 0, stream>>>(BB, RI, BA, rg_conv_w + (size_t)l * 4 * D, rg_conv_b + (size_t)l * D, rg_b_a + (size_t)l * D, rg_b_i + (size_t)l * D, rg_lambda + (size_t)l * D,
                state_conv + (size_t)l * SB * 3 * D, state_rnn + (size_t)l * SB * D, out + O_RNNP + (size_t)l * PB * D, out + O_RNNS + (size_t)l * SB * D);
            k_gemm<EpiResid><<<dim3(D / 128, T / 128, 1), 256, 0, stream>>>(BA, D, 0, WRGO + (size_t)l * D * D, D, 0, D, EpiResid{X, modl + 2 * D});
        } else {
            const int bl = l - 2;
            k_gemm<EpiQ><<<dim3(D / 128, T / 128, 1), 256, 0, stream>>>(HN, D, 0, WQ + (size_t)bl * D * D, D, 0, D, EpiQ{BA});
            k_attn<<<dim3(NH, PB * 32 + SB), 256, 0, stream>>>(BA, BB, BC, cache_k, cache_v, rel_bias + (size_t)bl * (2 * RELC + 1) * NH);
            k_gemm<EpiResid><<<dim3(D / 128, T / 128, 1), 256, 0, stream>>>(BA, D, 0, WO + (size_t)bl * D * D, D, 0, D, EpiResid{X, modl + 2 * D});
        }
        k_norm<<<T, 256, 0, stream>>>(X, g_ffn + (size_t)l * D, modl, 3 * D, 4 * D, HN, nullptr, 0);
        k_gemm<EpiFfn13><<<dim3(2 * DFF / 128, T / 128, 1), 256, 0, stream>>>(HN, D, 0, W13 + (size_t)l * 2 * DFF * D, D, 0, D, EpiFfn13{HID});
        k_gemm<EpiResid><<<dim3(D / 128, T / 128, 1), 256, 0, stream>>>(HID, DFF, 0, W2 + (size_t)l * D * DFF, DFF, 0, DFF, EpiResid{X, modl + 5 * D});
    }
    k_norm<<<T, 256, 0, stream>>>(X, g_final, nullptr, 0, 0, nullptr, X, 2);
}
```

```cpp
#include <hip/hip_runtime.h>
#include <cstdio>
#include <cstdint>

typedef unsigned short bf16_t;
typedef short bf16x8 __attribute__((ext_vector_type(8)));
typedef float f32x4 __attribute__((ext_vector_type(4)));
typedef float f32x2 __attribute__((ext_vector_type(2)));
typedef unsigned u32x2 __attribute__((ext_vector_type(2)));
typedef unsigned u32x4 __attribute__((ext_vector_type(4)));
#define LAS __attribute__((address_space(3)))

constexpr int D = 2048, DFF = 5632, NH = 16, HD = 128;
constexpr int PB = 16, PS = 2048, SB = 32, SS = 64;
constexpr int TP = PB * PS;
constexpr int TS = SB * SS;
constexpr int T = TP + TS;
constexpr int NBB = PB + SB;
constexpr int MODW = 6 * D;
constexpr int LEFT = 512, BAND = 576, RELC = 128;
constexpr float EPS = 1e-6f;

constexpr size_t O_Y = 0;
constexpr int XPITCH = 2 * 2048;
constexpr size_t O_CONVP = (size_t)T * D;
constexpr size_t O_RNNP = O_CONVP + 2 * PB * 3 * D;
constexpr size_t O_KP = O_RNNP + 2 * PB * D;
constexpr size_t O_VP = O_KP + (size_t)PB * LEFT * D;
constexpr size_t O_CONVS = O_VP + (size_t)PB * LEFT * D;
constexpr size_t O_RNNS = O_CONVS + 2 * SB * 3 * D;
constexpr size_t O_KS = O_RNNS + 2 * SB * D;
constexpr size_t O_VS = O_KS + (size_t)SB * SS * D;
constexpr size_t O_END = O_VS + (size_t)SB * SS * D;
static_assert(O_END == 114032640, "output size");

constexpr size_t MiB = 1u << 20;
constexpr size_t WS_CTL = 0, CTL_ZERO_BYTES = 1 * MiB;
constexpr size_t WS_MOD = 1 * MiB;
constexpr size_t WS_WGI = 10 * MiB;
constexpr size_t WS_WRGO = 42 * MiB;
constexpr size_t WS_WAI = 58 * MiB;
constexpr size_t WS_WKV = 62 * MiB;
constexpr size_t WS_WQ = 78 * MiB;
constexpr size_t WS_WO = 94 * MiB;
constexpr size_t WS_W13 = 110 * MiB;
constexpr size_t WS_W2 = 286 * MiB;
constexpr size_t WS_HN = 374 * MiB;
constexpr size_t WS_BA = 510 * MiB;
constexpr size_t WS_BB = 646 * MiB;
constexpr size_t WS_BC = 782 * MiB;
constexpr size_t WS_HID = 918 * MiB;
constexpr size_t WS_KS = 1292 * MiB;
constexpr size_t WS_VS = 1364 * MiB;
constexpr size_t WS_SSQ = 1454 * MiB;
constexpr size_t SSQ_BYTES = 9 * (size_t)34816 * 8;
constexpr size_t WS_GM = 1438 * MiB;
constexpr size_t WS_SHW = 1442 * MiB;
constexpr size_t SHW_GI = 0, SHW_Q = 2 * 48 * 4096, SHW_13 = SHW_Q + 2 * 48 * 2048;
constexpr size_t WS_END = 1458 * MiB;
constexpr int CW_BAR = 4096;

__device__ __forceinline__ float bf2f(bf16_t b) { return __uint_as_float(((unsigned)b) << 16); }
__device__ __forceinline__ unsigned f2bf(float f) { unsigned u = __float_as_uint(f); return (u + 0x7fffu + ((u >> 16) & 1u)) >> 16; }
__device__ __forceinline__ unsigned pk2(float lo, float hi) { return f2bf(lo) | (f2bf(hi) << 16); }
__device__ __forceinline__ int row_bb(int m) { return m < TP ? (m >> 11) : PB + ((m - TP) >> 6); }
__device__ __forceinline__ float fast_sigmoid(float x) { return __builtin_amdgcn_rcpf(1.0f + __expf(-x)); }
__device__ __forceinline__ float gelu_tanh_fast(float x) { const float u = 1.5957691216057308f * (x + 0.044715f * x * x * x); return x * __builtin_amdgcn_rcpf(1.0f + __expf(-u)); }
#define LDS_WAIT() asm volatile("s_waitcnt lgkmcnt(0)" ::: "memory")
#define VM_WAIT() asm volatile("s_waitcnt vmcnt(0)" ::: "memory")

namespace pg8 {
#define PG8_LAS __attribute__((address_space(3)))
typedef unsigned short bf16_t;
typedef short bf16x8 __attribute__((ext_vector_type(8)));
typedef float f32x4 __attribute__((ext_vector_type(4)));
typedef unsigned u32x4 __attribute__((ext_vector_type(4)));
constexpr int BM = 256, BK = 64, HALF = 128, HTB = HALF * BK * 2  , STAGE_BYTES = 8 * HTB, NXCD = 8, WGM = 8;

__host__ __device__ __forceinline__ int lds_byte(int r, int c) { const int st = (r >> 4) * 2 + (c >> 5), rr = r & 15, cc = c & 31, ob = rr * 64 + cc * 2; return st * 1024 + (ob ^ (((ob >> 9) & 1) << 5)); }
__host__ __device__ __forceinline__ void stage_rc(int b, int& R, int& C) { const int st = b / 1024, sb = b % 1024, swz = sb ^ (((sb >> 9) & 1) << 5); R = (st >> 1) * 16 + swz / 64; C = (st & 1) * 32 + (swz % 64) / 2; }
__host__ __device__ __forceinline__ int perm32(int rho) { const int n = rho >> 4, i = rho & 15; return 8 * (i >> 2) + 4 * n + (i & 3); }

struct Unit { int pm, pn; };
struct Gemm { const bf16_t* A; const bf16_t* Bt; int M, N, K; };

template <int WG  > struct StaticOrderT {
    int nM, nN, nwg, G, c;
    __host__ __device__ void init(int M, int N, int G_, int c_) { nM = M / BM; nN = N / BM; nwg = nM * nN; G = G_; c = c_; }
    __host__ __device__ bool next(int i, Unit& u) const {
        const long L = (long)i * G + c; if (L >= nwg) return false;
        int wgid = (int)L; { const int q = nwg / NXCD, r = nwg % NXCD, xcd = wgid % NXCD, off = wgid / NXCD; wgid = (xcd < r ? xcd * (q + 1) : r * (q + 1) + (xcd - r) * q) + off; }
        const int nig = WG * nN, gid = wgid / nig, fm = gid * WG, gsz = (nM - fm) < WG ? (nM - fm) : WG;
        u.pm = fm + ((wgid % nig) % gsz); u.pn = (wgid % nig) / gsz; return true;
    }
    __device__ __forceinline__ void a_ready(const Unit&) const {}
    __device__ __forceinline__ void done(const Unit&) const {}
};
typedef StaticOrderT<WGM> StaticOrder;
#ifndef WG_GI
#define WG_GI 4
#endif
#ifndef WG_KV
#define WG_KV 4
#endif
#ifndef WG_Q
#define WG_Q 4
#endif
#ifndef WG_F13
#define WG_F13 4
#endif
#ifndef WG_R
#define WG_R 4
#endif
#ifndef WG_F2
#define WG_F2 4
#endif
typedef StaticOrderT<WG_GI> ORD_GI; typedef StaticOrderT<WG_KV> ORD_KV; typedef StaticOrderT<WG_Q> ORD_Q; typedef StaticOrderT<WG_F13> ORD_F13; typedef StaticOrderT<WG_R> ORD_R; typedef StaticOrderT<WG_F2> ORD_F2;
__device__ __forceinline__ unsigned cvt_pk_bf16(float lo, float hi) { unsigned r; asm volatile("v_cvt_pk_bf16_f32 %0, %1, %2" : "=v"(r) : "v"(lo), "v"(hi)); return r; }
typedef unsigned long long ssq_t;
constexpr float SSQ_SCALE = 65536.0f;
__device__ __forceinline__ ssq_t ssq_fix(float s) { return (ssq_t)(s * SSQ_SCALE + 0.5f); }
__device__ __forceinline__ float rstd_of(ssq_t ssq) { return __builtin_amdgcn_rsqf((float)ssq * (1.0f / (SSQ_SCALE * D)) + EPS); }
__device__ __forceinline__ u32x4 pack8(const f32x4& v0, const f32x4& v1) { u32x4 w; w.x = cvt_pk_bf16(v0[0], v0[1]); w.y = cvt_pk_bf16(v0[2], v0[3]); w.z = cvt_pk_bf16(v1[0], v1[1]); w.w = cvt_pk_bf16(v1[2], v1[3]); return w; }
__device__ __forceinline__ float sq4(const f32x4& o) { return (o[0] * o[0] + o[1] * o[1]) + (o[2] * o[2] + o[3] * o[3]); }

__device__ __forceinline__ void unpack8(const u32x4& w, f32x4& lo, f32x4& hi) {
    lo[0] = __uint_as_float(w.x << 16); lo[1] = __uint_as_float(w.x & 0xffff0000u); lo[2] = __uint_as_float(w.y << 16); lo[3] = __uint_as_float(w.y & 0xffff0000u);
    hi[0] = __uint_as_float(w.z << 16); hi[1] = __uint_as_float(w.z & 0xffff0000u); hi[2] = __uint_as_float(w.w << 16); hi[3] = __uint_as_float(w.w & 0xffff0000u); }
__device__ __forceinline__ void resid_body(const f32x4 (&acc)[2][2][4][2], int row0  , int col0  , int fq,
                                           bf16_t* __restrict__ x, const float* __restrict__ gvec, bf16_t* __restrict__ xg, const float* __restrict__ gm, bf16_t* __restrict__ xkv, const float* __restrict__ gkv, ssq_t* __restrict__ ssq) {
#pragma unroll
    for (int ai = 0; ai < 2; ++ai) { const int bb = row_bb(row0 + ai * HALF);
        f32x4 g[2][2], q[2][2]; u32x4 xw[4][2];
#pragma unroll
        for (int bj = 0; bj < 2; ++bj)
#pragma unroll
            for (int n = 0; n < 2; ++n) { g[bj][n] = *(const f32x4*)(gvec + (size_t)bb * MODW + col0 + bj * HALF + 4 * n); q[bj][n] = xg ? *(const f32x4*)(gm + (size_t)bb * D + col0 + bj * HALF + 4 * n) : (f32x4){0.f, 0.f, 0.f, 0.f}; }
#pragma unroll
        for (int m = 0; m < 4; ++m)
#pragma unroll
            for (int bj = 0; bj < 2; ++bj) xw[m][bj] = *(const u32x4*)(x + (size_t)(row0 + ai * HALF + m * 16) * XPITCH + col0 + bj * HALF);
        asm volatile("s_waitcnt vmcnt(0)" ::: "memory");
#pragma unroll
        for (int m = 0; m < 4; ++m) { const int row = row0 + ai * HALF + m * 16; float s = 0.f;
#pragma unroll
            for (int bj = 0; bj < 2; ++bj) { f32x4 o0, o1; unpack8(xw[m][bj], o0, o1); o0 = o0 + g[bj][0] * acc[ai][bj][m][0]; o1 = o1 + g[bj][1] * acc[ai][bj][m][1];
                const u32x4 pw = pack8(o0, o1); *(u32x4*)(x + (size_t)row * XPITCH + col0 + bj * HALF) = pw;
                unpack8(pw, o0, o1);
                s += sq4(o0) + sq4(o1);
                if (xg) *(u32x4*)(xg + (size_t)row * D + col0 + bj * HALF) = pack8(o0 * q[bj][0], o1 * q[bj][1]);
                if (xkv) *(u32x4*)(xkv + (size_t)row * D + col0 + bj * HALF) = pack8(o0 * *(const f32x4*)(gkv + col0 + bj * HALF), o1 * *(const f32x4*)(gkv + col0 + bj * HALF + 4)); }
            s += __int_as_float(__builtin_amdgcn_ds_swizzle(__float_as_int(s), 0x401f));
            { auto r2 = __builtin_amdgcn_permlane32_swap(__float_as_uint(s), __float_as_uint(s), false, false); s = __uint_as_float(r2[0]) + __uint_as_float(r2[1]); }
            if (fq == 0) __hip_atomic_fetch_add(ssq + row, ssq_fix(s), __ATOMIC_RELAXED, __HIP_MEMORY_SCOPE_AGENT); }
    }
}
struct EpiResidP {
    static constexpr bool PERM = true, AFTER_DRAIN = false;
    bf16_t* x; const float* gvec;
    bf16_t* xg; const float* gm;
    bf16_t* xkv; const float* gkv;
    ssq_t* ssq;
    __device__ __forceinline__ void operator()(const f32x4 (&acc)[2][2][4][2], const Unit& u, int wr, int wc, int fr, int fq) const {
        resid_body(acc, u.pm * BM + wr * 64 + fr, u.pn * BM + wc * 32 + 8 * fq, fq, x, gvec, xg, gm, xkv, gkv, ssq);
    }
};
__device__ __forceinline__ void gatein_body(const f32x4 (&acc)[2][2][4][2], int row0, int n0  , bool isx, bf16_t* __restrict__ gate, bf16_t* __restrict__ xb, float* __restrict__ convp, float* __restrict__ convs,
                                            const ssq_t* __restrict__ ssq, const float* __restrict__ shw) {
    const int col0 = n0 - (isx ? D : 0);
    ssq_t rs[2][4]; f32x4 sh[2][2][2];
#pragma unroll
    for (int ai = 0; ai < 2; ++ai) { const int bb = row_bb(row0 + ai * HALF);
#pragma unroll
        for (int m = 0; m < 4; ++m) rs[ai][m] = ssq[row0 + ai * HALF + m * 16];
#pragma unroll
        for (int bj = 0; bj < 2; ++bj)
#pragma unroll
            for (int n = 0; n < 2; ++n) sh[ai][bj][n] = *(const f32x4*)(shw + (size_t)bb * (2 * D) + n0 + bj * HALF + 4 * n); }
#pragma unroll
    for (int ai = 0; ai < 2; ++ai)
#pragma unroll
        for (int m = 0; m < 4; ++m) { const int row = row0 + ai * HALF + m * 16; const float r = rstd_of(rs[ai][m]);
            float* cdst = nullptr;
            if (isx) { if (row < TP) { const int b = row >> 11, t = row & (PS - 1); if (t >= PS - 3) cdst = convp + ((size_t)b * 3 + (t - (PS - 3))) * D; }
                       else { const int mm = row - TP, b = mm >> 6, t = mm & (SS - 1); if (t >= SS - 3) cdst = convs + ((size_t)b * 3 + (t - (SS - 3))) * D; } }
#pragma unroll
            for (int bj = 0; bj < 2; ++bj) { f32x4 v0 = acc[ai][bj][m][0] * r + sh[ai][bj][0], v1 = acc[ai][bj][m][1] * r + sh[ai][bj][1]; const int c = col0 + bj * HALF;
                if (!isx) {
#pragma unroll
                    for (int e = 0; e < 4; ++e) { v0[e] = gelu_tanh_fast(v0[e]); v1[e] = gelu_tanh_fast(v1[e]); }
                    *(u32x4*)(gate + (size_t)row * D + c) = pack8(v0, v1);
                } else {
                    *(u32x4*)(xb + (size_t)row * D + c) = pack8(v0, v1);
                    if (cdst) { *(f32x4*)(cdst + c) = v0; *(f32x4*)(cdst + c + 4) = v1; }
                } } }
}
struct EpiGateInP {
    static constexpr bool PERM = true, AFTER_DRAIN = false;
    bf16_t* gate; bf16_t* xb; float* convp; float* convs; const ssq_t* ssq; const float* shw;
    __device__ __forceinline__ void operator()(const f32x4 (&acc)[2][2][4][2], const Unit& u, int wr, int wc, int fr, int fq) const {
        gatein_body(acc, u.pm * BM + wr * 64 + fr, u.pn * BM + wc * 32 + 8 * fq, u.pn >= 8, gate, xb, convp, convs, ssq, shw);
    }
};
__device__ __forceinline__ void ffn13_body(const f32x4 (&acc)[2][2][4][2], int row0, int n0, int hcol0, bf16_t* __restrict__ hid, const ssq_t* __restrict__ ssq, const float* __restrict__ shw) {
    ssq_t rs[2][4]; f32x4 sh[2][2][2];
#pragma unroll
    for (int ai = 0; ai < 2; ++ai) { const int bb = row_bb(row0 + ai * HALF);
#pragma unroll
        for (int m = 0; m < 4; ++m) rs[ai][m] = ssq[row0 + ai * HALF + m * 16];
#pragma unroll
        for (int bj = 0; bj < 2; ++bj)
#pragma unroll
            for (int n = 0; n < 2; ++n) sh[ai][bj][n] = *(const f32x4*)(shw + (size_t)bb * (2 * DFF) + n0 + bj * HALF + 4 * n); }
#pragma unroll
    for (int ai = 0; ai < 2; ++ai)
#pragma unroll
        for (int m = 0; m < 4; ++m) { const int row = row0 + ai * HALF + m * 16; const float r = rstd_of(rs[ai][m]);
            const f32x4 a0 = acc[ai][0][m][0] * r + sh[ai][0][0], a1 = acc[ai][0][m][1] * r + sh[ai][0][1], b0 = acc[ai][1][m][0] * r + sh[ai][1][0], b1 = acc[ai][1][m][1] * r + sh[ai][1][1];
            f32x4 h0, h1;
#pragma unroll
            for (int e = 0; e < 4; ++e) { h0[e] = a0[e] * fast_sigmoid(a0[e]) * b0[e]; h1[e] = a1[e] * fast_sigmoid(a1[e]) * b1[e]; }
            *(u32x4*)(hid + (size_t)row * DFF + hcol0) = pack8(h0, h1); }
}
struct EpiFfn13P {
    static constexpr bool PERM = true, AFTER_DRAIN = false;
    bf16_t* hid; const ssq_t* ssq; const float* shw;
    __device__ __forceinline__ void operator()(const f32x4 (&acc)[2][2][4][2], const Unit& u, int wr, int wc, int fr, int fq) const {
        ffn13_body(acc, u.pm * BM + wr * 64 + fr, u.pn * BM + wc * 32 + 8 * fq, u.pn * HALF + wc * 32 + 8 * fq, hid, ssq, shw);
    }
};
__device__ __forceinline__ void kv_body(const f32x4 (&acc)[2][2][4][2], int row0, int col0, bool isv, bf16_t* __restrict__ kvp  , bf16_t* __restrict__ kvs  , float* __restrict__ out, const ssq_t* __restrict__ ssq) {
    ssq_t rs[2][4];
#pragma unroll
    for (int ai = 0; ai < 2; ++ai)
#pragma unroll
        for (int m = 0; m < 4; ++m) rs[ai][m] = ssq[row0 + ai * HALF + m * 16];
#pragma unroll
    for (int ai = 0; ai < 2; ++ai)
#pragma unroll
        for (int m = 0; m < 4; ++m) { const int row = row0 + ai * HALF + m * 16; const float r = rstd_of(rs[ai][m]);
            float* fdst = nullptr; bf16_t* dst;
            if (row < TP) { const int b = row >> 11, t = row & (PS - 1); dst = kvp + (size_t)row * D; if (t >= PS - LEFT) fdst = out + (isv ? O_VP : O_KP) + ((size_t)b * LEFT + (t - (PS - LEFT))) * D; }
            else { const int mm = row - TP, b = mm >> 6, t = mm & (SS - 1); dst = kvs + ((size_t)b * BAND + LEFT + t) * D; fdst = out + (isv ? O_VS : O_KS) + (size_t)mm * D; }
#pragma unroll
            for (int bj = 0; bj < 2; ++bj) { const f32x4 v0 = acc[ai][bj][m][0] * r, v1 = acc[ai][bj][m][1] * r; const int c = col0 + bj * HALF;
                *(u32x4*)(dst + c) = pack8(v0, v1);
                if (fdst) { *(f32x4*)(fdst + c) = v0; *(f32x4*)(fdst + c + 4) = v1; } } }
}
struct EpiKVP {
    static constexpr bool PERM = true, AFTER_DRAIN = false;
    bf16_t* kb; bf16_t* vb; bf16_t* ks; bf16_t* vs; float* out; const ssq_t* ssq;
    __device__ __forceinline__ void operator()(const f32x4 (&acc)[2][2][4][2], const Unit& u, int wr, int wc, int fr, int fq) const {
        const bool isv = u.pn >= 8;
        kv_body(acc, u.pm * BM + wr * 64 + fr, (isv ? u.pn - 8 : u.pn) * BM + wc * 32 + 8 * fq, isv, isv ? vb : kb, isv ? vs : ks, out, ssq);
    }
};
__device__ __forceinline__ void q_body(const f32x4 (&acc)[2][2][4][2], int row0, int col0, bf16_t* __restrict__ q, const ssq_t* __restrict__ ssq, const float* __restrict__ shw) {
    ssq_t rs[2][4]; f32x4 sh[2][2][2];
#pragma unroll
    for (int ai = 0; ai < 2; ++ai) { const int bb = row_bb(row0 + ai * HALF);
#pragma unroll
        for (int m = 0; m < 4; ++m) rs[ai][m] = ssq[row0 + ai * HALF + m * 16];
#pragma unroll
        for (int bj = 0; bj < 2; ++bj)
#pragma unroll
            for (int n = 0; n < 2; ++n) sh[ai][bj][n] = *(const f32x4*)(shw + (size_t)bb * D + col0 + bj * HALF + 4 * n); }
#pragma unroll
    for (int ai = 0; ai < 2; ++ai)
#pragma unroll
        for (int m = 0; m < 4; ++m) { const int row = row0 + ai * HALF + m * 16; const float r = rstd_of(rs[ai][m]);
#pragma unroll
            for (int bj = 0; bj < 2; ++bj) *(u32x4*)(q + (size_t)row * D + col0 + bj * HALF) = pack8(acc[ai][bj][m][0] * r + sh[ai][bj][0], acc[ai][bj][m][1] * r + sh[ai][bj][1]); }
}
struct EpiNull {
    static constexpr bool PERM = true, AFTER_DRAIN = false;
    __device__ __forceinline__ void operator()(const f32x4 (&acc)[2][2][4][2], const Unit& u, int wr, int wc, int fr, int fq) const {
#pragma unroll
        for (int ai = 0; ai < 2; ++ai)
#pragma unroll
            for (int bj = 0; bj < 2; ++bj) asm volatile("" :: "v"(acc[ai][bj][0][0]), "v"(acc[ai][bj][0][1]), "v"(acc[ai][bj][1][0]), "v"(acc[ai][bj][1][1]), "v"(acc[ai][bj][2][0]), "v"(acc[ai][bj][2][1]), "v"(acc[ai][bj][3][0]), "v"(acc[ai][bj][3][1])); }
};
struct EpiQP {
    static constexpr bool PERM = true, AFTER_DRAIN = false;
    bf16_t* q; const ssq_t* ssq; const float* shw;
    __device__ __forceinline__ void operator()(const f32x4 (&acc)[2][2][4][2], const Unit& u, int wr, int wc, int fr, int fq) const {
        q_body(acc, u.pm * BM + wr * 64 + fr, u.pn * BM + wc * 32 + 8 * fq, q, ssq, shw);
    }
};

template <class Epi, class Sched, bool ALIGN_EPI = false, bool SP2 = false, int AUXA = 0, int AUXB = 0  >
__device__ __forceinline__ void gemm_phase(PG8_LAS unsigned char* lds, const Gemm g, const Sched& S, const Epi& E, int tid_in) {
    int tid_ = tid_in; asm volatile("" : "+v"(tid_));
    const int tid = tid_, wid = __builtin_amdgcn_readfirstlane(tid >> 6), lane = tid & 63, wr = wid >> 2, wc = wid & 3, fr = lane & 15, fq = lane >> 4;
    const int K = g.K, nt = K / BK;
    unsigned voffA[2], voffB[2];
#pragma unroll
    for (int i = 0; i < 2; ++i) { int R, C; stage_rc(tid * 16 + i * 8192, R, C); const int Rb = Epi::PERM ? ((R & ~31) + perm32(R & 31)) : R;
        voffA[i] = (unsigned)(R * K + C) * 2u; voffB[i] = (unsigned)(Rb * K + C) * 2u; }
    const size_t kstep = (size_t)(BK * 2);
    const size_t hstep = (size_t)HALF * K * 2;
    const size_t tstep = 2 * hstep;
    const unsigned ldsw = (unsigned)wid * 1024u;
    const int aoff = lds_byte(wr * 64 + fr, fq * 8), boff = lds_byte(wc * 32 + fr, fq * 8);
#define PG8_SA(b, h) (((b) * 2 + (h)) * HTB)
#define PG8_SB(b, h) ((4 + (b) * 2 + (h)) * HTB)
    constexpr int AUX_voffA = AUXA, AUX_voffB = AUXB;
#define PG8_STAGE(bufoff, gbase, voff) do { _Pragma("unroll") for (int _i = 0; _i < 2; ++_i) \
        __builtin_amdgcn_global_load_lds((const unsigned*)((const char*)(gbase) + (voff)[_i]), (PG8_LAS unsigned*)(lds + (bufoff) + ldsw + _i * 8192), 16, 0, AUX_##voff); } while (0)
#define PG8_LDA(dst, b, h) do { _Pragma("unroll") for (int m = 0; m < 4; ++m) _Pragma("unroll") for (int k = 0; k < 2; ++k) dst[m][k] = *(const PG8_LAS bf16x8*)(lds + PG8_SA(b, h) + aoff + m * 2048 + k * 1024); } while (0)
#define PG8_LDB(dst, b, h) do { _Pragma("unroll") for (int n = 0; n < 2; ++n) _Pragma("unroll") for (int k = 0; k < 2; ++k) dst[n][k] = *(const PG8_LAS bf16x8*)(lds + PG8_SB(b, h) + boff + n * 2048 + k * 1024); } while (0)
#define PG8_MMA(ai, bj, At, Bt) do { __builtin_amdgcn_s_setprio(1); _Pragma("unroll") for (int m = 0; m < 4; ++m) _Pragma("unroll") for (int n = 0; n < 2; ++n) _Pragma("unroll") for (int k = 0; k < 2; ++k) \
        acc[ai][bj][m][n] = __builtin_amdgcn_mfma_f32_16x16x32_bf16(Bt[n][k], At[m][k], acc[ai][bj][m][n], 0, 0, 0); __builtin_amdgcn_s_setprio(0); } while (0)
#define PG8_WAIT_V(n) asm volatile("s_waitcnt vmcnt(" #n ")" ::: "memory")
#define PG8_WAIT_L(n) asm volatile("s_waitcnt lgkmcnt(" #n ")" ::: "memory")
#define PG8_BAR __builtin_amdgcn_s_barrier()
#define PG8_SCHED __builtin_amdgcn_sched_barrier(0)
    Unit cur, nxt; int ui = 0;
    if (!S.next(0, cur)) return;
    f32x4 acc[2][2][4][2];
#pragma unroll
    for (int a = 0; a < 2; ++a)
#pragma unroll
        for (int b = 0; b < 2; ++b)
#pragma unroll
            for (int m = 0; m < 4; ++m)
#pragma unroll
                for (int n = 0; n < 2; ++n) acc[a][b][m][n] = (f32x4){0.f, 0.f, 0.f, 0.f};
    bf16x8 At[4][2], B0[2][2], B1[2][2];
    const char* cA = (const char*)g.A + (size_t)cur.pm * tstep; const char* cB = (const char*)g.Bt + (size_t)cur.pn * tstep;
    S.a_ready(cur);
    if constexpr (SP2) {
        PG8_STAGE(PG8_SB(0, 0), cB, voffB); PG8_STAGE(PG8_SB(0, 1), cB + hstep, voffB); PG8_STAGE(PG8_SA(0, 0), cA, voffA); PG8_STAGE(PG8_SA(0, 1), cA + hstep, voffA);
        if (wr == 1) PG8_BAR;
        PG8_WAIT_V(2); PG8_BAR;
        PG8_STAGE(PG8_SB(1, 0), cB + kstep, voffB); PG8_STAGE(PG8_SA(1, 0), cA + kstep, voffA); PG8_STAGE(PG8_SB(1, 1), cB + hstep + kstep, voffB);
        PG8_WAIT_V(6); PG8_BAR;
    } else {
        PG8_STAGE(PG8_SB(0, 0), cB, voffB); PG8_STAGE(PG8_SA(0, 0), cA, voffA); PG8_STAGE(PG8_SB(0, 1), cB + hstep, voffB); PG8_STAGE(PG8_SA(0, 1), cA + hstep, voffA);
        if (wr == 1) PG8_BAR;
        PG8_WAIT_V(4); PG8_BAR;
        PG8_STAGE(PG8_SB(1, 0), cB + kstep, voffB); PG8_STAGE(PG8_SA(1, 0), cA + kstep, voffA); PG8_STAGE(PG8_SB(1, 1), cB + hstep + kstep, voffB);
        PG8_WAIT_V(6); PG8_BAR;
    }
    for (;;) {
        const bool has_next = S.next(ui + 1, nxt);
        const char* nA = has_next ? (const char*)g.A + (size_t)nxt.pm * tstep : cA; const char* nB = has_next ? (const char*)g.Bt + (size_t)nxt.pn * tstep : cB;
        for (int t = 0; t < nt; t += 2) {
            const bool last = (t == nt - 2);
            const char* a1 = cA + (size_t)(t + 1) * kstep;
            const char* a2 = last ? nA : cA + (size_t)(t + 2) * kstep; const char* b2 = last ? nB : cB + (size_t)(t + 2) * kstep;
            const char* a3 = a2 + kstep; const char* b3 = b2 + kstep;
            if (last && has_next) S.a_ready(nxt);
            if constexpr (SP2) {
            PG8_LDB(B0, 0, 0); PG8_LDB(B1, 0, 1); PG8_SCHED; PG8_LDA(At, 0, 0); PG8_STAGE(PG8_SA(1, 1), a1 + hstep, voffA);
            PG8_WAIT_V(8); PG8_WAIT_L(0); PG8_BAR; PG8_MMA(0, 0, At, B0); PG8_MMA(0, 1, At, B1); PG8_BAR; PG8_SCHED;
            PG8_LDA(At, 0, 1); PG8_STAGE(PG8_SB(0, 0), b2, voffB); PG8_STAGE(PG8_SB(0, 1), b2 + hstep, voffB); PG8_STAGE(PG8_SA(0, 0), a2, voffA);
            PG8_WAIT_V(8); PG8_WAIT_L(0); PG8_BAR; PG8_MMA(1, 0, At, B0); PG8_MMA(1, 1, At, B1); PG8_BAR; PG8_SCHED;
            PG8_LDB(B0, 1, 0); PG8_LDB(B1, 1, 1); PG8_SCHED; PG8_LDA(At, 1, 0); PG8_STAGE(PG8_SA(0, 1), a2 + hstep, voffA);
            PG8_WAIT_V(8); PG8_WAIT_L(0); PG8_BAR; PG8_MMA(0, 0, At, B0); PG8_MMA(0, 1, At, B1); PG8_BAR; PG8_SCHED;
            PG8_LDA(At, 1, 1); PG8_STAGE(PG8_SB(1, 0), b3, voffB); PG8_STAGE(PG8_SB(1, 1), b3 + hstep, voffB); PG8_STAGE(PG8_SA(1, 0), a3, voffA);
            PG8_WAIT_V(8); PG8_WAIT_L(0); PG8_BAR; PG8_MMA(1, 0, At, B0); PG8_MMA(1, 1, At, B1); PG8_BAR; PG8_SCHED;
            } else {
            PG8_LDB(B0, 0, 0); PG8_SCHED; PG8_LDA(At, 0, 0); PG8_STAGE(PG8_SA(1, 1), a1 + hstep, voffA);
            PG8_WAIT_L(8); PG8_BAR; PG8_WAIT_L(0); PG8_MMA(0, 0, At, B0); PG8_BAR; PG8_SCHED;
            PG8_LDB(B1, 0, 1); PG8_STAGE(PG8_SB(0, 0), b2, voffB);
            PG8_BAR; PG8_WAIT_L(0); PG8_MMA(0, 1, At, B1); PG8_BAR;
            PG8_LDA(At, 0, 1); PG8_STAGE(PG8_SA(0, 0), a2, voffA);
            PG8_BAR; PG8_WAIT_L(0); PG8_MMA(1, 0, At, B0); PG8_BAR; PG8_SCHED;
            PG8_STAGE(PG8_SB(0, 1), b2 + hstep, voffB);
            PG8_WAIT_V(6); PG8_BAR; PG8_MMA(1, 1, At, B1); PG8_BAR;
            PG8_LDB(B0, 1, 0); PG8_SCHED; PG8_LDA(At, 1, 0); PG8_STAGE(PG8_SA(0, 1), a2 + hstep, voffA);
            PG8_WAIT_L(8); PG8_BAR; PG8_WAIT_L(0); PG8_MMA(0, 0, At, B0); PG8_BAR; PG8_SCHED;
            PG8_LDB(B1, 1, 1); PG8_STAGE(PG8_SB(1, 0), b3, voffB);
            PG8_BAR; PG8_WAIT_L(0); PG8_MMA(0, 1, At, B1); PG8_BAR;
            PG8_LDA(At, 1, 1); PG8_STAGE(PG8_SA(1, 0), a3, voffA);
            PG8_BAR; PG8_WAIT_L(0); PG8_MMA(1, 0, At, B0); PG8_BAR; PG8_SCHED;
            PG8_STAGE(PG8_SB(1, 1), b3 + hstep, voffB);
            PG8_WAIT_V(6); PG8_BAR; PG8_MMA(1, 1, At, B1); PG8_BAR;
            }
        }
        if constexpr (ALIGN_EPI) { if (wr == 0) PG8_BAR; }
        if constexpr (!Epi::AFTER_DRAIN) { E(acc, cur, wr, wc, fr, fq); S.done(cur); }
        if (!has_next) break;
#pragma unroll
        for (int a = 0; a < 2; ++a)
#pragma unroll
            for (int b = 0; b < 2; ++b)
#pragma unroll
                for (int m = 0; m < 4; ++m)
#pragma unroll
                    for (int n = 0; n < 2; ++n) acc[a][b][m][n] = (f32x4){0.f, 0.f, 0.f, 0.f};
        cur = nxt; cA = nA; cB = nB; ++ui;
        if constexpr (ALIGN_EPI) { if (wr == 1) PG8_BAR; }
    }
    PG8_WAIT_V(0);
    if constexpr (!ALIGN_EPI) { if (wr == 0) PG8_BAR; }
    PG8_BAR;
    if constexpr (Epi::AFTER_DRAIN) { E.fused(acc, cur, wr, wc, fr, fq, lds, wid, lane); S.done(cur); }
#undef PG8_SA
#undef PG8_SB
#undef PG8_STAGE
#undef PG8_LDA
#undef PG8_LDB
#undef PG8_MMA
#undef PG8_WAIT_V
#undef PG8_WAIT_L
#undef PG8_BAR
#undef PG8_SCHED
}
}
#undef LAS
#define LAS __attribute__((address_space(3)))
#define XB_TMO      128
#define XB_XCNT(j)  (256  + 64 * (j))
#define XB_XSUB(j)  (1280 + 64 * (j))
#define XB_XGEN(j)  (2304 + 64 * (j))
#define XB_TOP      3328
#define XB_TOPGEN   3392
#define XCD_BAR_WORDS 3456
#define XB_SPIN_CAP (1u << 22)

__device__ __forceinline__ unsigned xb_ld(unsigned* p)              { return __hip_atomic_load(p, __ATOMIC_RELAXED, __HIP_MEMORY_SCOPE_AGENT); }
__device__ __forceinline__ unsigned xb_add(unsigned* p, unsigned v) { return __hip_atomic_fetch_add(p, v, __ATOMIC_RELAXED, __HIP_MEMORY_SCOPE_AGENT); }
__device__ __forceinline__ unsigned xb_xcc_id() { return (unsigned)__builtin_amdgcn_s_getreg((3 << 11) | 20) & 0xFu; }
#define XB_SPIN(cond, bar) do { unsigned _sp = 0; while (cond) { __builtin_amdgcn_s_sleep(1); \
    if ((++_sp & 255u) == 0u) { if (xb_ld(&(bar)[XB_TMO])) break; if (_sp > XB_SPIN_CAP) { atomicAdd(&(bar)[XB_TMO], 1u); break; } } } } while (0)

struct XcdBarrier {
    unsigned* bar; unsigned x;
    volatile LAS unsigned* st;
};

__device__ __forceinline__ XcdBarrier xcd_barrier_post(unsigned* bar, volatile LAS unsigned* st) {
    XcdBarrier b; b.bar = bar; b.x = xb_xcc_id(); b.st = st;
    if (threadIdx.x == 0) (void)xb_add(&bar[XB_XCNT(b.x)], 1u);
    return b;
}
__device__ __forceinline__ void xcd_barrier_complete(unsigned* bar, unsigned x, unsigned& nloc, unsigned& nx) {
    const unsigned G = gridDim.x * gridDim.y * gridDim.z;
    unsigned sum, cnt, mine, sp = 0u;
    for (;;) {
        sum = 0u; cnt = 0u; mine = 0u;
#pragma unroll
        for (unsigned j = 0; j < 16; ++j) { const unsigned c = xb_ld(&bar[XB_XCNT(j)]); sum += c; cnt += (c > 0u) ? 1u : 0u; mine = (j == x) ? c : mine; }
        if (sum == G) break;
        __builtin_amdgcn_s_sleep(1);
        if ((++sp & 255u) == 0u) { if (xb_ld(&bar[XB_TMO])) break; if (sp > XB_SPIN_CAP) { atomicAdd(&bar[XB_TMO], 1u); break; } }
    }
    nloc = mine > 0u ? mine : 1u; nx = cnt > 0u ? cnt : 1u;
}

__device__ __forceinline__ void xcd_barrier(const XcdBarrier& b) {
    asm volatile("s_waitcnt vmcnt(0)" ::: "memory");
    __syncthreads();
    if (threadIdx.x == 0) {
        unsigned* bar = b.bar;
        __builtin_amdgcn_s_waitcnt(0);
        unsigned nloc = b.st[0], nx = b.st[1];
        if (nloc == 0u) { xcd_barrier_complete(bar, b.x, nloc, nx); b.st[0] = nloc; b.st[1] = nx; }
        const unsigned old = xb_add(&bar[XB_XSUB(b.x)], 1u);
        const unsigned gen = old / nloc;
        if (old + 1u == (gen + 1u) * nloc) {
            __builtin_amdgcn_fence(__ATOMIC_RELEASE, "agent");
            asm volatile("s_waitcnt vmcnt(0)" ::: "memory");
            const unsigned og = xb_add(&bar[XB_TOP], 1u);
            const unsigned tg = og / nx;
            if (og + 1u == (tg + 1u) * nx) xb_add(&bar[XB_TOPGEN], 1u);
            else XB_SPIN(xb_ld(&bar[XB_TOPGEN]) == tg, bar);
            __builtin_amdgcn_fence(__ATOMIC_ACQUIRE, "agent");
            xb_add(&bar[XB_XGEN(b.x)], 1u);
            asm volatile("s_waitcnt vmcnt(0)" ::: "memory");
        } else {
            XB_SPIN(xb_ld(&bar[XB_XGEN(b.x)]) == gen, bar);
            __builtin_amdgcn_fence(__ATOMIC_ACQUIRE, "agent");
            asm volatile("s_waitcnt vmcnt(0)" ::: "memory");
        }
    }
    __syncthreads();
}
namespace att {
typedef short s16x4 __attribute__((ext_vector_type(4)));
typedef float f32x16 __attribute__((ext_vector_type(16)));
constexpr int SHM_V = 16384, SHM_K = 16384;
constexpr int OFF_V = 0, OFF_K = 2 * SHM_V, OFF_WS = OFF_K + 2 * SHM_K, OFF_TB = OFF_WS + 8 * 64 * 4;
constexpr float SCALE = 0.088388347648318440f, LOG2E = 1.4426950408889634f, CS = SCALE * LOG2E;
constexpr float THR2 = 8.0f * LOG2E;
#define KSWZ(row, colB) ((row) * 256 + ((colB) ^ (((row) & 7) << 4)))
#define SBAR() __builtin_amdgcn_sched_barrier(0)
__device__ __forceinline__ int crow(int r, int hi) { return (r & 3) + 8 * (r >> 2) + 4 * hi; }
__device__ __forceinline__ unsigned cvtpk(float lo, float hi) { unsigned r; asm volatile("v_cvt_pk_bf16_f32 %0, %1, %2" : "=v"(r) : "v"(lo), "v"(hi)); return r; }
__device__ __forceinline__ void qkt(f32x16& p0, f32x16& p1, const char* Ks, const bf16x8* qr, int r32, int hi) {
  p0 = f32x16{}; p1 = f32x16{};
#pragma unroll
  for (int d0 = 0; d0 < 8; ++d0) { const int cb = (d0 * 16 + hi * 8) * 2;
    const bf16x8 b0 = *reinterpret_cast<const bf16x8*>(Ks + KSWZ(r32, cb));
    const bf16x8 b1 = *reinterpret_cast<const bf16x8*>(Ks + KSWZ(32 + r32, cb));
    p0 = __builtin_amdgcn_mfma_f32_32x32x16_bf16(b0, qr[d0], p0, 0, 0, 0);
    p1 = __builtin_amdgcn_mfma_f32_32x32x16_bf16(b1, qr[d0], p1, 0, 0, 0); }
}
__device__ __forceinline__ int v_st(int k, int c) { const int kk = (k & ~0xC) | ((k & 4) << 1) | ((k & 8) >> 1); return ((kk >> 3) * 4 + (c >> 5)) * 512 + ((kk & 7) * 32 + (c & 31)) * 2; }
__device__ __forceinline__ int v_rd_base(int lane) { return ((lane & 3) << 3) | (((lane >> 2) & 3) << 6) | (((lane >> 4) & 1) << 5) | (((lane >> 5) & 1) << 8); }
constexpr int v_rd_off(int d0, int ks, int half) { return d0 * 512 + ks * 4096 + half * 2048; }
template <int OFF> __device__ __forceinline__ s16x4 tr_read(int vb) { s16x4 r; asm volatile("ds_read_b64_tr_b16 %0, %1 offset:%2" : "=&v"(r) : "v"(vb), "i"(OFF) : "memory"); return r; }
template <int D0> __device__ __forceinline__ void pv_one(f32x16& od, int vb, bf16x8 pa0, bf16x8 pa1, bf16x8 pa2, bf16x8 pa3) {
  const s16x4 l0 = tr_read<v_rd_off(D0, 0, 0)>(vb), h0 = tr_read<v_rd_off(D0, 0, 1)>(vb), l1 = tr_read<v_rd_off(D0, 1, 0)>(vb), h1 = tr_read<v_rd_off(D0, 1, 1)>(vb);
  const s16x4 l2 = tr_read<v_rd_off(D0, 2, 0)>(vb), h2 = tr_read<v_rd_off(D0, 2, 1)>(vb), l3 = tr_read<v_rd_off(D0, 3, 0)>(vb), h3 = tr_read<v_rd_off(D0, 3, 1)>(vb);
  asm volatile("s_waitcnt lgkmcnt(0)" ::: "memory"); SBAR();
#define PK(L, H) (bf16x8){L[0], L[1], L[2], L[3], H[0], H[1], H[2], H[3]}
  od = __builtin_amdgcn_mfma_f32_32x32x16_bf16(pa0, PK(l0, h0), od, 0, 0, 0);
  od = __builtin_amdgcn_mfma_f32_32x32x16_bf16(pa1, PK(l1, h1), od, 0, 0, 0);
  od = __builtin_amdgcn_mfma_f32_32x32x16_bf16(pa2, PK(l2, h2), od, 0, 0, 0);
  od = __builtin_amdgcn_mfma_f32_32x32x16_bf16(pa3, PK(l3, h3), od, 0, 0, 0);
#undef PK
}
__device__ __forceinline__ void band_unit(const bf16_t* __restrict__ Qb, bf16_t* __restrict__ Ob, const bf16_t* __restrict__ Kh, const bf16_t* __restrict__ Vh, const float* __restrict__ relb, int h, int c0, int nw, char* lds, int tid_in) {
  int tid = tid_in; asm volatile("" : "+v"(tid));
  const int wid = __builtin_amdgcn_readfirstlane(tid >> 6), lane = tid & 63, r32 = lane & 31, hi = lane >> 5;
  char* V_lds = lds + OFF_V; char* K_lds = lds + OFF_K;
  float* wsf = (float*)(lds + OFF_WS) + wid * 64; float* li_l = wsf; float* al_l = wsf + 32; float* tb = (float*)(lds + OFF_TB);
  const bool won = wid < nw; const int cw = c0 + (wid >> 1);
  const int t_lo = c0 > 8 ? c0 - 8 : 0, t_hi = c0 + ((nw + 1) >> 1) - 1;
  if (tid < 257) tb[tid] = relb[tid * NH + h] * LOG2E;
  float m_reg = -1e30f, l_reg = 0.f; f32x16 o[4] = {}; bf16x8 qr[8];
  { const bf16_t* Qw = Qb + (size_t)((won ? wid : 0) * 32 + r32) * D + hi * 8;
#pragma unroll
    for (int d0 = 0; d0 < 8; ++d0) qr[d0] = *reinterpret_cast<const bf16x8*>(Qw + d0 * 16); }
  const int sr = tid >> 4, sc = (tid & 15) * 8, vst0 = v_st(sr, sc), vst1 = v_st(32 + sr, sc);
  const int vb0 = (int)(uintptr_t)V_lds + v_rd_base(lane);
  bf16x8 vs0, vs1, ks0, ks1;
#define SLOAD(k0) do { vs0 = *reinterpret_cast<const bf16x8*>(&Vh[(size_t)((k0) + sr) * D + sc]); vs1 = *reinterpret_cast<const bf16x8*>(&Vh[(size_t)((k0) + 32 + sr) * D + sc]); \
    ks0 = *reinterpret_cast<const bf16x8*>(&Kh[(size_t)((k0) + sr) * D + sc]); ks1 = *reinterpret_cast<const bf16x8*>(&Kh[(size_t)((k0) + 32 + sr) * D + sc]); } while (0)
#define SWRITE(b) do { *(bf16x8*)(V_lds + (b) * SHM_V + vst0) = vs0; *(bf16x8*)(V_lds + (b) * SHM_V + vst1) = vs1; const int kc = sc * 2; \
    *(bf16x8*)(K_lds + (b) * SHM_K + KSWZ(sr, kc)) = ks0; *(bf16x8*)(K_lds + (b) * SHM_K + KSWZ(32 + sr, kc)) = ks1; } while (0)
  SLOAD(t_lo * 64); asm volatile("s_waitcnt vmcnt(0)" ::: "memory"); SWRITE(0); __syncthreads();
  for (int t = t_lo; t <= t_hi; ++t) {
    const int buf = (t - t_lo) & 1;
    if (t < t_hi) SLOAD((t + 1) * 64);
    const int dch = cw - t;
    if (won && dch >= 0 && dch <= 8) {
      f32x16 p0, p1;
      qkt(p0, p1, K_lds + buf * SHM_K, qr, r32, hi);
      if (dch >= 3) { const float bc = tb[256];
#pragma unroll
        for (int r = 0; r < 16; ++r) { p0[r] = fmaf(p0[r], CS, bc); p1[r] = fmaf(p1[r], CS, bc); } }
      else { const int base = 64 * dch + 32 * (wid & 1) + r32 - 4 * hi;
#pragma unroll
        for (int r = 0; r < 16; ++r) { const int j0 = (r & 3) + 8 * (r >> 2); int i0 = base - j0, i1 = base - 32 - j0; i0 = (i0 > 128 ? 128 : i0) + 128; i1 = (i1 > 128 ? 128 : i1) + 128;
          p0[r] = fmaf(p0[r], CS, tb[i0]); p1[r] = fmaf(p1[r], CS, tb[i1]); } }
      float pmax = p0[0];
#pragma unroll
      for (int r = 1; r < 16; ++r) pmax = fmaxf(pmax, p0[r]);
#pragma unroll
      for (int r = 0; r < 16; ++r) pmax = fmaxf(pmax, p1[r]);
      { auto rr = __builtin_amdgcn_permlane32_swap(__float_as_uint(pmax), __float_as_uint(pmax), false, false); pmax = fmaxf(__uint_as_float(rr[0]), __uint_as_float(rr[1])); }
      float mn, alpha;
      if (__all(pmax - m_reg <= THR2)) { mn = m_reg; alpha = 1.f; } else { mn = fmaxf(m_reg, pmax); alpha = __builtin_amdgcn_exp2f(m_reg - mn); m_reg = mn; }
      float ps = 0.f;
#pragma unroll
      for (int r = 0; r < 16; ++r) { p0[r] = __builtin_amdgcn_exp2f(p0[r] - mn); p1[r] = __builtin_amdgcn_exp2f(p1[r] - mn); ps += p0[r] + p1[r]; }
      { auto rr = __builtin_amdgcn_permlane32_swap(__float_as_uint(ps), __float_as_uint(ps), false, false); ps = __uint_as_float(rr[0]) + __uint_as_float(rr[1]); }
      l_reg = l_reg * alpha + ps;
      if (__any(alpha < 1.f)) { if (hi == 0) al_l[r32] = alpha; asm volatile("s_waitcnt lgkmcnt(0)" ::: "memory");
#pragma unroll
        for (int d = 0; d < 4; ++d)
#pragma unroll
          for (int r = 0; r < 16; ++r) o[d][r] *= al_l[crow(r, hi)]; }
      bf16x8 pa0, pa1, pa2, pa3;
#define PK4(P, BASE, OUT) do { unsigned a0 = cvtpk(P[BASE + 0], P[BASE + 1]), a1 = cvtpk(P[BASE + 2], P[BASE + 3]); unsigned b0 = cvtpk(P[BASE + 4], P[BASE + 5]), b1 = cvtpk(P[BASE + 6], P[BASE + 7]); \
    auto r0 = __builtin_amdgcn_permlane32_swap(a0, b0, false, false); auto r1 = __builtin_amdgcn_permlane32_swap(a1, b1, false, false); u32x4 w = {r0[0], r1[0], r0[1], r1[1]}; OUT = *reinterpret_cast<bf16x8*>(&w); } while (0)
      PK4(p0, 0, pa0); PK4(p0, 8, pa1); PK4(p1, 0, pa2); PK4(p1, 8, pa3);
#undef PK4
      const int vb = vb0 + buf * SHM_V;
      pv_one<0>(o[0], vb, pa0, pa1, pa2, pa3); pv_one<1>(o[1], vb, pa0, pa1, pa2, pa3); pv_one<2>(o[2], vb, pa0, pa1, pa2, pa3); pv_one<3>(o[3], vb, pa0, pa1, pa2, pa3);
    }
    if (t < t_hi) { asm volatile("s_waitcnt vmcnt(0)" ::: "memory"); SWRITE(buf ^ 1); }
    __syncthreads();
  }
  if (hi == 0) li_l[r32] = l_reg; asm volatile("s_waitcnt lgkmcnt(0)" ::: "memory");
  if (won) {
    char* ost = lds + wid * 8192;
#pragma unroll
    for (int r = 0; r < 16; ++r) { const int orow = crow(r, hi); const float rl = __builtin_amdgcn_rcpf(li_l[orow]);
#pragma unroll
      for (int d0 = 0; d0 < 4; ++d0) *(bf16_t*)(ost + orow * 256 + (d0 * 32 + r32) * 2) = (bf16_t)f2bf(o[d0][r] * rl); }
    asm volatile("s_waitcnt lgkmcnt(0)" ::: "memory");
    bf16_t* Ow = Ob + (size_t)(wid * 32) * D;
#pragma unroll
    for (int k = 0; k < 8; ++k) { const int row = (lane >> 4) + 4 * k, c16 = lane & 15; const u32x4 v = *(const u32x4*)(ost + row * 256 + c16 * 16); *(u32x4*)(Ow + (size_t)row * D + c16 * 8) = v; }
  }
  __syncthreads();
#undef SLOAD
#undef SWRITE
}
#undef KSWZ
#undef SBAR

__device__ __forceinline__ void attn_phase(char* lds, const bf16_t* Q, bf16_t* O, const bf16_t* Kp, const bf16_t* Vp, const bf16_t* Ks, const bf16_t* Vs, const float* relb, int vcu, int G, int tid) {
  for (int bh = vcu; bh < PB * NH; bh += G) { const int b = bh >> 4, h = bh & 15;
    const bf16_t* Kh = Kp + (size_t)b * PS * D + h * HD; const bf16_t* Vh = Vp + (size_t)b * PS * D + h * HD;
    for (int qb = 0; qb < 8; ++qb) band_unit(Q + ((size_t)b * PS + qb * 256) * D + h * HD, O + ((size_t)b * PS + qb * 256) * D + h * HD, Kh, Vh, relb, h, 4 * qb, 8, lds, tid); }
  for (int u = vcu; u < SB * NH; u += G) { const int b = u >> 4, h = u & 15;
    band_unit(Q + ((size_t)TP + (size_t)b * SS) * D + h * HD, O + ((size_t)TP + (size_t)b * SS) * D + h * HD, Ks + (size_t)b * BAND * D + h * HD, Vs + (size_t)b * BAND * D + h * HD, relb, h, 8, 2, lds, tid); }
}
}

namespace rg {
constexpr int XP = 264, GP = 136;
constexpr int OFF_XB = 0, OFF_XC = 35840, OFF_GT = 69632, OFF_CW = 87040;
constexpr float LOG2E = 1.4426950408889634f;
__device__ __forceinline__ float softplus_neg(float l) {
    const float y = __expf(-fabsf(l)); const float lp = y < 0.02f ? y * (1.f - y * (0.5f - y * (0.33333334f - 0.25f * y))) : __logf(1.f + y); return (l > 0.f ? 0.f : -l) + lp; }
__device__ __forceinline__ float neg_expm1(float x) {
    const float s = -x * (1.f + x * (0.5f + x * (0.16666667f + x * (0.041666668f + x * (0.0083333338f + x * 0.0013888889f))))); const float e = 1.f - __expf(x); return x > -0.3f ? s : e; }
__device__ __forceinline__ float neg_expm1_series(float x) { return -x * (1.f + x * (0.5f + x * (0.16666667f + x * (0.041666668f + x * (0.0083333338f + x * 0.0013888889f))))); }
__device__ __forceinline__ float bperm(float v, int addr) { return __int_as_float(__builtin_amdgcn_ds_bpermute(addr, __float_as_int(v))); }
__device__ __forceinline__ bf16x8 cvt8(const float* p) { const f32x4 a = *(const f32x4*)p, b = *(const f32x4*)(p + 4); u32x4 w; w.x = pk2(a[0], a[1]); w.y = pk2(a[2], a[3]); w.z = pk2(b[0], b[1]); w.w = pk2(b[2], b[3]); return *reinterpret_cast<bf16x8*>(&w); }

__device__ __forceinline__ void rg_unit(char* lds, const bf16_t* __restrict__ xb, const bf16_t* __restrict__ gin, bf16_t* __restrict__ hgo, const bf16_t* __restrict__ wai, const float* __restrict__ cw, const float* __restrict__ cb,
                                        const float* __restrict__ b_a, const float* __restrict__ b_i, const float* __restrict__ lam, const float* __restrict__ sconv, const float* __restrict__ h0p, float* __restrict__ rnn_out,
                                        size_t m0, int nchunks, int cbase, int hf, bool pos0, int tid_in) {
    int tid = tid_in; asm volatile("" : "+v"(tid));
    const int wid = __builtin_amdgcn_readfirstlane(tid >> 6), lane = tid & 63, fr = lane & 15, fq = lane >> 4;
    bf16_t* XB = (bf16_t*)(lds + OFF_XB); bf16_t* XC = (bf16_t*)(lds + OFF_XC); bf16_t* GT = (bf16_t*)(lds + OFF_GT); float* CW = (float*)(lds + OFF_CW);
    const int chl = hf * 128 + 16 * wid + fr, ch = cbase + chl, gcol = cbase + hf * 128;
    bf16x8 Bf[2][8];
#pragma unroll
    for (int nt = 0; nt < 2; ++nt)
#pragma unroll
        for (int ks = 0; ks < 8; ++ks) Bf[nt][ks] = *reinterpret_cast<const bf16x8*>(wai + (size_t)(2 * chl + nt) * 256 + 32 * ks + 8 * fq);
    if (tid < 256) {
#pragma unroll
        for (int k = 0; k < 4; ++k) CW[k * 256 + tid] = cw[k * D + cbase + tid];
        CW[4 * 256 + tid] = cb[cbase + tid]; }
    const float ba = b_a[ch], bi = b_i[ch], sp = softplus_neg(lam[ch]), c8l = -8.f * sp * LOG2E, c2 = -16.f * sp;
    float H = h0p ? h0p[ch] : 0.f;
    const bool small_x = __all(c2 > -0.3f);
#pragma unroll
    for (int i = 0; i < 5; ++i) { const int p = tid + 512 * i; if (p < 67 * 32) { const int row = p >> 5, pc = p & 31; bf16x8 v;
        if (row >= 3) v = *reinterpret_cast<const bf16x8*>(xb + (m0 + row - 3) * D + cbase + 8 * pc);
        else if (sconv) v = cvt8(sconv + (size_t)row * D + cbase + 8 * pc); else v = (bf16x8){0, 0, 0, 0, 0, 0, 0, 0};
        *reinterpret_cast<bf16x8*>(XB + row * XP + 8 * pc) = v; } }
#pragma unroll
    for (int i = 0; i < 2; ++i) { const int p = tid + 512 * i, row = p >> 4, pc = p & 15; *reinterpret_cast<bf16x8*>(GT + row * GP + 8 * pc) = *reinterpret_cast<const bf16x8*>(gin + (m0 + row) * D + gcol + 8 * pc); }
    __syncthreads();
    const int a16 = (lane >= 16 ? lane - 16 : lane) << 2, a32 = (lane >= 32 ? lane - 32 : lane) << 2, a48 = (fr + 48) << 2;
    for (int c = 0; c < nchunks; ++c) {
        const size_t mc = m0 + (size_t)c * 64; const bool more = c + 1 < nchunks;
        { const int pc = tid & 31, r4 = (tid >> 5) * 4; f32x2 y[4][4], wk[4][4];
          { const f32x4 b0 = *(const f32x4*)(CW + 4 * 256 + 8 * pc), b1 = *(const f32x4*)(CW + 4 * 256 + 8 * pc + 4);
#pragma unroll
            for (int o = 0; o < 4; ++o) { y[o][0] = (f32x2){b0[0], b0[1]}; y[o][1] = (f32x2){b0[2], b0[3]}; y[o][2] = (f32x2){b1[0], b1[1]}; y[o][3] = (f32x2){b1[2], b1[3]}; } }
#pragma unroll
          for (int k = 0; k < 4; ++k) { const f32x4 w0 = *(const f32x4*)(CW + k * 256 + 8 * pc), w1 = *(const f32x4*)(CW + k * 256 + 8 * pc + 4);
              wk[k][0] = (f32x2){w0[0], w0[1]}; wk[k][1] = (f32x2){w0[2], w0[3]}; wk[k][2] = (f32x2){w1[0], w1[1]}; wk[k][3] = (f32x2){w1[2], w1[3]}; }
#pragma unroll
          for (int j = 0; j < 7; ++j) { const u32x4 xr = *reinterpret_cast<const u32x4*>(XB + (r4 + j) * XP + 8 * pc); f32x2 xv[4];
              xv[0] = (f32x2){__uint_as_float(xr.x << 16), __uint_as_float(xr.x & 0xffff0000u)}; xv[1] = (f32x2){__uint_as_float(xr.y << 16), __uint_as_float(xr.y & 0xffff0000u)};
              xv[2] = (f32x2){__uint_as_float(xr.z << 16), __uint_as_float(xr.z & 0xffff0000u)}; xv[3] = (f32x2){__uint_as_float(xr.w << 16), __uint_as_float(xr.w & 0xffff0000u)};
#pragma unroll
              for (int o = 0; o < 4; ++o) { const int k = j - o; if (k >= 0 && k < 4) {
#pragma unroll
                  for (int p = 0; p < 4; ++p) y[o][p] = wk[k][p] * xv[p] + y[o][p]; } } }
#pragma unroll
          for (int o = 0; o < 4; ++o) { u32x4 w; w.x = pk2(y[o][0][0], y[o][0][1]); w.y = pk2(y[o][1][0], y[o][1][1]); w.z = pk2(y[o][2][0], y[o][2][1]); w.w = pk2(y[o][3][0], y[o][3][1]); *(u32x4*)(XC + (r4 + o) * XP + 8 * pc) = w; } }
        __syncthreads();
        bf16x8 px[5], pg[2]; int t2 = tid; asm volatile("" : "+v"(t2));
        if (more) {
#pragma unroll
            for (int i = 0; i < 5; ++i) { const int p = t2 + 512 * i; if (p < 67 * 32) px[i] = *reinterpret_cast<const bf16x8*>(xb + (mc + 61 + (p >> 5)) * D + cbase + 8 * (p & 31)); }
#pragma unroll
            for (int i = 0; i < 2; ++i) { const int p = t2 + 512 * i; pg[i] = *reinterpret_cast<const bf16x8*>(gin + (mc + 64 + (p >> 4)) * D + gcol + 8 * (p & 15)); } }
        f32x4 acc[4][2];
#pragma unroll
        for (int m = 0; m < 4; ++m) { acc[m][0] = (f32x4){0.f, 0.f, 0.f, 0.f}; acc[m][1] = (f32x4){0.f, 0.f, 0.f, 0.f}; }
#pragma unroll
        for (int ks = 0; ks < 8; ++ks) { bf16x8 af[4];
#pragma unroll
            for (int m = 0; m < 4; ++m) af[m] = *reinterpret_cast<const bf16x8*>(XC + (16 * m + fr) * XP + 32 * ks + 8 * fq);
#pragma unroll
            for (int m = 0; m < 4; ++m) { acc[m][0] = __builtin_amdgcn_mfma_f32_16x16x32_bf16(af[m], Bf[0][ks], acc[m][0], 0, 0, 0); acc[m][1] = __builtin_amdgcn_mfma_f32_16x16x32_bf16(af[m], Bf[1][ks], acc[m][1], 0, 0, 0); } }
#pragma unroll
        for (int m = 0; m < 4; ++m)
#pragma unroll
            for (int rgi = 0; rgi < 4; ++rgi) { const int tok = 16 * m + 4 * fq + rgi;
                const float xcv = bf2f(XC[tok * XP + chl]);
                const float r = __builtin_amdgcn_rcpf(1.f + __expf(-(acc[m][0][rgi] + ba))), ig = __builtin_amdgcn_rcpf(1.f + __expf(-(acc[m][1][rgi] + bi)));
                const float av = __builtin_amdgcn_exp2f(r * c8l); const float x2 = r * c2;
                float mult = __builtin_amdgcn_sqrtf(small_x ? neg_expm1_series(x2) : neg_expm1(x2)); if (pos0 && c == 0 && tok == 0) mult = 1.f;
                acc[m][0][rgi] = av; acc[m][1][rgi] = mult * ig * xcv; }
#pragma unroll
        for (int m = 0; m < 4; ++m) {
            float A = 1.f, B = 0.f;
#pragma unroll
            for (int rgi = 0; rgi < 4; ++rgi) { B = acc[m][0][rgi] * B + acc[m][1][rgi]; A *= acc[m][0][rgi]; }
            { const float Ap = bperm(A, a16), Bp = bperm(B, a16); if (fq >= 1) { B = A * Bp + B; A = A * Ap; } }
            { const float Ap = bperm(A, a32), Bp = bperm(B, a32); if (fq >= 2) { B = A * Bp + B; A = A * Ap; } }
            float Ae = bperm(A, a16), Be = bperm(B, a16); if (fq == 0) { Ae = 1.f; Be = 0.f; }
            const float At = bperm(A, a48), Bt = bperm(B, a48);
            float h = Ae * H + Be; H = At * H + Bt;
#pragma unroll
            for (int rgi = 0; rgi < 4; ++rgi) { h = acc[m][0][rgi] * h + acc[m][1][rgi]; acc[m][1][rgi] = h; } }
#pragma unroll
        for (int m = 0; m < 4; ++m)
#pragma unroll
            for (int rgi = 0; rgi < 4; ++rgi) { bf16_t* gp = GT + (16 * m + 4 * fq + rgi) * GP + 16 * wid + fr; *gp = (bf16_t)f2bf(acc[m][1][rgi] * bf2f(*gp)); }
        if (!more && fq == 0) rnn_out[ch] = H;
        __syncthreads();
#pragma unroll
        for (int i = 0; i < 2; ++i) { const int p = tid + 512 * i, row = p >> 4, pc = p & 15; *(u32x4*)(hgo + (mc + row) * D + gcol + 8 * pc) = *(const u32x4*)(GT + row * GP + 8 * pc); }
        __syncthreads();
        if (more) {
#pragma unroll
            for (int i = 0; i < 5; ++i) { const int p = t2 + 512 * i; if (p < 67 * 32) *reinterpret_cast<bf16x8*>(XB + (p >> 5) * XP + 8 * (p & 31)) = px[i]; }
#pragma unroll
            for (int i = 0; i < 2; ++i) { const int p = t2 + 512 * i; *reinterpret_cast<bf16x8*>(GT + (p >> 4) * GP + 8 * (p & 15)) = pg[i]; }
            __syncthreads(); }
    }
    __syncthreads();
}

__device__ __forceinline__ void rglru_phase(char* lds, const bf16_t* xb, const bf16_t* gin, bf16_t* hgo, const bf16_t* wai, const float* cw, const float* cb, const float* b_a, const float* b_i, const float* lam,
                                            const float* sconv, const float* srnn, float* rnnp, float* rnns, int vcu, int G, int tid) {
    for (int uu = vcu; uu < (PB + SB) * 16; uu += G) { const bool samp = uu >= PB * 16; const int u = samp ? uu - PB * 16 : uu; const int b = u >> 4, n = (u >> 1) & 7, hf = u & 1;
        rg_unit(lds, xb, gin, hgo, wai + (size_t)n * 512 * 256, cw, cb, b_a, b_i, lam, samp ? sconv + (size_t)b * 3 * D : nullptr, samp ? srnn + (size_t)b * D : nullptr, (samp ? rnns : rnnp) + (size_t)b * D,
                samp ? (size_t)TP + (size_t)b * SS : (size_t)b * PS, samp ? 1 : PS / 64, n * 256, hf, !samp, tid); }
}
}

constexpr int NWAVES = 8;
constexpr int RING_BYTES = 139264;
constexpr int MISC_OFF = RING_BYTES + 320;
constexpr int LDS_BYTES = 147456;
using pg8::bf16_t;

__device__ __forceinline__ float lane_xor_f(float v, int lane4) { return __int_as_float(__builtin_amdgcn_ds_bpermute(lane4, __float_as_int(v))); }
__device__ __forceinline__ float wave_sum(float v, int lane) {
#pragma unroll
    for (int o = 1; o < 64; o <<= 1) v += lane_xor_f(v, (lane ^ o) << 2);
    return v;
}
__device__ __forceinline__ float wave_max(float v, int lane) {
#pragma unroll
    for (int o = 1; o < 64; o <<= 1) v = fmaxf(v, lane_xor_f(v, (lane ^ o) << 2));
    return v;
}

struct Args { const float* in[32]; float* out; unsigned char* ws; };
typedef const __attribute__((address_space(4))) unsigned char* kaptr_t;
__device__ __forceinline__ kaptr_t ka_fresh() { kaptr_t ka = (kaptr_t)__builtin_amdgcn_kernarg_segment_ptr(); asm volatile("" : "+s"(ka)); return ka; }
__device__ __forceinline__ const float* arg_in(kaptr_t ka, int i) { return *(const float* const __attribute__((address_space(4)))*)(ka + 8 * i); }
__device__ __forceinline__ float* arg_out(kaptr_t ka) { return *(float* const __attribute__((address_space(4)))*)(ka + 8 * 32); }
__device__ __forceinline__ unsigned char* arg_ws(kaptr_t ka) { return *(unsigned char* const __attribute__((address_space(4)))*)(ka + 8 * 33); }
#define GAS __attribute__((address_space(1)))
struct TItem { const GAS float* W; GAS bf16_t* WT; int K, N, mode, off, item; };
__device__ __forceinline__ void t_load(const TItem& t, float (&v)[32], int lane) {
    const int nblk = t.N / 32, kb = t.item / nblk, nb = t.item % nblk; const GAS float* p = t.W + (size_t)(64 * kb + (lane >> 5)) * t.N + 32 * nb + (lane & 31);
#pragma unroll
    for (int i = 0; i < 32; ++i) v[i] = p[(size_t)(2 * i) * t.N];
}
__device__ __forceinline__ void t_finish(const TItem& t, const float (&v)[32], LAS float* scr, int lane) {
    const int nblk = t.N / 32, kb = t.item / nblk, nb = t.item % nblk, k0 = 64 * kb, n0 = 32 * nb;
#pragma unroll
    for (int i = 0; i < 32; ++i) scr[(2 * i + (lane >> 5)) * 33 + (lane & 31)] = v[i];
    LDS_WAIT(); asm volatile("" ::: "memory");
    const int c = lane & 7;
#pragma unroll
    for (int j = 0; j < 4; ++j) { const int n = (lane >> 3) + 8 * j; const LAS float* s = scr + (8 * c) * 33 + n;
        u32x4 o; o.x = pk2(s[0 * 33], s[1 * 33]); o.y = pk2(s[2 * 33], s[3 * 33]); o.z = pk2(s[4 * 33], s[5 * 33]); o.w = pk2(s[6 * 33], s[7 * 33]);
        const int nc = n0 + n; const int drow = t.mode == 0 ? t.off + nc : (t.mode == 1 ? ((nc >> 7) * 256 + (nc & 127) + t.off) : (2 * nc + t.off));
        *(GAS u32x4*)(t.WT + (size_t)drow * t.K + k0 + 8 * c) = o; }
}
constexpr int T_IB = 2048;
constexpr int T_I13 = 32 * (DFF / 32);
constexpr int T_I2 = (DFF / 64) * 64;
constexpr int T_S0 = 6 * T_IB, T_S1 = T_S0 + 4 * T_IB, T_S2 = T_S1 + 2 * T_IB, T_S3 = T_S2 + 32 * 32, T_S4 = T_S3 + 8 * T_I13, T_S5 = T_S4 + 4 * T_I2;
__device__ __forceinline__ TItem t_decode(kaptr_t ka, int it) {
    unsigned char* ws = arg_ws(ka); TItem t;
    if (it < T_S0) { const int mi = it / T_IB, l = mi / 3, ty = mi % 3;
        t.W = (const GAS float*)((ty == 0 ? arg_in(ka, 13) : (ty == 1 ? arg_in(ka, 12) : arg_in(ka, 21))) + (size_t)l * D * D); t.WT = (GAS bf16_t*)(ty == 2 ? (bf16_t*)(ws + WS_WRGO) + (size_t)l * D * D : (bf16_t*)(ws + WS_WGI) + (size_t)l * 2 * D * D);
        t.K = D; t.N = D; t.mode = 0; t.off = ty == 1 ? D : 0; t.item = it % T_IB; }
    else if (it < T_S1) { const int q = it - T_S0, mi = q / T_IB, l = mi >> 1, ty = mi & 1;
        t.W = (const GAS float*)((ty == 0 ? arg_in(ka, 25) : arg_in(ka, 26)) + (size_t)l * D * D); t.WT = (GAS bf16_t*)((bf16_t*)(ws + (ty == 0 ? WS_WQ : WS_WO)) + (size_t)l * D * D); t.K = D; t.N = D; t.mode = 0; t.off = 0; t.item = q % T_IB; }
    else if (it < T_S2) { const int q = it - T_S1, ty = q / T_IB;
        t.W = (const GAS float*)(ty == 0 ? arg_in(ka, 23) : arg_in(ka, 24)); t.WT = (GAS bf16_t*)((bf16_t*)(ws + WS_WKV)); t.K = D; t.N = D; t.mode = 0; t.off = ty == 0 ? 0 : D; t.item = q % T_IB; }
    else if (it < T_S3) { const int q = it - T_S2, mi = q / 32, ln = mi >> 1, ty = mi & 1;
        t.W = (const GAS float*)((ty == 0 ? arg_in(ka, 16) : arg_in(ka, 18)) + (size_t)ln * 256 * 256); t.WT = (GAS bf16_t*)((bf16_t*)(ws + WS_WAI) + (size_t)ln * 512 * 256); t.K = 256; t.N = 256; t.mode = 2; t.off = ty; t.item = q % 32; }
    else if (it < T_S4) { const int q = it - T_S3, mi = q / T_I13, l = mi >> 1, ty = mi & 1;
        t.W = (const GAS float*)((ty == 0 ? arg_in(ka, 28) : arg_in(ka, 29)) + (size_t)l * D * DFF); t.WT = (GAS bf16_t*)((bf16_t*)(ws + WS_W13) + (size_t)l * 2 * DFF * D); t.K = D; t.N = DFF; t.mode = 1; t.off = ty * 128; t.item = q % T_I13; }
    else { const int q = it - T_S4, l = q / T_I2;
        t.W = (const GAS float*)(arg_in(ka, 30) + (size_t)l * DFF * D); t.WT = (GAS bf16_t*)((bf16_t*)(ws + WS_W2) + (size_t)l * D * DFF); t.K = DFF; t.N = D; t.mode = 0; t.off = 0; t.item = q % T_I2; }
    return t;
}
__device__ __forceinline__ void p0_weights(kaptr_t ka, LAS unsigned char* lds, int gw, int NGW, int wave, int lane) {
    LAS float* scr0 = (LAS float*)(lds + wave * 16896); LAS float* scr1 = scr0 + 64 * 33;
    for (int it = 2 * gw; it < T_S5; it += 2 * NGW) {
        const TItem t0 = t_decode(ka, it), t1 = t_decode(ka, it + 1);
        float v0[32], v1[32];
        t_load(t0, v0, lane); t_load(t1, v1, lane);
        t_finish(t0, v0, scr0, lane); t_finish(t1, v1, scr1, lane);
        LDS_WAIT(); asm volatile("" ::: "memory");
    }
}

__device__ __forceinline__ void p0_cache(const float* __restrict__ ck, const float* __restrict__ cv, bf16_t* __restrict__ KS, bf16_t* __restrict__ VS, int gw, int NGW, int lane) {
    constexpr int STEPS = SB * LEFT * D / 512;
    for (int it0 = 4 * gw; it0 < 2 * STEPS; it0 += 4 * NGW) {
        f32x4 x0[4], x1[4];
#pragma unroll
        for (int u = 0; u < 4; ++u) { const int it = it0 + u; const bool isv = it >= STEPS; const size_t e = (size_t)(isv ? it - STEPS : it) * 512 + lane * 8; const float* src = (isv ? cv : ck) + e; x0[u] = *(const f32x4*)src; x1[u] = *(const f32x4*)(src + 4); }
#pragma unroll
        for (int u = 0; u < 4; ++u) { const int it = it0 + u; const bool isv = it >= STEPS; const size_t e = (size_t)(isv ? it - STEPS : it) * 512 + lane * 8;
            const size_t bj = e >> 11, col = e & (D - 1), b = bj >> 9, j = bj & (LEFT - 1);
            u32x4 w; w.x = pk2(x0[u][0], x0[u][1]); w.y = pk2(x0[u][2], x0[u][3]); w.z = pk2(x1[u][0], x1[u][1]); w.w = pk2(x1[u][2], x1[u][3]);
            *(u32x4*)((isv ? VS : KS) + (b * BAND + j) * D + col) = w; }
    }
}

__device__ __forceinline__ void p0_mod(const float* __restrict__ c_p, const float* __restrict__ c_s, const float* __restrict__ ada_w, const float* __restrict__ ada_b, float* __restrict__ mod, LAS unsigned char* lds, int vcu, int G, int tid) {
    LAS float* cs = (LAS float*)lds;
    LAS float* red = (LAS float*)lds;
    const int cp = tid & 31, ks = tid >> 5, lane = tid & 63, wv = tid >> 6;
    for (int item = vcu; item < 4 * 192; item += G) {
        const int l = item / 192, j0 = (item % 192) * 64;
        f32x2 acc[NBB];
#pragma unroll
        for (int bb = 0; bb < NBB; ++bb) acc[bb] = (f32x2){0.f, 0.f};
        for (int kc = 0; kc < 8; ++kc) {
            __syncthreads();
#pragma unroll 4
            for (int i = 0; i < 24; ++i) { const int idx = tid + 512 * i, bb = idx >> 8, kk = idx & 255; const float c = bb < PB ? c_p[bb * D + kc * 256 + kk] : c_s[(bb - PB) * D + kc * 256 + kk]; cs[kk * NBB + bb] = c / (1.0f + __expf(-c)); }
            __syncthreads();
            f32x2 w2[16];
            const float* wp = ada_w + ((size_t)l * D + kc * 256 + ks * 16) * MODW + j0 + 2 * cp;
#pragma unroll
            for (int i = 0; i < 16; ++i) w2[i] = *(const f32x2*)(wp + (size_t)i * MODW);
#pragma unroll
            for (int i = 0; i < 16; ++i) { const LAS f32x4* cr = (const LAS f32x4*)(cs + (ks * 16 + i) * NBB);
#pragma unroll
                for (int q = 0; q < 12; ++q) { const f32x4 c4 = cr[q];
#pragma unroll
                    for (int e = 0; e < 4; ++e) acc[4 * q + e] += w2[i] * c4[e]; } }
        }
#pragma unroll
        for (int bb = 0; bb < NBB; ++bb) {
            { auto r = __builtin_amdgcn_permlane32_swap(__float_as_uint(acc[bb][0]), __float_as_uint(acc[bb][0]), false, false); acc[bb][0] = __uint_as_float(r[0]) + __uint_as_float(r[1]); }
            { auto r = __builtin_amdgcn_permlane32_swap(__float_as_uint(acc[bb][1]), __float_as_uint(acc[bb][1]), false, false); acc[bb][1] = __uint_as_float(r[0]) + __uint_as_float(r[1]); } }
        __syncthreads();
        if (lane < 32) {
#pragma unroll
            for (int bb = 0; bb < NBB; ++bb) { red[(wv * 96 + 2 * bb) * 32 + lane] = acc[bb][0]; red[(wv * 96 + 2 * bb + 1) * 32 + lane] = acc[bb][1]; } }
        __syncthreads();
#pragma unroll
        for (int i = 0; i < 6; ++i) { const int o = tid + 512 * i, bb = o >> 6, col = o & 63, v = 2 * bb + (col & 1), c2 = col >> 1; float s = ada_b[l * MODW + j0 + col];
#pragma unroll
            for (int w = 0; w < 8; ++w) s += red[(w * 96 + v) * 32 + c2];
            mod[((size_t)l * NBB + bb) * MODW + j0 + col] = s; }
    }
    __syncthreads();
}

__device__ __forceinline__ void gm_tables(const float* __restrict__ g_mix, const float* __restrict__ g_ffn, const float* __restrict__ mod, float* __restrict__ gm, int gtid, int nthreads) {
    for (int e = gtid; e < 8 * NBB * (D / 4); e += nthreads) { const int k4 = e % (D / 4), b = (e / (D / 4)) % NBB, i = e / ((D / 4) * NBB), l = i >> 1;
        const f32x4 g = *(const f32x4*)((i & 1 ? g_ffn : g_mix) + (size_t)l * D + 4 * k4), sc = *(const f32x4*)(mod + ((size_t)l * NBB + b) * MODW + (i & 1 ? 4 * D : D) + 4 * k4);
        *(f32x4*)(gm + ((size_t)i * NBB + b) * D + 4 * k4) = g * (sc + 1.0f); }
}
__device__ __forceinline__ void norm0_pass(const float* __restrict__ xp_, const float* __restrict__ xs_, bf16_t* __restrict__ X, bf16_t* __restrict__ xg, const float* __restrict__ g, const float* __restrict__ mod0, pg8::ssq_t* __restrict__ ssq0, int gw, int NGW, int lane) {
    for (int m0 = gw; m0 < T; m0 += 2 * NGW) {
        const int m1 = m0 + NGW; const bool two = m1 < T; const int mb = two ? m1 : m0;
        const f32x4* xr0 = (const f32x4*)(m0 < TP ? xp_ + (size_t)m0 * D : xs_ + (size_t)(m0 - TP) * D) + lane;
        const f32x4* xr1 = (const f32x4*)(mb < TP ? xp_ + (size_t)mb * D : xs_ + (size_t)(mb - TP) * D) + lane;
        f32x4 v0[8], v1[8];
#pragma unroll
        for (int j = 0; j < 8; ++j) { v0[j] = xr0[64 * j]; v1[j] = xr1[64 * j]; }
#pragma unroll
        for (int r = 0; r < 2; ++r) { if (r == 1 && !two) break; const int m = r ? m1 : m0; const f32x4* v = r ? v1 : v0; float ss = 0.f;
#pragma unroll
            for (int j = 0; j < 8; ++j) ss += (v[j][0] * v[j][0] + v[j][1] * v[j][1]) + (v[j][2] * v[j][2] + v[j][3] * v[j][3]);
            ss = wave_sum(ss, lane); if (lane == 0) ssq0[m] = pg8::ssq_fix(ss);
            const int bb = row_bb(m); const f32x4* gp = (const f32x4*)g + lane; const f32x4* sc = (const f32x4*)(mod0 + (size_t)bb * MODW + D) + lane;
            u32x2* xc = (u32x2*)(X + (size_t)m * XPITCH) + lane; u32x2* o = (u32x2*)(xg + (size_t)m * D) + lane;
#pragma unroll
            for (int j = 0; j < 8; ++j) { { u32x2 w; w.x = pk2(v[j][0], v[j][1]); w.y = pk2(v[j][2], v[j][3]); xc[64 * j] = w; } const f32x4 z = v[j] * (gp[64 * j] * (sc[64 * j] + 1.0f)); u32x2 w; w.x = pk2(z[0], z[1]); w.y = pk2(z[2], z[3]); o[64 * j] = w; } }
    }
}
__device__ __forceinline__ void shw_tile(const float* __restrict__ sh, const bf16_t* __restrict__ Wt, float* __restrict__ dst, int N, int n0, int lane) {
    const int fr = lane & 15, fq = lane >> 4;
    f32x4 acc[3][4];
#pragma unroll
    for (int m = 0; m < 3; ++m)
#pragma unroll
        for (int j = 0; j < 4; ++j) acc[m][j] = (f32x4){0.f, 0.f, 0.f, 0.f};
    const float* ap = sh + (size_t)fr * MODW + 8 * fq; const bf16_t* bp = Wt + (size_t)(n0 + fr) * D + 8 * fq;
#pragma unroll 4
    for (int k0 = 0; k0 < D; k0 += 32) { bf16x8 af[3], bfr[4];
#pragma unroll
        for (int m = 0; m < 3; ++m) { const f32x4 x0 = *(const f32x4*)(ap + (size_t)(16 * m) * MODW + k0), x1 = *(const f32x4*)(ap + (size_t)(16 * m) * MODW + k0 + 4); u32x4 w; w.x = pk2(x0[0], x0[1]); w.y = pk2(x0[2], x0[3]); w.z = pk2(x1[0], x1[1]); w.w = pk2(x1[2], x1[3]); af[m] = *reinterpret_cast<bf16x8*>(&w); }
#pragma unroll
        for (int j = 0; j < 4; ++j) bfr[j] = *reinterpret_cast<const bf16x8*>(bp + (size_t)(16 * j) * D + k0);
#pragma unroll
        for (int m = 0; m < 3; ++m)
#pragma unroll
            for (int j = 0; j < 4; ++j) acc[m][j] = __builtin_amdgcn_mfma_f32_16x16x32_bf16(af[m], bfr[j], acc[m][j], 0, 0, 0); }
#pragma unroll
    for (int m = 0; m < 3; ++m)
#pragma unroll
        for (int j = 0; j < 4; ++j)
#pragma unroll
            for (int r = 0; r < 4; ++r) dst[(size_t)(16 * m + 4 * fq + r) * N + n0 + 16 * j + fr] = acc[m][j][r];
}
__device__ __forceinline__ void shw_phase(const float* __restrict__ mod, unsigned char* ws, int vcu, int G, int wave, int lane) {
    float* shw = (float*)(ws + WS_SHW);
    for (int t = vcu + G * wave; t < 896; t += G * NWAVES) {
        if (t < 128) { const int l = t >> 6, n0 = (t & 63) * 64; shw_tile(mod + (size_t)l * NBB * MODW, (const bf16_t*)(ws + WS_WGI) + (size_t)l * 2 * D * D, shw + SHW_GI + (size_t)l * NBB * 2 * D, 2 * D, n0, lane); }
        else if (t < 192) { const int bl = (t - 128) >> 5, n0 = ((t - 128) & 31) * 64; shw_tile(mod + (size_t)(2 + bl) * NBB * MODW, (const bf16_t*)(ws + WS_WQ) + (size_t)bl * D * D, shw + SHW_Q + (size_t)bl * NBB * D, D, n0, lane); }
        else { const int q = t - 192, l = q / 176, n0 = (q % 176) * 64; shw_tile(mod + (size_t)l * NBB * MODW + 3 * D, (const bf16_t*)(ws + WS_W13) + (size_t)l * 2 * DFF * D, shw + SHW_13 + (size_t)l * NBB * 2 * DFF, 2 * DFF, n0, lane); }
    }
}
__device__ __forceinline__ void final_pass(float* Y, const float* __restrict__ g, const pg8::ssq_t* __restrict__ ssq, int gw, int NGW, int lane) {
    for (int m0 = gw; m0 < T; m0 += 2 * NGW) {
        const int m1 = m0 + NGW; const bool two = m1 < T; const int mb = two ? m1 : m0;
        const u32x2* x0 = (const u32x2*)((const bf16_t*)(Y + (size_t)m0 * D) + D) + lane; const u32x2* x1 = (const u32x2*)((const bf16_t*)(Y + (size_t)mb * D) + D) + lane; const f32x4* gp = (const f32x4*)g + lane;
        u32x2 v0[8], v1[8];
#pragma unroll
        for (int j = 0; j < 8; ++j) { v0[j] = x0[64 * j]; v1[j] = x1[64 * j]; }
        const float r0 = pg8::rstd_of(ssq[m0]), r1 = pg8::rstd_of(ssq[mb]);
        asm volatile("s_waitcnt vmcnt(0)" ::: "memory");
        f32x4* y0 = (f32x4*)(Y + (size_t)m0 * D) + lane; f32x4* y1 = (f32x4*)(Y + (size_t)mb * D) + lane;
#pragma unroll
        for (int j = 0; j < 8; ++j) { const f32x4 xv = {__uint_as_float(v0[j].x << 16), __uint_as_float(v0[j].x & 0xffff0000u), __uint_as_float(v0[j].y << 16), __uint_as_float(v0[j].y & 0xffff0000u)}; y0[64 * j] = (xv * r0) * gp[64 * j]; }
        if (two) {
#pragma unroll
            for (int j = 0; j < 8; ++j) { const f32x4 xv = {__uint_as_float(v1[j].x << 16), __uint_as_float(v1[j].x & 0xffff0000u), __uint_as_float(v1[j].y << 16), __uint_as_float(v1[j].y & 0xffff0000u)}; y1[64 * j] = (xv * r1) * gp[64 * j]; } }
    }
}

#define fresh_tid() ({ int t_ = (wave_s_ << 6) | (int)__builtin_amdgcn_mbcnt_hi(~0u, __builtin_amdgcn_mbcnt_lo(~0u, 0u)); asm volatile("" : "+v"(t_)); t_; })
__device__ __forceinline__ int fresh_s(int v) { asm volatile("" : "+s"(v)); return v; }
#define WSP(off) ((bf16_t*)(arg_ws(ka) + (off)))

__global__ void __launch_bounds__(NWAVES * 64, 2) mega_fwd(Args a_unused) {
    extern __shared__ __attribute__((aligned(16))) unsigned char lds_raw[];
    LAS unsigned char* lds = (LAS unsigned char*)lds_raw;
    const int G_ = gridDim.x, bx_ = blockIdx.x; const int wave_s_ = __builtin_amdgcn_readfirstlane((int)threadIdx.x >> 6);
#define G (fresh_s(G_))
#define bx (fresh_s(bx_))
#define TID (fresh_tid())
#define LANE (fresh_tid() & 63)
#define WAVE (__builtin_amdgcn_readfirstlane(fresh_tid() >> 6))
#define VCU ((G % 8 == 0) ? (bx % 8) * (G / 8) + bx / 8 : bx)
#define GW (VCU * NWAVES + WAVE)
#define NGW (G * NWAVES)
    for (int u = TID; u < (LDS_BYTES - RING_BYTES) / 4; u += NWAVES * 64) ((LAS unsigned*)(lds + RING_BYTES))[u] = 0u;
    __syncthreads();
    XcdBarrier bar;
    { kaptr_t ka = ka_fresh(); bar = xcd_barrier_post((unsigned*)(arg_ws(ka) + WS_CTL) + CW_BAR, (volatile LAS unsigned*)(lds + MISC_OFF) + 8); }
#define GRID_BAR() do { XcdBarrier b2_ = bar; __attribute__((address_space(1))) unsigned* gb_ = (__attribute__((address_space(1))) unsigned*)bar.bar; asm volatile("" : "+s"(gb_), "+s"(b2_.x)); b2_.bar = (unsigned*)gb_; xcd_barrier(b2_); } while (0)

    { kaptr_t ka = ka_fresh(); pg8::ssq_t* sq = (pg8::ssq_t*)(arg_ws(ka) + WS_SSQ);
      for (int i = VCU * (NWAVES * 64) + TID; i < 9 * T; i += G * NWAVES * 64) sq[i] = 0ull; }
    { kaptr_t ka = ka_fresh(); p0_weights(ka, lds, GW, NGW, WAVE, LANE); }
    { kaptr_t ka = ka_fresh(); p0_cache(arg_in(ka, 6), arg_in(ka, 7), WSP(WS_KS), WSP(WS_VS), GW, NGW, LANE); }
    __syncthreads();
    { kaptr_t ka = ka_fresh(); p0_mod(arg_in(ka, 2), arg_in(ka, 3), arg_in(ka, 8), arg_in(ka, 9), (float*)(arg_ws(ka) + WS_MOD), lds, VCU, G, TID); }
    GRID_BAR();

    { kaptr_t ka = ka_fresh(); const float* mod = (const float*)(arg_ws(ka) + WS_MOD);
      gm_tables(arg_in(ka, 10), arg_in(ka, 11), mod, (float*)(arg_ws(ka) + WS_GM), VCU * (NWAVES * 64) + TID, G * NWAVES * 64); }
    { kaptr_t ka = ka_fresh(); shw_phase((const float*)(arg_ws(ka) + WS_MOD), arg_ws(ka), VCU, G, WAVE, LANE); }
    { kaptr_t ka = ka_fresh();
      norm0_pass(arg_in(ka, 0), arg_in(ka, 1), (bf16_t*)(arg_out(ka) + O_Y) + D, WSP(WS_HN), arg_in(ka, 10), (const float*)(arg_ws(ka) + WS_MOD), (pg8::ssq_t*)(arg_ws(ka) + WS_SSQ), GW, NGW, LANE); }
    GRID_BAR();

#define SSQP(i) ((pg8::ssq_t*)(arg_ws(ka) + WS_SSQ) + (size_t)(i) * T)
#define GMP(i) ((const float*)(arg_ws(ka) + WS_GM) + (size_t)(i) * NBB * D)
#define MODL(l) ((const float*)(arg_ws(ka) + WS_MOD) + (size_t)(l) * NBB * MODW)
#define SHWP(off) ((const float*)(arg_ws(ka) + WS_SHW) + (off))
#pragma unroll 1
    for (int l = 0; l < 4; ++l) {
        if (l < 2) {
            { kaptr_t ka = ka_fresh(); float* out = arg_out(ka);
              pg8::Gemm g{WSP(WS_HN), WSP(WS_WGI) + (size_t)l * 2 * D * D, T, 2 * D, D}; pg8::ORD_GI S; S.init(T, 2 * D, G, bx);
              pg8::EpiGateInP E{WSP(WS_BA), WSP(WS_BB), out + O_CONVP + (size_t)l * PB * 3 * D, out + O_CONVS + (size_t)l * SB * 3 * D, SSQP(2 * l), SHWP(SHW_GI + (size_t)l * NBB * 2 * D)};
              pg8::gemm_phase<pg8::EpiGateInP, pg8::ORD_GI, true, true>(lds, g, S, E, TID); }
            GRID_BAR();
            { kaptr_t ka = ka_fresh(); float* out = arg_out(ka);
              rg::rglru_phase((char*)lds_raw, WSP(WS_BB), WSP(WS_BA), WSP(WS_HN), WSP(WS_WAI) + (size_t)l * 8 * 512 * 256, arg_in(ka, 14) + (size_t)l * 4 * D, arg_in(ka, 15) + (size_t)l * D, arg_in(ka, 17) + (size_t)l * D, arg_in(ka, 19) + (size_t)l * D,
                              arg_in(ka, 20) + (size_t)l * D, arg_in(ka, 4) + (size_t)l * SB * 3 * D, arg_in(ka, 5) + (size_t)l * SB * D, out + O_RNNP + (size_t)l * PB * D, out + O_RNNS + (size_t)l * SB * D, VCU, G, TID); }
            GRID_BAR();
            { kaptr_t ka = ka_fresh();
              pg8::Gemm g{WSP(WS_HN), WSP(WS_WRGO) + (size_t)l * D * D, T, D, D}; pg8::ORD_R S; S.init(T, D, G, bx);
              pg8::EpiResidP E{(bf16_t*)(arg_out(ka) + O_Y) + D, MODL(l) + 2 * D, WSP(WS_BA), GMP(2 * l + 1), nullptr, nullptr, SSQP(2 * l + 1)};
              pg8::gemm_phase<pg8::EpiResidP, pg8::ORD_R, true, true>(lds, g, S, E, TID); }
        } else {
            if (l == 2) { kaptr_t ka = ka_fresh();
              pg8::Gemm g{WSP(WS_BA), WSP(WS_WKV), T, 2 * D, D}; pg8::ORD_KV S; S.init(T, 2 * D, G, bx);
              pg8::EpiKVP E{WSP(WS_BB), WSP(WS_BC), WSP(WS_KS), WSP(WS_VS), arg_out(ka), SSQP(4)};
              pg8::gemm_phase<pg8::EpiKVP, pg8::ORD_KV, true, true>(lds, g, S, E, TID); }
            { kaptr_t ka = ka_fresh();
              pg8::Gemm g{WSP(WS_HN), WSP(WS_WQ) + (size_t)(l - 2) * D * D, T, D, D}; pg8::ORD_Q S; S.init(T, D, G, bx);
              pg8::EpiQP E{WSP(WS_HID), SSQP(2 * l), SHWP(SHW_Q + (size_t)(l - 2) * NBB * D)};
              pg8::gemm_phase<pg8::EpiQP, pg8::ORD_Q, true, true>(lds, g, S, E, TID); }
            GRID_BAR();
            { kaptr_t ka = ka_fresh();
              att::attn_phase((char*)lds_raw, WSP(WS_HID), WSP(WS_HN), WSP(WS_BB), WSP(WS_BC), WSP(WS_KS), WSP(WS_VS), arg_in(ka, 27) + (size_t)(l - 2) * (2 * RELC + 1) * NH, VCU, G, TID); }
            GRID_BAR();
            { kaptr_t ka = ka_fresh();
              pg8::Gemm g{WSP(WS_HN), WSP(WS_WO) + (size_t)(l - 2) * D * D, T, D, D}; pg8::ORD_R S; S.init(T, D, G, bx);
              pg8::EpiResidP E{(bf16_t*)(arg_out(ka) + O_Y) + D, MODL(l) + 2 * D, WSP(WS_BA), GMP(2 * l + 1), nullptr, nullptr, SSQP(2 * l + 1)};
              pg8::gemm_phase<pg8::EpiResidP, pg8::ORD_R, true, true>(lds, g, S, E, TID); }
        }
        GRID_BAR();
        { kaptr_t ka = ka_fresh();
          pg8::Gemm g{WSP(WS_BA), WSP(WS_W13) + (size_t)l * 2 * DFF * D, T, 2 * DFF, D}; pg8::ORD_F13 S; S.init(T, 2 * DFF, G, bx);
          pg8::EpiFfn13P E{WSP(WS_HID), SSQP(2 * l + 1), SHWP(SHW_13 + (size_t)l * NBB * 2 * DFF)};
          pg8::gemm_phase<pg8::EpiFfn13P, pg8::ORD_F13, true, true>(lds, g, S, E, TID);
          }
        GRID_BAR();
        { kaptr_t ka = ka_fresh();
          pg8::Gemm g{WSP(WS_HID), WSP(WS_W2) + (size_t)l * D * DFF, T, D, DFF}; pg8::ORD_F2 S; S.init(T, D, G, bx);
          pg8::EpiResidP E{(bf16_t*)(arg_out(ka) + O_Y) + D, MODL(l) + 5 * D, l < 3 ? WSP(WS_HN) : nullptr, GMP(l < 3 ? 2 * l + 2 : 0), l == 1 ? WSP(WS_BA) : nullptr, arg_in(ka, 22), SSQP(2 * l + 2)};
          pg8::gemm_phase<pg8::EpiResidP, pg8::ORD_F2, true, true>(lds, g, S, E, TID); }
        GRID_BAR();
    }
    { kaptr_t ka = ka_fresh(); final_pass(arg_out(ka) + O_Y, arg_in(ka, 31), SSQP(8), GW, NGW, LANE); }
}

extern "C" void kernel_launch(void* const* d_in, const int* in_sizes, int n_in, void* d_out, int out_size, void* d_ws, size_t ws_size, hipStream_t stream) {
    (void)in_sizes; (void)out_size;
    static int grid = 0;
    if (grid == 0) {
        if (n_in != 32 || ws_size < WS_END) { fprintf(stderr, "kernel_launch: unexpected n_in %d / ws %zu\n", n_in, ws_size); grid = -1; return; }
        int dev = 0, cus = 0, per_cu = 0;
        if (hipGetDevice(&dev) != hipSuccess || hipDeviceGetAttribute(&cus, hipDeviceAttributeMultiprocessorCount, dev) != hipSuccess) { grid = -1; return; }
        if (hipFuncSetAttribute((const void*)mega_fwd, hipFuncAttributeMaxDynamicSharedMemorySize, LDS_BYTES) != hipSuccess) { fprintf(stderr, "kernel_launch: hipFuncSetAttribute failed\n"); grid = -1; return; }
        if (hipOccupancyMaxActiveBlocksPerMultiprocessor(&per_cu, (const void*)mega_fwd, NWAVES * 64, LDS_BYTES) != hipSuccess || per_cu < 1) fprintf(stderr, "kernel_launch: occupancy query says %d\n", per_cu);
        (void)hipGetLastError();
        grid = cus;
    }
    if (grid < 0) return;
    if (hipMemsetAsync((char*)d_ws + WS_CTL, 0, CTL_ZERO_BYTES, stream) != hipSuccess) return;
    Args a{};
    for (int i = 0; i < 32; ++i) a.in[i] = (const float*)d_in[i];
    a.out = (float*)d_out; a.ws = (unsigned char*)d_ws;
    hipLaunchKernelGGL(mega_fwd, dim3(grid), dim3(NWAVES * 64), LDS_BYTES, stream, a);
}
```

```cpp
#include <hip/hip_runtime.h>
#include <cstdio>
#include <cstdint>

typedef unsigned short bf16_t;
typedef short bf16x8 __attribute__((ext_vector_type(8)));
typedef float f32x4 __attribute__((ext_vector_type(4)));
typedef float f32x2 __attribute__((ext_vector_type(2)));
typedef unsigned u32x2 __attribute__((ext_vector_type(2)));
typedef unsigned u32x4 __attribute__((ext_vector_type(4)));
#define LAS __attribute__((address_space(3)))

constexpr int D = 2048, DFF = 5632, NH = 16, HD = 128;
constexpr int PB = 16, PS = 2048, SB = 32, SS = 64;
constexpr int TP = PB * PS;
constexpr int TS = SB * SS;
constexpr int T = TP + TS;
constexpr int NBB = PB + SB;
constexpr int MODW = 6 * D;
constexpr int LEFT = 512, BAND = 576, RELC = 128;
constexpr float EPS = 1e-6f;

constexpr size_t O_Y = 0;
constexpr int XPITCH = 2 * 2048;
constexpr size_t O_CONVP = (size_t)T * D;
constexpr size_t O_RNNP = O_CONVP + 2 * PB * 3 * D;
constexpr size_t O_KP = O_RNNP + 2 * PB * D;
constexpr size_t O_VP = O_KP + (size_t)PB * LEFT * D;
constexpr size_t O_CONVS = O_VP + (size_t)PB * LEFT * D;
constexpr size_t O_RNNS = O_CONVS + 2 * SB * 3 * D;
constexpr size_t O_KS = O_RNNS + 2 * SB * D;
constexpr size_t O_VS = O_KS + (size_t)SB * SS * D;
constexpr size_t O_END = O_VS + (size_t)SB * SS * D;
static_assert(O_END == 114032640, "output size");

constexpr size_t MiB = 1u << 20;
constexpr size_t WS_CTL = 0, CTL_ZERO_BYTES = 1 * MiB;
constexpr size_t WS_MOD = 1 * MiB;
constexpr size_t WS_WGI = 10 * MiB;
constexpr size_t WS_WRGO = 42 * MiB;
constexpr size_t WS_WAI = 58 * MiB;
constexpr size_t WS_WKV = 62 * MiB;
constexpr size_t WS_WQ = 78 * MiB;
constexpr size_t WS_WO = 94 * MiB;
constexpr size_t WS_W13 = 110 * MiB;
constexpr size_t WS_W2 = 286 * MiB;
constexpr size_t WS_HN = 374 * MiB;
constexpr size_t WS_BA = 510 * MiB;
constexpr size_t WS_BB = 646 * MiB;
constexpr size_t WS_BC = 782 * MiB;
constexpr size_t WS_HID = 918 * MiB;
constexpr size_t WS_KS = 1292 * MiB;
constexpr size_t WS_VS = 1364 * MiB;
constexpr size_t WS_SSQ = 1454 * MiB;
constexpr size_t SSQ_BYTES = 9 * (size_t)34816 * 8;
constexpr size_t WS_GM = 1438 * MiB;
constexpr size_t WS_SHW = 1442 * MiB;
constexpr size_t SHW_GI = 0, SHW_Q = 2 * 48 * 4096, SHW_13 = SHW_Q + 2 * 48 * 2048;
constexpr size_t WS_END = 1458 * MiB;
constexpr int CW_BAR = 4096;

__device__ __forceinline__ float bf2f(bf16_t b) { return __uint_as_float(((unsigned)b) << 16); }
__device__ __forceinline__ unsigned f2bf(float f) { unsigned u = __float_as_uint(f); return (u + 0x7fffu + ((u >> 16) & 1u)) >> 16; }
__device__ __forceinline__ unsigned pk2(float lo, float hi) { return f2bf(lo) | (f2bf(hi) << 16); }
__device__ __forceinline__ int row_bb(int m) { return m < TP ? (m >> 11) : PB + ((m - TP) >> 6); }
__device__ __forceinline__ float fast_sigmoid(float x) { return __builtin_amdgcn_rcpf(1.0f + __expf(-x)); }
__device__ __forceinline__ f32x4 sigmoid4(const f32x4& x) { const f32x4 t = x * (-1.4426950408889634f); f32x4 e; e[0] = __builtin_amdgcn_exp2f(t[0]); e[1] = __builtin_amdgcn_exp2f(t[1]); e[2] = __builtin_amdgcn_exp2f(t[2]); e[3] = __builtin_amdgcn_exp2f(t[3]);
    const f32x4 d = e + 1.0f; f32x4 s; s[0] = __builtin_amdgcn_rcpf(d[0]); s[1] = __builtin_amdgcn_rcpf(d[1]); s[2] = __builtin_amdgcn_rcpf(d[2]); s[3] = __builtin_amdgcn_rcpf(d[3]); return s; }
__device__ __forceinline__ f32x4 gelu_tanh4(const f32x4& x) { const f32x4 u = (x * x * 0.044715f + 1.0f) * x * 1.5957691216057308f; return x * sigmoid4(u); }
__device__ __forceinline__ float gelu_tanh_fast(float x) { const float u = 1.5957691216057308f * (x + 0.044715f * x * x * x); return x * __builtin_amdgcn_rcpf(1.0f + __expf(-u)); }
#define LDS_WAIT() asm volatile("s_waitcnt lgkmcnt(0)" ::: "memory")
#define VM_WAIT() asm volatile("s_waitcnt vmcnt(0)" ::: "memory")

namespace pg8 {
#define PG8_LAS __attribute__((address_space(3)))
typedef unsigned short bf16_t;
typedef short bf16x8 __attribute__((ext_vector_type(8)));
typedef float f32x4 __attribute__((ext_vector_type(4)));
typedef unsigned u32x4 __attribute__((ext_vector_type(4)));
constexpr int BM = 256, BK = 64, HALF = 128, HTB = HALF * BK * 2  , STAGE_BYTES = 8 * HTB, NXCD = 8, WGM = 8;

__host__ __device__ __forceinline__ int lds_byte(int r, int c) { const int st = (r >> 4) * 2 + (c >> 5), rr = r & 15, cc = c & 31, ob = rr * 64 + cc * 2; return st * 1024 + (ob ^ (((ob >> 9) & 1) << 5)); }
__host__ __device__ __forceinline__ void stage_rc(int b, int& R, int& C) { const int st = b / 1024, sb = b % 1024, swz = sb ^ (((sb >> 9) & 1) << 5); R = (st >> 1) * 16 + swz / 64; C = (st & 1) * 32 + (swz % 64) / 2; }
__host__ __device__ __forceinline__ int perm32(int rho) { const int n = rho >> 4, i = rho & 15; return 8 * (i >> 2) + 4 * n + (i & 3); }

struct Unit { int pm, pn; };
struct Gemm { const bf16_t* A; const bf16_t* Bt; int M, N, K; };

template <int WG  > struct StaticOrderT {
    int nM, nN, nwg, G, c;
    __host__ __device__ void init(int M, int N, int G_, int c_) { nM = M / BM; nN = N / BM; nwg = nM * nN; G = G_; c = c_; }
    __host__ __device__ bool next(int i, Unit& u) const {
        const long L = (long)i * G + c; if (L >= nwg) return false;
        int wgid = (int)L; { const int q = nwg / NXCD, r = nwg % NXCD, xcd = wgid % NXCD, off = wgid / NXCD; wgid = (xcd < r ? xcd * (q + 1) : r * (q + 1) + (xcd - r) * q) + off; }
        const int nig = WG * nN, gid = wgid / nig, fm = gid * WG, gsz = (nM - fm) < WG ? (nM - fm) : WG;
        u.pm = fm + ((wgid % nig) % gsz); u.pn = (wgid % nig) / gsz; return true;
    }
    __device__ __forceinline__ void a_ready(const Unit&) const {}
    __device__ __forceinline__ void done(const Unit&) const {}
};
typedef StaticOrderT<WGM> StaticOrder;
#ifndef WG_GI
#define WG_GI 4
#endif
#ifndef WG_KV
#define WG_KV 4
#endif
#ifndef WG_Q
#define WG_Q 4
#endif
#ifndef WG_F13
#define WG_F13 4
#endif
#ifndef WG_R
#define WG_R 4
#endif
#ifndef WG_F2
#define WG_F2 4
#endif
typedef StaticOrderT<WG_GI> ORD_GI; typedef StaticOrderT<WG_KV> ORD_KV; typedef StaticOrderT<WG_Q> ORD_Q; typedef StaticOrderT<WG_F13> ORD_F13; typedef StaticOrderT<WG_R> ORD_R; typedef StaticOrderT<WG_F2> ORD_F2;
__device__ __forceinline__ unsigned cvt_pk_bf16(float lo, float hi) { unsigned r; asm volatile("v_cvt_pk_bf16_f32 %0, %1, %2" : "=v"(r) : "v"(lo), "v"(hi)); return r; }
typedef unsigned long long ssq_t;
constexpr float SSQ_SCALE = 65536.0f;
__device__ __forceinline__ ssq_t ssq_fix(float s) { return (ssq_t)(s * SSQ_SCALE + 0.5f); }
__device__ __forceinline__ float rstd_of(ssq_t ssq) { return __builtin_amdgcn_rsqf((float)ssq * (1.0f / (SSQ_SCALE * D)) + EPS); }
__device__ __forceinline__ u32x4 pack8(const f32x4& v0, const f32x4& v1) { u32x4 w; w.x = cvt_pk_bf16(v0[0], v0[1]); w.y = cvt_pk_bf16(v0[2], v0[3]); w.z = cvt_pk_bf16(v1[0], v1[1]); w.w = cvt_pk_bf16(v1[2], v1[3]); return w; }
__device__ __forceinline__ float sq4(const f32x4& o) { return (o[0] * o[0] + o[1] * o[1]) + (o[2] * o[2] + o[3] * o[3]); }

__device__ __forceinline__ void unpack8(const u32x4& w, f32x4& lo, f32x4& hi) {
    lo[0] = __uint_as_float(w.x << 16); lo[1] = __uint_as_float(w.x & 0xffff0000u); lo[2] = __uint_as_float(w.y << 16); lo[3] = __uint_as_float(w.y & 0xffff0000u);
    hi[0] = __uint_as_float(w.z << 16); hi[1] = __uint_as_float(w.z & 0xffff0000u); hi[2] = __uint_as_float(w.w << 16); hi[3] = __uint_as_float(w.w & 0xffff0000u); }
__device__ __forceinline__ void resid_body(const f32x4 (&acc)[2][2][4][2], int row0  , int col0  , int fq,
                                           bf16_t* __restrict__ x, const float* __restrict__ gvec, bf16_t* __restrict__ xg, const float* __restrict__ gm, bf16_t* __restrict__ xkv, const float* __restrict__ gkv, ssq_t* __restrict__ ssq) {
#pragma unroll
    for (int ai = 0; ai < 2; ++ai) { const int bb = row_bb(row0 + ai * HALF);
        f32x4 g[2][2], q[2][2]; u32x4 xw[4][2];
#pragma unroll
        for (int bj = 0; bj < 2; ++bj)
#pragma unroll
            for (int n = 0; n < 2; ++n) { g[bj][n] = *(const f32x4*)(gvec + (size_t)bb * MODW + col0 + bj * HALF + 4 * n); q[bj][n] = xg ? *(const f32x4*)(gm + (size_t)bb * D + col0 + bj * HALF + 4 * n) : (f32x4){0.f, 0.f, 0.f, 0.f}; }
#pragma unroll
        for (int m = 0; m < 4; ++m)
#pragma unroll
            for (int bj = 0; bj < 2; ++bj) xw[m][bj] = *(const u32x4*)(x + (size_t)(row0 + ai * HALF + m * 16) * XPITCH + col0 + bj * HALF);
        asm volatile("s_waitcnt vmcnt(0)" ::: "memory");
#pragma unroll
        for (int m = 0; m < 4; ++m) { const int row = row0 + ai * HALF + m * 16; float s = 0.f;
#pragma unroll
            for (int bj = 0; bj < 2; ++bj) { f32x4 o0, o1; unpack8(xw[m][bj], o0, o1); o0 = o0 + g[bj][0] * acc[ai][bj][m][0]; o1 = o1 + g[bj][1] * acc[ai][bj][m][1];
                const u32x4 pw = pack8(o0, o1); *(u32x4*)(x + (size_t)row * XPITCH + col0 + bj * HALF) = pw;
                unpack8(pw, o0, o1);
                s += sq4(o0) + sq4(o1);
                if (xg) *(u32x4*)(xg + (size_t)row * D + col0 + bj * HALF) = pack8(o0 * q[bj][0], o1 * q[bj][1]);
                if (xkv) *(u32x4*)(xkv + (size_t)row * D + col0 + bj * HALF) = pack8(o0 * *(const f32x4*)(gkv + col0 + bj * HALF), o1 * *(const f32x4*)(gkv + col0 + bj * HALF + 4)); }
            s += __int_as_float(__builtin_amdgcn_ds_swizzle(__float_as_int(s), 0x401f));
            { auto r2 = __builtin_amdgcn_permlane32_swap(__float_as_uint(s), __float_as_uint(s), false, false); s = __uint_as_float(r2[0]) + __uint_as_float(r2[1]); }
            if (fq == 0) __hip_atomic_fetch_add(ssq + row, ssq_fix(s), __ATOMIC_RELAXED, __HIP_MEMORY_SCOPE_AGENT); }
    }
}
struct EpiResidP {
    static constexpr bool PERM = true, AFTER_DRAIN = false;
    bf16_t* x; const float* gvec;
    bf16_t* xg; const float* gm;
    bf16_t* xkv; const float* gkv;
    ssq_t* ssq;
    __device__ __forceinline__ void operator()(const f32x4 (&acc)[2][2][4][2], const Unit& u, int wr, int wc, int fr, int fq) const {
        resid_body(acc, u.pm * BM + wr * 64 + fr, u.pn * BM + wc * 32 + 8 * fq, fq, x, gvec, xg, gm, xkv, gkv, ssq);
    }
};
__device__ __forceinline__ void gatein_body(const f32x4 (&acc)[2][2][4][2], int row0, int n0  , bool isx, bf16_t* __restrict__ gate, bf16_t* __restrict__ xb, float* __restrict__ convp, float* __restrict__ convs,
                                            const ssq_t* __restrict__ ssq, const float* __restrict__ shw) {
    const int col0 = n0 - (isx ? D : 0);
    ssq_t rs[2][4]; f32x4 sh[2][2][2];
#pragma unroll
    for (int ai = 0; ai < 2; ++ai) { const int bb = row_bb(row0 + ai * HALF);
#pragma unroll
        for (int m = 0; m < 4; ++m) rs[ai][m] = ssq[row0 + ai * HALF + m * 16];
#pragma unroll
        for (int bj = 0; bj < 2; ++bj)
#pragma unroll
            for (int n = 0; n < 2; ++n) sh[ai][bj][n] = *(const f32x4*)(shw + (size_t)bb * (2 * D) + n0 + bj * HALF + 4 * n); }
#pragma unroll
    for (int ai = 0; ai < 2; ++ai)
#pragma unroll
        for (int m = 0; m < 4; ++m) { const int row = row0 + ai * HALF + m * 16; const float r = rstd_of(rs[ai][m]);
            float* cdst = nullptr;
            if (isx) { if (row < TP) { const int b = row >> 11, t = row & (PS - 1); if (t >= PS - 3) cdst = convp + ((size_t)b * 3 + (t - (PS - 3))) * D; }
                       else { const int mm = row - TP, b = mm >> 6, t = mm & (SS - 1); if (t >= SS - 3) cdst = convs + ((size_t)b * 3 + (t - (SS - 3))) * D; } }
#pragma unroll
            for (int bj = 0; bj < 2; ++bj) { f32x4 v0 = acc[ai][bj][m][0] * r + sh[ai][bj][0], v1 = acc[ai][bj][m][1] * r + sh[ai][bj][1]; const int c = col0 + bj * HALF;
                if (!isx) {
                    v0 = gelu_tanh4(v0); v1 = gelu_tanh4(v1);
                    *(u32x4*)(gate + (size_t)row * D + c) = pack8(v0, v1);
                } else {
                    *(u32x4*)(xb + (size_t)row * D + c) = pack8(v0, v1);
                    if (cdst) { *(f32x4*)(cdst + c) = v0; *(f32x4*)(cdst + c + 4) = v1; }
                } } }
}
struct EpiGateInP {
    static constexpr bool PERM = true, AFTER_DRAIN = false;
    bf16_t* gate; bf16_t* xb; float* convp; float* convs; const ssq_t* ssq; const float* shw;
    __device__ __forceinline__ void operator()(const f32x4 (&acc)[2][2][4][2], const Unit& u, int wr, int wc, int fr, int fq) const {
        gatein_body(acc, u.pm * BM + wr * 64 + fr, u.pn * BM + wc * 32 + 8 * fq, u.pn >= 8, gate, xb, convp, convs, ssq, shw);
    }
};
__device__ __forceinline__ void ffn13_body(const f32x4 (&acc)[2][2][4][2], int row0, int n0, int hcol0, bf16_t* __restrict__ hid, const ssq_t* __restrict__ ssq, const float* __restrict__ shw) {
    ssq_t rs[2][4]; f32x4 sh[2][2][2];
#pragma unroll
    for (int ai = 0; ai < 2; ++ai) { const int bb = row_bb(row0 + ai * HALF);
#pragma unroll
        for (int m = 0; m < 4; ++m) rs[ai][m] = ssq[row0 + ai * HALF + m * 16];
#pragma unroll
        for (int bj = 0; bj < 2; ++bj)
#pragma unroll
            for (int n = 0; n < 2; ++n) sh[ai][bj][n] = *(const f32x4*)(shw + (size_t)bb * (2 * DFF) + n0 + bj * HALF + 4 * n); }
#pragma unroll
    for (int ai = 0; ai < 2; ++ai)
#pragma unroll
        for (int m = 0; m < 4; ++m) { const int row = row0 + ai * HALF + m * 16; const float r = rstd_of(rs[ai][m]);
            const f32x4 a0 = acc[ai][0][m][0] * r + sh[ai][0][0], a1 = acc[ai][0][m][1] * r + sh[ai][0][1], b0 = acc[ai][1][m][0] * r + sh[ai][1][0], b1 = acc[ai][1][m][1] * r + sh[ai][1][1];
            const f32x4 h0 = a0 * sigmoid4(a0) * b0, h1 = a1 * sigmoid4(a1) * b1;
            *(u32x4*)(hid + (size_t)row * DFF + hcol0) = pack8(h0, h1); }
}
struct EpiFfn13P {
    static constexpr bool PERM = true, AFTER_DRAIN = false;
    bf16_t* hid; const ssq_t* ssq; const float* shw;
    __device__ __forceinline__ void operator()(const f32x4 (&acc)[2][2][4][2], const Unit& u, int wr, int wc, int fr, int fq) const {
        ffn13_body(acc, u.pm * BM + wr * 64 + fr, u.pn * BM + wc * 32 + 8 * fq, u.pn * HALF + wc * 32 + 8 * fq, hid, ssq, shw);
    }
};
__device__ __forceinline__ void kv_body(const f32x4 (&acc)[2][2][4][2], int row0, int col0, bool isv, bf16_t* __restrict__ kvp  , bf16_t* __restrict__ kvs  , float* __restrict__ out, const ssq_t* __restrict__ ssq) {
    ssq_t rs[2][4];
#pragma unroll
    for (int ai = 0; ai < 2; ++ai)
#pragma unroll
        for (int m = 0; m < 4; ++m) rs[ai][m] = ssq[row0 + ai * HALF + m * 16];
#pragma unroll
    for (int ai = 0; ai < 2; ++ai)
#pragma unroll
        for (int m = 0; m < 4; ++m) { const int row = row0 + ai * HALF + m * 16; const float r = rstd_of(rs[ai][m]);
            float* fdst = nullptr; bf16_t* dst;
            if (row < TP) { const int b = row >> 11, t = row & (PS - 1); dst = kvp + (size_t)row * D; if (t >= PS - LEFT) fdst = out + (isv ? O_VP : O_KP) + ((size_t)b * LEFT + (t - (PS - LEFT))) * D; }
            else { const int mm = row - TP, b = mm >> 6, t = mm & (SS - 1); dst = kvs + ((size_t)b * BAND + LEFT + t) * D; fdst = out + (isv ? O_VS : O_KS) + (size_t)mm * D; }
#pragma unroll
            for (int bj = 0; bj < 2; ++bj) { const f32x4 v0 = acc[ai][bj][m][0] * r, v1 = acc[ai][bj][m][1] * r; const int c = col0 + bj * HALF;
                *(u32x4*)(dst + c) = pack8(v0, v1);
                if (fdst) { *(f32x4*)(fdst + c) = v0; *(f32x4*)(fdst + c + 4) = v1; } } }
}
struct EpiKVP {
    static constexpr bool PERM = true, AFTER_DRAIN = false;
    bf16_t* kb; bf16_t* vb; bf16_t* ks; bf16_t* vs; float* out; const ssq_t* ssq;
    __device__ __forceinline__ void operator()(const f32x4 (&acc)[2][2][4][2], const Unit& u, int wr, int wc, int fr, int fq) const {
        const bool isv = u.pn >= 8;
        kv_body(acc, u.pm * BM + wr * 64 + fr, (isv ? u.pn - 8 : u.pn) * BM + wc * 32 + 8 * fq, isv, isv ? vb : kb, isv ? vs : ks, out, ssq);
    }
};
__device__ __forceinline__ void q_body(const f32x4 (&acc)[2][2][4][2], int row0, int col0, bf16_t* __restrict__ q, const ssq_t* __restrict__ ssq, const float* __restrict__ shw) {
    ssq_t rs[2][4]; f32x4 sh[2][2][2];
#pragma unroll
    for (int ai = 0; ai < 2; ++ai) { const int bb = row_bb(row0 + ai * HALF);
#pragma unroll
        for (int m = 0; m < 4; ++m) rs[ai][m] = ssq[row0 + ai * HALF + m * 16];
#pragma unroll
        for (int bj = 0; bj < 2; ++bj)
#pragma unroll
            for (int n = 0; n < 2; ++n) sh[ai][bj][n] = *(const f32x4*)(shw + (size_t)bb * D + col0 + bj * HALF + 4 * n); }
#pragma unroll
    for (int ai = 0; ai < 2; ++ai)
#pragma unroll
        for (int m = 0; m < 4; ++m) { const int row = row0 + ai * HALF + m * 16; const float r = rstd_of(rs[ai][m]);
#pragma unroll
            for (int bj = 0; bj < 2; ++bj) *(u32x4*)(q + (size_t)row * D + col0 + bj * HALF) = pack8(acc[ai][bj][m][0] * r + sh[ai][bj][0], acc[ai][bj][m][1] * r + sh[ai][bj][1]); }
}
struct EpiNull {
    static constexpr bool PERM = true, AFTER_DRAIN = false;
    __device__ __forceinline__ void operator()(const f32x4 (&acc)[2][2][4][2], const Unit& u, int wr, int wc, int fr, int fq) const {
#pragma unroll
        for (int ai = 0; ai < 2; ++ai)
#pragma unroll
            for (int bj = 0; bj < 2; ++bj) asm volatile("" :: "v"(acc[ai][bj][0][0]), "v"(acc[ai][bj][0][1]), "v"(acc[ai][bj][1][0]), "v"(acc[ai][bj][1][1]), "v"(acc[ai][bj][2][0]), "v"(acc[ai][bj][2][1]), "v"(acc[ai][bj][3][0]), "v"(acc[ai][bj][3][1])); }
};
struct EpiQP {
    static constexpr bool PERM = true, AFTER_DRAIN = false;
    bf16_t* q; const ssq_t* ssq; const float* shw;
    __device__ __forceinline__ void operator()(const f32x4 (&acc)[2][2][4][2], const Unit& u, int wr, int wc, int fr, int fq) const {
        q_body(acc, u.pm * BM + wr * 64 + fr, u.pn * BM + wc * 32 + 8 * fq, q, ssq, shw);
    }
};

template <class Epi, class Sched, bool ALIGN_EPI = false, bool SP2 = false, int AUXA = 0, int AUXB = 0  >
__device__ __forceinline__ void gemm_phase(PG8_LAS unsigned char* lds, const Gemm g, const Sched& S, const Epi& E, int tid_in) {
    int tid_ = tid_in; asm volatile("" : "+v"(tid_));
    const int tid = tid_, wid = __builtin_amdgcn_readfirstlane(tid >> 6), lane = tid & 63, wr = wid >> 2, wc = wid & 3, fr = lane & 15, fq = lane >> 4;
    const int K = g.K, nt = K / BK;
    unsigned voffA[2], voffB[2];
#pragma unroll
    for (int i = 0; i < 2; ++i) { int R, C; stage_rc(tid * 16 + i * 8192, R, C); const int Rb = Epi::PERM ? ((R & ~31) + perm32(R & 31)) : R;
        voffA[i] = (unsigned)(R * K + C) * 2u; voffB[i] = (unsigned)(Rb * K + C) * 2u; }
    const size_t kstep = (size_t)(BK * 2);
    const size_t hstep = (size_t)HALF * K * 2;
    const size_t tstep = 2 * hstep;
    const unsigned ldsw = (unsigned)wid * 1024u;
    const int aoff = lds_byte(wr * 64 + fr, fq * 8), boff = lds_byte(wc * 32 + fr, fq * 8);
#define PG8_SA(b, h) (((b) * 2 + (h)) * HTB)
#define PG8_SB(b, h) ((4 + (b) * 2 + (h)) * HTB)
    constexpr int AUX_voffA = AUXA, AUX_voffB = AUXB;
#define PG8_STAGE(bufoff, gbase, voff) do { _Pragma("unroll") for (int _i = 0; _i < 2; ++_i) \
        __builtin_amdgcn_global_load_lds((const unsigned*)((const char*)(gbase) + (voff)[_i]), (PG8_LAS unsigned*)(lds + (bufoff) + ldsw + _i * 8192), 16, 0, AUX_##voff); } while (0)
#define PG8_LDA(dst, b, h) do { _Pragma("unroll") for (int m = 0; m < 4; ++m) _Pragma("unroll") for (int k = 0; k < 2; ++k) dst[m][k] = *(const PG8_LAS bf16x8*)(lds + PG8_SA(b, h) + aoff + m * 2048 + k * 1024); } while (0)
#define PG8_LDB(dst, b, h) do { _Pragma("unroll") for (int n = 0; n < 2; ++n) _Pragma("unroll") for (int k = 0; k < 2; ++k) dst[n][k] = *(const PG8_LAS bf16x8*)(lds + PG8_SB(b, h) + boff + n * 2048 + k * 1024); } while (0)
#define PG8_MMA(ai, bj, At, Bt) do { __builtin_amdgcn_s_setprio(1); _Pragma("unroll") for (int m = 0; m < 4; ++m) _Pragma("unroll") for (int n = 0; n < 2; ++n) _Pragma("unroll") for (int k = 0; k < 2; ++k) \
        acc[ai][bj][m][n] = __builtin_amdgcn_mfma_f32_16x16x32_bf16(Bt[n][k], At[m][k], acc[ai][bj][m][n], 0, 0, 0); __builtin_amdgcn_s_setprio(0); } while (0)
#define PG8_WAIT_V(n) asm volatile("s_waitcnt vmcnt(" #n ")" ::: "memory")
#define PG8_WAIT_L(n) asm volatile("s_waitcnt lgkmcnt(" #n ")" ::: "memory")
#define PG8_BAR __builtin_amdgcn_s_barrier()
#define PG8_SCHED __builtin_amdgcn_sched_barrier(0)
    Unit cur, nxt; int ui = 0;
    if (!S.next(0, cur)) return;
    f32x4 acc[2][2][4][2];
#pragma unroll
    for (int a = 0; a < 2; ++a)
#pragma unroll
        for (int b = 0; b < 2; ++b)
#pragma unroll
            for (int m = 0; m < 4; ++m)
#pragma unroll
                for (int n = 0; n < 2; ++n) acc[a][b][m][n] = (f32x4){0.f, 0.f, 0.f, 0.f};
    bf16x8 At[4][2], B0[2][2], B1[2][2];
    const char* cA = (const char*)g.A + (size_t)cur.pm * tstep; const char* cB = (const char*)g.Bt + (size_t)cur.pn * tstep;
    S.a_ready(cur);
    if constexpr (SP2) {
        PG8_STAGE(PG8_SB(0, 0), cB, voffB); PG8_STAGE(PG8_SB(0, 1), cB + hstep, voffB); PG8_STAGE(PG8_SA(0, 0), cA, voffA); PG8_STAGE(PG8_SA(0, 1), cA + hstep, voffA);
        if (wr == 1) PG8_BAR;
        PG8_WAIT_V(2); PG8_BAR;
        PG8_STAGE(PG8_SB(1, 0), cB + kstep, voffB); PG8_STAGE(PG8_SA(1, 0), cA + kstep, voffA); PG8_STAGE(PG8_SB(1, 1), cB + hstep + kstep, voffB);
        PG8_WAIT_V(6); PG8_BAR;
    } else {
        PG8_STAGE(PG8_SB(0, 0), cB, voffB); PG8_STAGE(PG8_SA(0, 0), cA, voffA); PG8_STAGE(PG8_SB(0, 1), cB + hstep, voffB); PG8_STAGE(PG8_SA(0, 1), cA + hstep, voffA);
        if (wr == 1) PG8_BAR;
        PG8_WAIT_V(4); PG8_BAR;
        PG8_STAGE(PG8_SB(1, 0), cB + kstep, voffB); PG8_STAGE(PG8_SA(1, 0), cA + kstep, voffA); PG8_STAGE(PG8_SB(1, 1), cB + hstep + kstep, voffB);
        PG8_WAIT_V(6); PG8_BAR;
    }
    for (;;) {
        const bool has_next = S.next(ui + 1, nxt);
        const char* nA = has_next ? (const char*)g.A + (size_t)nxt.pm * tstep : cA; const char* nB = has_next ? (const char*)g.Bt + (size_t)nxt.pn * tstep : cB;
        for (int t = 0; t < nt; t += 2) {
            const bool last = (t == nt - 2);
            const char* a1 = cA + (size_t)(t + 1) * kstep;
            const char* a2 = last ? nA : cA + (size_t)(t + 2) * kstep; const char* b2 = last ? nB : cB + (size_t)(t + 2) * kstep;
            const char* a3 = a2 + kstep; const char* b3 = b2 + kstep;
            if (last && has_next) S.a_ready(nxt);
            if constexpr (SP2) {
            PG8_LDB(B0, 0, 0); PG8_LDB(B1, 0, 1); PG8_SCHED; PG8_LDA(At, 0, 0); PG8_STAGE(PG8_SA(1, 1), a1 + hstep, voffA);
            PG8_WAIT_V(8); PG8_WAIT_L(0); PG8_BAR; PG8_MMA(0, 0, At, B0); PG8_MMA(0, 1, At, B1); PG8_BAR; PG8_SCHED;
            PG8_LDA(At, 0, 1); PG8_STAGE(PG8_SB(0, 0), b2, voffB); PG8_STAGE(PG8_SB(0, 1), b2 + hstep, voffB); PG8_STAGE(PG8_SA(0, 0), a2, voffA);
            PG8_WAIT_V(8); PG8_WAIT_L(0); PG8_BAR; PG8_MMA(1, 0, At, B0); PG8_MMA(1, 1, At, B1); PG8_BAR; PG8_SCHED;
            PG8_LDB(B0, 1, 0); PG8_LDB(B1, 1, 1); PG8_SCHED; PG8_LDA(At, 1, 0); PG8_STAGE(PG8_SA(0, 1), a2 + hstep, voffA);
            PG8_WAIT_V(8); PG8_WAIT_L(0); PG8_BAR; PG8_MMA(0, 0, At, B0); PG8_MMA(0, 1, At, B1); PG8_BAR; PG8_SCHED;
            PG8_LDA(At, 1, 1); PG8_STAGE(PG8_SB(1, 0), b3, voffB); PG8_STAGE(PG8_SB(1, 1), b3 + hstep, voffB); PG8_STAGE(PG8_SA(1, 0), a3, voffA);
            PG8_WAIT_V(8); PG8_WAIT_L(0); PG8_BAR; PG8_MMA(1, 0, At, B0); PG8_MMA(1, 1, At, B1); PG8_BAR; PG8_SCHED;
            } else {
            PG8_LDB(B0, 0, 0); PG8_SCHED; PG8_LDA(At, 0, 0); PG8_STAGE(PG8_SA(1, 1), a1 + hstep, voffA);
            PG8_WAIT_L(8); PG8_BAR; PG8_WAIT_L(0); PG8_MMA(0, 0, At, B0); PG8_BAR; PG8_SCHED;
            PG8_LDB(B1, 0, 1); PG8_STAGE(PG8_SB(0, 0), b2, voffB);
            PG8_BAR; PG8_WAIT_L(0); PG8_MMA(0, 1, At, B1); PG8_BAR;
            PG8_LDA(At, 0, 1); PG8_STAGE(PG8_SA(0, 0), a2, voffA);
            PG8_BAR; PG8_WAIT_L(0); PG8_MMA(1, 0, At, B0); PG8_BAR; PG8_SCHED;
            PG8_STAGE(PG8_SB(0, 1), b2 + hstep, voffB);
            PG8_WAIT_V(6); PG8_BAR; PG8_MMA(1, 1, At, B1); PG8_BAR;
            PG8_LDB(B0, 1, 0); PG8_SCHED; PG8_LDA(At, 1, 0); PG8_STAGE(PG8_SA(0, 1), a2 + hstep, voffA);
            PG8_WAIT_L(8); PG8_BAR; PG8_WAIT_L(0); PG8_MMA(0, 0, At, B0); PG8_BAR; PG8_SCHED;
            PG8_LDB(B1, 1, 1); PG8_STAGE(PG8_SB(1, 0), b3, voffB);
            PG8_BAR; PG8_WAIT_L(0); PG8_MMA(0, 1, At, B1); PG8_BAR;
            PG8_LDA(At, 1, 1); PG8_STAGE(PG8_SA(1, 0), a3, voffA);
            PG8_BAR; PG8_WAIT_L(0); PG8_MMA(1, 0, At, B0); PG8_BAR; PG8_SCHED;
            PG8_STAGE(PG8_SB(1, 1), b3 + hstep, voffB);
            PG8_WAIT_V(6); PG8_BAR; PG8_MMA(1, 1, At, B1); PG8_BAR;
            }
        }
        if constexpr (ALIGN_EPI) { if (wr == 0) PG8_BAR; }
        if constexpr (!Epi::AFTER_DRAIN) { E(acc, cur, wr, wc, fr, fq); S.done(cur); }
        if (!has_next) break;
#pragma unroll
        for (int a = 0; a < 2; ++a)
#pragma unroll
            for (int b = 0; b < 2; ++b)
#pragma unroll
                for (int m = 0; m < 4; ++m)
#pragma unroll
                    for (int n = 0; n < 2; ++n) acc[a][b][m][n] = (f32x4){0.f, 0.f, 0.f, 0.f};
        cur = nxt; cA = nA; cB = nB; ++ui;
        if constexpr (ALIGN_EPI) { if (wr == 1) PG8_BAR; }
    }
    PG8_WAIT_V(0);
    if constexpr (!ALIGN_EPI) { if (wr == 0) PG8_BAR; }
    PG8_BAR;
    if constexpr (Epi::AFTER_DRAIN) { E.fused(acc, cur, wr, wc, fr, fq, lds, wid, lane); S.done(cur); }
#undef PG8_SA
#undef PG8_SB
#undef PG8_STAGE
#undef PG8_LDA
#undef PG8_LDB
#undef PG8_MMA
#undef PG8_WAIT_V
#undef PG8_WAIT_L
#undef PG8_BAR
#undef PG8_SCHED
}
}
#undef LAS
#define LAS __attribute__((address_space(3)))
#define XB_TMO      128
#define XB_XCNT(j)  (256  + 64 * (j))
#define XB_XSUB(j)  (1280 + 64 * (j))
#define XB_XGEN(j)  (2304 + 64 * (j))
#define XB_TOP      3328
#define XB_TOPGEN   3392
#define XCD_BAR_WORDS 3456
#define XB_SPIN_CAP (1u << 22)

__device__ __forceinline__ unsigned xb_ld(unsigned* p)              { return __hip_atomic_load(p, __ATOMIC_RELAXED, __HIP_MEMORY_SCOPE_AGENT); }
__device__ __forceinline__ unsigned xb_add(unsigned* p, unsigned v) { return __hip_atomic_fetch_add(p, v, __ATOMIC_RELAXED, __HIP_MEMORY_SCOPE_AGENT); }
__device__ __forceinline__ unsigned xb_xcc_id() { return (unsigned)__builtin_amdgcn_s_getreg((3 << 11) | 20) & 0xFu; }
#define XB_SPIN(cond, bar) do { unsigned _sp = 0; while (cond) { __builtin_amdgcn_s_sleep(1); \
    if ((++_sp & 255u) == 0u) { if (xb_ld(&(bar)[XB_TMO])) break; if (_sp > XB_SPIN_CAP) { atomicAdd(&(bar)[XB_TMO], 1u); break; } } } } while (0)

struct XcdBarrier {
    unsigned* bar; unsigned x;
    volatile LAS unsigned* st;
};

__device__ __forceinline__ XcdBarrier xcd_barrier_post(unsigned* bar, volatile LAS unsigned* st) {
    XcdBarrier b; b.bar = bar; b.x = xb_xcc_id(); b.st = st;
    if (threadIdx.x == 0) (void)xb_add(&bar[XB_XCNT(b.x)], 1u);
    return b;
}
__device__ __forceinline__ void xcd_barrier_complete(unsigned* bar, unsigned x, unsigned& nloc, unsigned& nx) {
    const unsigned G = gridDim.x * gridDim.y * gridDim.z;
    unsigned sum, cnt, mine, sp = 0u;
    for (;;) {
        sum = 0u; cnt = 0u; mine = 0u;
#pragma unroll
        for (unsigned j = 0; j < 16; ++j) { const unsigned c = xb_ld(&bar[XB_XCNT(j)]); sum += c; cnt += (c > 0u) ? 1u : 0u; mine = (j == x) ? c : mine; }
        if (sum == G) break;
        __builtin_amdgcn_s_sleep(1);
        if ((++sp & 255u) == 0u) { if (xb_ld(&bar[XB_TMO])) break; if (sp > XB_SPIN_CAP) { atomicAdd(&bar[XB_TMO], 1u); break; } }
    }
    nloc = mine > 0u ? mine : 1u; nx = cnt > 0u ? cnt : 1u;
}

__device__ __forceinline__ void xcd_barrier(const XcdBarrier& b) {
    asm volatile("s_waitcnt vmcnt(0)" ::: "memory");
    __syncthreads();
    if (threadIdx.x == 0) {
        unsigned* bar = b.bar;
        __builtin_amdgcn_s_waitcnt(0);
        unsigned nloc = b.st[0], nx = b.st[1];
        if (nloc == 0u) { xcd_barrier_complete(bar, b.x, nloc, nx); b.st[0] = nloc; b.st[1] = nx; }
        const unsigned old = xb_add(&bar[XB_XSUB(b.x)], 1u);
        const unsigned gen = old / nloc;
        if (old + 1u == (gen + 1u) * nloc) {
            __builtin_amdgcn_fence(__ATOMIC_RELEASE, "agent");
            asm volatile("s_waitcnt vmcnt(0)" ::: "memory");
            const unsigned og = xb_add(&bar[XB_TOP], 1u);
            const unsigned tg = og / nx;
            if (og + 1u == (tg + 1u) * nx) xb_add(&bar[XB_TOPGEN], 1u);
            else XB_SPIN(xb_ld(&bar[XB_TOPGEN]) == tg, bar);
            __builtin_amdgcn_fence(__ATOMIC_ACQUIRE, "agent");
            xb_add(&bar[XB_XGEN(b.x)], 1u);
            asm volatile("s_waitcnt vmcnt(0)" ::: "memory");
        } else {
            XB_SPIN(xb_ld(&bar[XB_XGEN(b.x)]) == gen, bar);
            __builtin_amdgcn_fence(__ATOMIC_ACQUIRE, "agent");
            asm volatile("s_waitcnt vmcnt(0)" ::: "memory");
        }
    }
    __syncthreads();
}
namespace att {
typedef short s16x4 __attribute__((ext_vector_type(4)));
typedef float f32x16 __attribute__((ext_vector_type(16)));
constexpr int SHM_V = 16384, SHM_K = 16384;
constexpr int OFF_V = 0, OFF_K = 2 * SHM_V, OFF_WS = OFF_K + 2 * SHM_K, OFF_TB = OFF_WS + 8 * 64 * 4;
constexpr float SCALE = 0.088388347648318440f, LOG2E = 1.4426950408889634f, CS = SCALE * LOG2E;
constexpr float THR2 = 8.0f * LOG2E;
#define KSWZ(row, colB) ((row) * 256 + ((colB) ^ (((row) & 7) << 4)))
#define SBAR() __builtin_amdgcn_sched_barrier(0)
__device__ __forceinline__ int crow(int r, int hi) { return (r & 3) + 8 * (r >> 2) + 4 * hi; }
__device__ __forceinline__ unsigned cvtpk(float lo, float hi) { unsigned r; asm volatile("v_cvt_pk_bf16_f32 %0, %1, %2" : "=v"(r) : "v"(lo), "v"(hi)); return r; }
__device__ __forceinline__ void qkt(f32x16& p0, f32x16& p1, const char* Ks, const bf16x8* qr, int r32, int hi) {
  p0 = f32x16{}; p1 = f32x16{};
#pragma unroll
  for (int d0 = 0; d0 < 8; ++d0) { const int cb = (d0 * 16 + hi * 8) * 2;
    const bf16x8 b0 = *reinterpret_cast<const bf16x8*>(Ks + KSWZ(r32, cb));
    const bf16x8 b1 = *reinterpret_cast<const bf16x8*>(Ks + KSWZ(32 + r32, cb));
    p0 = __builtin_amdgcn_mfma_f32_32x32x16_bf16(b0, qr[d0], p0, 0, 0, 0);
    p1 = __builtin_amdgcn_mfma_f32_32x32x16_bf16(b1, qr[d0], p1, 0, 0, 0); }
}
__device__ __forceinline__ int v_st(int k, int c) { const int kk = (k & ~0xC) | ((k & 4) << 1) | ((k & 8) >> 1); return ((kk >> 3) * 4 + (c >> 5)) * 512 + ((kk & 7) * 32 + (c & 31)) * 2; }
__device__ __forceinline__ int v_rd_base(int lane) { return ((lane & 3) << 3) | (((lane >> 2) & 3) << 6) | (((lane >> 4) & 1) << 5) | (((lane >> 5) & 1) << 8); }
constexpr int v_rd_off(int d0, int ks, int half) { return d0 * 512 + ks * 4096 + half * 2048; }
template <int OFF> __device__ __forceinline__ s16x4 tr_read(int vb) { s16x4 r; asm volatile("ds_read_b64_tr_b16 %0, %1 offset:%2" : "=&v"(r) : "v"(vb), "i"(OFF) : "memory"); return r; }
template <int D0> __device__ __forceinline__ void pv_one(f32x16& od, int vb, bf16x8 pa0, bf16x8 pa1, bf16x8 pa2, bf16x8 pa3) {
  const s16x4 l0 = tr_read<v_rd_off(D0, 0, 0)>(vb), h0 = tr_read<v_rd_off(D0, 0, 1)>(vb), l1 = tr_read<v_rd_off(D0, 1, 0)>(vb), h1 = tr_read<v_rd_off(D0, 1, 1)>(vb);
  const s16x4 l2 = tr_read<v_rd_off(D0, 2, 0)>(vb), h2 = tr_read<v_rd_off(D0, 2, 1)>(vb), l3 = tr_read<v_rd_off(D0, 3, 0)>(vb), h3 = tr_read<v_rd_off(D0, 3, 1)>(vb);
  asm volatile("s_waitcnt lgkmcnt(0)" ::: "memory"); SBAR();
#define PK(L, H) (bf16x8){L[0], L[1], L[2], L[3], H[0], H[1], H[2], H[3]}
  od = __builtin_amdgcn_mfma_f32_32x32x16_bf16(pa0, PK(l0, h0), od, 0, 0, 0);
  od = __builtin_amdgcn_mfma_f32_32x32x16_bf16(pa1, PK(l1, h1), od, 0, 0, 0);
  od = __builtin_amdgcn_mfma_f32_32x32x16_bf16(pa2, PK(l2, h2), od, 0, 0, 0);
  od = __builtin_amdgcn_mfma_f32_32x32x16_bf16(pa3, PK(l3, h3), od, 0, 0, 0);
#undef PK
}
__device__ __forceinline__ void band_unit(const bf16_t* __restrict__ Qb, bf16_t* __restrict__ Ob, const bf16_t* __restrict__ Kh, const bf16_t* __restrict__ Vh, const float* __restrict__ relb, int h, int c0, int nw, char* lds, int tid_in) {
  int tid = tid_in; asm volatile("" : "+v"(tid));
  const int wid = __builtin_amdgcn_readfirstlane(tid >> 6), lane = tid & 63, r32 = lane & 31, hi = lane >> 5;
  char* V_lds = lds + OFF_V; char* K_lds = lds + OFF_K;
  float* wsf = (float*)(lds + OFF_WS) + wid * 64; float* li_l = wsf; float* al_l = wsf + 32; float* tb = (float*)(lds + OFF_TB);
  const bool won = wid < nw; const int cw = c0 + (wid >> 1);
  const int t_lo = c0 > 8 ? c0 - 8 : 0, t_hi = c0 + ((nw + 1) >> 1) - 1;
  if (tid < 257) tb[tid] = relb[tid * NH + h] * LOG2E;
  float m_reg = -1e30f, l_reg = 0.f; f32x16 o[4] = {}; bf16x8 qr[8];
  { const bf16_t* Qw = Qb + (size_t)((won ? wid : 0) * 32 + r32) * D + hi * 8;
#pragma unroll
    for (int d0 = 0; d0 < 8; ++d0) qr[d0] = *reinterpret_cast<const bf16x8*>(Qw + d0 * 16); }
  const int sr = tid >> 4, sc = (tid & 15) * 8, vst0 = v_st(sr, sc), vst1 = v_st(32 + sr, sc);
  const int vb0 = (int)(uintptr_t)V_lds + v_rd_base(lane);
  bf16x8 vs0, vs1, ks0, ks1;
#define SLOAD(k0) do { vs0 = *reinterpret_cast<const bf16x8*>(&Vh[(size_t)((k0) + sr) * D + sc]); vs1 = *reinterpret_cast<const bf16x8*>(&Vh[(size_t)((k0) + 32 + sr) * D + sc]); \
    ks0 = *reinterpret_cast<const bf16x8*>(&Kh[(size_t)((k0) + sr) * D + sc]); ks1 = *reinterpret_cast<const bf16x8*>(&Kh[(size_t)((k0) + 32 + sr) * D + sc]); } while (0)
#define SWRITE(b) do { *(bf16x8*)(V_lds + (b) * SHM_V + vst0) = vs0; *(bf16x8*)(V_lds + (b) * SHM_V + vst1) = vs1; const int kc = sc * 2; \
    *(bf16x8*)(K_lds + (b) * SHM_K + KSWZ(sr, kc)) = ks0; *(bf16x8*)(K_lds + (b) * SHM_K + KSWZ(32 + sr, kc)) = ks1; } while (0)
  SLOAD(t_lo * 64); asm volatile("s_waitcnt vmcnt(0)" ::: "memory"); SWRITE(0); __syncthreads();
  for (int t = t_lo; t <= t_hi; ++t) {
    const int buf = (t - t_lo) & 1;
    if (t < t_hi) SLOAD((t + 1) * 64);
    const int dch = cw - t;
    if (won && dch >= 0 && dch <= 8) {
      f32x16 p0, p1;
      qkt(p0, p1, K_lds + buf * SHM_K, qr, r32, hi);
      if (dch >= 3) { const float bc = tb[256];
#pragma unroll
        for (int r = 0; r < 16; ++r) { p0[r] = fmaf(p0[r], CS, bc); p1[r] = fmaf(p1[r], CS, bc); } }
      else { const int base = 64 * dch + 32 * (wid & 1) + r32 - 4 * hi;
#pragma unroll
        for (int r = 0; r < 16; ++r) { const int j0 = (r & 3) + 8 * (r >> 2); int i0 = base - j0, i1 = base - 32 - j0; i0 = (i0 > 128 ? 128 : i0) + 128; i1 = (i1 > 128 ? 128 : i1) + 128;
          p0[r] = fmaf(p0[r], CS, tb[i0]); p1[r] = fmaf(p1[r], CS, tb[i1]); } }
      float pmax = p0[0];
#pragma unroll
      for (int r = 1; r < 16; ++r) pmax = fmaxf(pmax, p0[r]);
#pragma unroll
      for (int r = 0; r < 16; ++r) pmax = fmaxf(pmax, p1[r]);
      { auto rr = __builtin_amdgcn_permlane32_swap(__float_as_uint(pmax), __float_as_uint(pmax), false, false); pmax = fmaxf(__uint_as_float(rr[0]), __uint_as_float(rr[1])); }
      float mn, alpha;
      if (__all(pmax - m_reg <= THR2)) { mn = m_reg; alpha = 1.f; } else { mn = fmaxf(m_reg, pmax); alpha = __builtin_amdgcn_exp2f(m_reg - mn); m_reg = mn; }
      float ps = 0.f;
#pragma unroll
      for (int r = 0; r < 16; ++r) { p0[r] = __builtin_amdgcn_exp2f(p0[r] - mn); p1[r] = __builtin_amdgcn_exp2f(p1[r] - mn); ps += p0[r] + p1[r]; }
      { auto rr = __builtin_amdgcn_permlane32_swap(__float_as_uint(ps), __float_as_uint(ps), false, false); ps = __uint_as_float(rr[0]) + __uint_as_float(rr[1]); }
      l_reg = l_reg * alpha + ps;
      if (__any(alpha < 1.f)) { if (hi == 0) al_l[r32] = alpha; asm volatile("s_waitcnt lgkmcnt(0)" ::: "memory");
#pragma unroll
        for (int d = 0; d < 4; ++d)
#pragma unroll
          for (int r = 0; r < 16; ++r) o[d][r] *= al_l[crow(r, hi)]; }
      bf16x8 pa0, pa1, pa2, pa3;
#define PK4(P, BASE, OUT) do { unsigned a0 = cvtpk(P[BASE + 0], P[BASE + 1]), a1 = cvtpk(P[BASE + 2], P[BASE + 3]); unsigned b0 = cvtpk(P[BASE + 4], P[BASE + 5]), b1 = cvtpk(P[BASE + 6], P[BASE + 7]); \
    auto r0 = __builtin_amdgcn_permlane32_swap(a0, b0, false, false); auto r1 = __builtin_amdgcn_permlane32_swap(a1, b1, false, false); u32x4 w = {r0[0], r1[0], r0[1], r1[1]}; OUT = *reinterpret_cast<bf16x8*>(&w); } while (0)
      PK4(p0, 0, pa0); PK4(p0, 8, pa1); PK4(p1, 0, pa2); PK4(p1, 8, pa3);
#undef PK4
      const int vb = vb0 + buf * SHM_V;
      pv_one<0>(o[0], vb, pa0, pa1, pa2, pa3); pv_one<1>(o[1], vb, pa0, pa1, pa2, pa3); pv_one<2>(o[2], vb, pa0, pa1, pa2, pa3); pv_one<3>(o[3], vb, pa0, pa1, pa2, pa3);
    }
    if (t < t_hi) { asm volatile("s_waitcnt vmcnt(0)" ::: "memory"); SWRITE(buf ^ 1); }
    __syncthreads();
  }
  if (hi == 0) li_l[r32] = l_reg; asm volatile("s_waitcnt lgkmcnt(0)" ::: "memory");
  if (won) {
    char* ost = lds + wid * 8192;
#pragma unroll
    for (int r = 0; r < 16; ++r) { const int orow = crow(r, hi); const float rl = __builtin_amdgcn_rcpf(li_l[orow]);
#pragma unroll
      for (int d0 = 0; d0 < 4; ++d0) *(bf16_t*)(ost + orow * 256 + (d0 * 32 + r32) * 2) = (bf16_t)f2bf(o[d0][r] * rl); }
    asm volatile("s_waitcnt lgkmcnt(0)" ::: "memory");
    bf16_t* Ow = Ob + (size_t)(wid * 32) * D;
#pragma unroll
    for (int k = 0; k < 8; ++k) { const int row = (lane >> 4) + 4 * k, c16 = lane & 15; const u32x4 v = *(const u32x4*)(ost + row * 256 + c16 * 16); *(u32x4*)(Ow + (size_t)row * D + c16 * 8) = v; }
  }
  __syncthreads();
#undef SLOAD
#undef SWRITE
}
#undef KSWZ
#undef SBAR

__device__ __forceinline__ void attn_phase(char* lds, const bf16_t* Q, bf16_t* O, const bf16_t* Kp, const bf16_t* Vp, const bf16_t* Ks, const bf16_t* Vs, const float* relb, int vcu, int G, int tid) {
  for (int bh = vcu; bh < PB * NH; bh += G) { const int b = bh >> 4, h = bh & 15;
    const bf16_t* Kh = Kp + (size_t)b * PS * D + h * HD; const bf16_t* Vh = Vp + (size_t)b * PS * D + h * HD;
    for (int qb = 0; qb < 8; ++qb) band_unit(Q + ((size_t)b * PS + qb * 256) * D + h * HD, O + ((size_t)b * PS + qb * 256) * D + h * HD, Kh, Vh, relb, h, 4 * qb, 8, lds, tid); }
  for (int u = vcu; u < SB * NH; u += G) { const int b = u >> 4, h = u & 15;
    band_unit(Q + ((size_t)TP + (size_t)b * SS) * D + h * HD, O + ((size_t)TP + (size_t)b * SS) * D + h * HD, Ks + (size_t)b * BAND * D + h * HD, Vs + (size_t)b * BAND * D + h * HD, relb, h, 8, 2, lds, tid); }
}
}

namespace rg {
constexpr int XP = 264, GP = 136;
constexpr int OFF_XB = 0, OFF_XC = 35840, OFF_GT = 69632, OFF_CW = 87040;
constexpr float LOG2E = 1.4426950408889634f;
__device__ __forceinline__ float softplus_neg(float l) {
    const float y = __expf(-fabsf(l)); const float lp = y < 0.02f ? y * (1.f - y * (0.5f - y * (0.33333334f - 0.25f * y))) : __logf(1.f + y); return (l > 0.f ? 0.f : -l) + lp; }
__device__ __forceinline__ float neg_expm1(float x) {
    const float s = -x * (1.f + x * (0.5f + x * (0.16666667f + x * (0.041666668f + x * (0.0083333338f + x * 0.0013888889f))))); const float e = 1.f - __expf(x); return x > -0.3f ? s : e; }
__device__ __forceinline__ float neg_expm1_series(float x) { return -x * (1.f + x * (0.5f + x * (0.16666667f + x * (0.041666668f + x * (0.0083333338f + x * 0.0013888889f))))); }
__device__ __forceinline__ float bperm(float v, int addr) { return __int_as_float(__builtin_amdgcn_ds_bpermute(addr, __float_as_int(v))); }
__device__ __forceinline__ bf16x8 cvt8(const float* p) { const f32x4 a = *(const f32x4*)p, b = *(const f32x4*)(p + 4); u32x4 w; w.x = pk2(a[0], a[1]); w.y = pk2(a[2], a[3]); w.z = pk2(b[0], b[1]); w.w = pk2(b[2], b[3]); return *reinterpret_cast<bf16x8*>(&w); }

__device__ __forceinline__ void rg_unit(char* lds, const bf16_t* __restrict__ xb, const bf16_t* __restrict__ gin, bf16_t* __restrict__ hgo, const bf16_t* __restrict__ wai, const float* __restrict__ cw, const float* __restrict__ cb,
                                        const float* __restrict__ b_a, const float* __restrict__ b_i, const float* __restrict__ lam, const float* __restrict__ sconv, const float* __restrict__ h0p, float* __restrict__ rnn_out,
                                        size_t m0, int nchunks, int cbase, int hf, bool pos0, int tid_in) {
    int tid = tid_in; asm volatile("" : "+v"(tid));
    const int wid = __builtin_amdgcn_readfirstlane(tid >> 6), lane = tid & 63, fr = lane & 15, fq = lane >> 4;
    bf16_t* XB = (bf16_t*)(lds + OFF_XB); bf16_t* XC = (bf16_t*)(lds + OFF_XC); bf16_t* GT = (bf16_t*)(lds + OFF_GT); float* CW = (float*)(lds + OFF_CW);
    const int chl = hf * 128 + 16 * wid + fr, ch = cbase + chl, gcol = cbase + hf * 128;
    bf16x8 Bf[2][8];
#pragma unroll
    for (int nt = 0; nt < 2; ++nt)
#pragma unroll
        for (int ks = 0; ks < 8; ++ks) Bf[nt][ks] = *reinterpret_cast<const bf16x8*>(wai + (size_t)(2 * chl + nt) * 256 + 32 * ks + 8 * fq);
    if (tid < 256) {
#pragma unroll
        for (int k = 0; k < 4; ++k) CW[k * 256 + tid] = cw[k * D + cbase + tid];
        CW[4 * 256 + tid] = cb[cbase + tid]; }
    const float ba = b_a[ch], bi = b_i[ch], sp = softplus_neg(lam[ch]), c8l = -8.f * sp * LOG2E, c2 = -16.f * sp;
    float H = h0p ? h0p[ch] : 0.f;
    const bool small_x = __all(c2 > -0.3f);
#pragma unroll
    for (int i = 0; i < 5; ++i) { const int p = tid + 512 * i; if (p < 67 * 32) { const int row = p >> 5, pc = p & 31; bf16x8 v;
        if (row >= 3) v = *reinterpret_cast<const bf16x8*>(xb + (m0 + row - 3) * D + cbase + 8 * pc);
        else if (sconv) v = cvt8(sconv + (size_t)row * D + cbase + 8 * pc); else v = (bf16x8){0, 0, 0, 0, 0, 0, 0, 0};
        *reinterpret_cast<bf16x8*>(XB + row * XP + 8 * pc) = v; } }
#pragma unroll
    for (int i = 0; i < 2; ++i) { const int p = tid + 512 * i, row = p >> 4, pc = p & 15; *reinterpret_cast<bf16x8*>(GT + row * GP + 8 * pc) = *reinterpret_cast<const bf16x8*>(gin + (m0 + row) * D + gcol + 8 * pc); }
    __syncthreads();
    const int a16 = (lane >= 16 ? lane - 16 : lane) << 2, a32 = (lane >= 32 ? lane - 32 : lane) << 2, a48 = (fr + 48) << 2;
    for (int c = 0; c < nchunks; ++c) {
        const size_t mc = m0 + (size_t)c * 64; const bool more = c + 1 < nchunks;
        { const int pc = tid & 31, r4 = (tid >> 5) * 4; f32x2 y[4][4], wk[4][4];
          { const f32x4 b0 = *(const f32x4*)(CW + 4 * 256 + 8 * pc), b1 = *(const f32x4*)(CW + 4 * 256 + 8 * pc + 4);
#pragma unroll
            for (int o = 0; o < 4; ++o) { y[o][0] = (f32x2){b0[0], b0[1]}; y[o][1] = (f32x2){b0[2], b0[3]}; y[o][2] = (f32x2){b1[0], b1[1]}; y[o][3] = (f32x2){b1[2], b1[3]}; } }
#pragma unroll
          for (int k = 0; k < 4; ++k) { const f32x4 w0 = *(const f32x4*)(CW + k * 256 + 8 * pc), w1 = *(const f32x4*)(CW + k * 256 + 8 * pc + 4);
              wk[k][0] = (f32x2){w0[0], w0[1]}; wk[k][1] = (f32x2){w0[2], w0[3]}; wk[k][2] = (f32x2){w1[0], w1[1]}; wk[k][3] = (f32x2){w1[2], w1[3]}; }
#pragma unroll
          for (int j = 0; j < 7; ++j) { const u32x4 xr = *reinterpret_cast<const u32x4*>(XB + (r4 + j) * XP + 8 * pc); f32x2 xv[4];
              xv[0] = (f32x2){__uint_as_float(xr.x << 16), __uint_as_float(xr.x & 0xffff0000u)}; xv[1] = (f32x2){__uint_as_float(xr.y << 16), __uint_as_float(xr.y & 0xffff0000u)};
              xv[2] = (f32x2){__uint_as_float(xr.z << 16), __uint_as_float(xr.z & 0xffff0000u)}; xv[3] = (f32x2){__uint_as_float(xr.w << 16), __uint_as_float(xr.w & 0xffff0000u)};
#pragma unroll
              for (int o = 0; o < 4; ++o) { const int k = j - o; if (k >= 0 && k < 4) {
#pragma unroll
                  for (int p = 0; p < 4; ++p) y[o][p] = wk[k][p] * xv[p] + y[o][p]; } } }
#pragma unroll
          for (int o = 0; o < 4; ++o) { u32x4 w; w.x = pk2(y[o][0][0], y[o][0][1]); w.y = pk2(y[o][1][0], y[o][1][1]); w.z = pk2(y[o][2][0], y[o][2][1]); w.w = pk2(y[o][3][0], y[o][3][1]); *(u32x4*)(XC + (r4 + o) * XP + 8 * pc) = w; } }
        __syncthreads();
        bf16x8 px[5], pg[2]; int t2 = tid; asm volatile("" : "+v"(t2));
        if (more) {
#pragma unroll
            for (int i = 0; i < 5; ++i) { const int p = t2 + 512 * i; if (p < 67 * 32) px[i] = *reinterpret_cast<const bf16x8*>(xb + (mc + 61 + (p >> 5)) * D + cbase + 8 * (p & 31)); }
#pragma unroll
            for (int i = 0; i < 2; ++i) { const int p = t2 + 512 * i; pg[i] = *reinterpret_cast<const bf16x8*>(gin + (mc + 64 + (p >> 4)) * D + gcol + 8 * (p & 15)); } }
        f32x4 acc[4][2];
#pragma unroll
        for (int m = 0; m < 4; ++m) { acc[m][0] = (f32x4){0.f, 0.f, 0.f, 0.f}; acc[m][1] = (f32x4){0.f, 0.f, 0.f, 0.f}; }
#pragma unroll
        for (int ks = 0; ks < 8; ++ks) { bf16x8 af[4];
#pragma unroll
            for (int m = 0; m < 4; ++m) af[m] = *reinterpret_cast<const bf16x8*>(XC + (16 * m + fr) * XP + 32 * ks + 8 * fq);
#pragma unroll
            for (int m = 0; m < 4; ++m) { acc[m][0] = __builtin_amdgcn_mfma_f32_16x16x32_bf16(af[m], Bf[0][ks], acc[m][0], 0, 0, 0); acc[m][1] = __builtin_amdgcn_mfma_f32_16x16x32_bf16(af[m], Bf[1][ks], acc[m][1], 0, 0, 0); } }
#pragma unroll
        for (int m = 0; m < 4; ++m)
#pragma unroll
            for (int rgi = 0; rgi < 4; ++rgi) { const int tok = 16 * m + 4 * fq + rgi;
                const float xcv = bf2f(XC[tok * XP + chl]);
                const float r = __builtin_amdgcn_rcpf(1.f + __expf(-(acc[m][0][rgi] + ba))), ig = __builtin_amdgcn_rcpf(1.f + __expf(-(acc[m][1][rgi] + bi)));
                const float av = __builtin_amdgcn_exp2f(r * c8l); const float x2 = r * c2;
                float mult = __builtin_amdgcn_sqrtf(small_x ? neg_expm1_series(x2) : neg_expm1(x2)); if (pos0 && c == 0 && tok == 0) mult = 1.f;
                acc[m][0][rgi] = av; acc[m][1][rgi] = mult * ig * xcv; }
#pragma unroll
        for (int m = 0; m < 4; ++m) {
            float A = 1.f, B = 0.f;
#pragma unroll
            for (int rgi = 0; rgi < 4; ++rgi) { B = acc[m][0][rgi] * B + acc[m][1][rgi]; A *= acc[m][0][rgi]; }
            { const float Ap = bperm(A, a16), Bp = bperm(B, a16); if (fq >= 1) { B = A * Bp + B; A = A * Ap; } }
            { const float Ap = bperm(A, a32), Bp = bperm(B, a32); if (fq >= 2) { B = A * Bp + B; A = A * Ap; } }
            float Ae = bperm(A, a16), Be = bperm(B, a16); if (fq == 0) { Ae = 1.f; Be = 0.f; }
            const float At = bperm(A, a48), Bt = bperm(B, a48);
            float h = Ae * H + Be; H = At * H + Bt;
#pragma unroll
            for (int rgi = 0; rgi < 4; ++rgi) { h = acc[m][0][rgi] * h + acc[m][1][rgi]; acc[m][1][rgi] = h; } }
#pragma unroll
        for (int m = 0; m < 4; ++m)
#pragma unroll
            for (int rgi = 0; rgi < 4; ++rgi) { bf16_t* gp = GT + (16 * m + 4 * fq + rgi) * GP + 16 * wid + fr; *gp = (bf16_t)f2bf(acc[m][1][rgi] * bf2f(*gp)); }
        if (!more && fq == 0) rnn_out[ch] = H;
        __syncthreads();
#pragma unroll
        for (int i = 0; i < 2; ++i) { const int p = tid + 512 * i, row = p >> 4, pc = p & 15; *(u32x4*)(hgo + (mc + row) * D + gcol + 8 * pc) = *(const u32x4*)(GT + row * GP + 8 * pc); }
        __syncthreads();
        if (more) {
#pragma unroll
            for (int i = 0; i < 5; ++i) { const int p = t2 + 512 * i; if (p < 67 * 32) *reinterpret_cast<bf16x8*>(XB + (p >> 5) * XP + 8 * (p & 31)) = px[i]; }
#pragma unroll
            for (int i = 0; i < 2; ++i) { const int p = t2 + 512 * i; *reinterpret_cast<bf16x8*>(GT + (p >> 4) * GP + 8 * (p & 15)) = pg[i]; }
            __syncthreads(); }
    }
    __syncthreads();
}

__device__ __forceinline__ void rglru_phase(char* lds, const bf16_t* xb, const bf16_t* gin, bf16_t* hgo, const bf16_t* wai, const float* cw, const float* cb, const float* b_a, const float* b_i, const float* lam,
                                            const float* sconv, const float* srnn, float* rnnp, float* rnns, int vcu, int G, int tid) {
    for (int uu = vcu; uu < (PB + SB) * 16; uu += G) { const bool samp = uu >= PB * 16; const int u = samp ? uu - PB * 16 : uu; const int b = u >> 4, n = (u >> 1) & 7, hf = u & 1;
        rg_unit(lds, xb, gin, hgo, wai + (size_t)n * 512 * 256, cw, cb, b_a, b_i, lam, samp ? sconv + (size_t)b * 3 * D : nullptr, samp ? srnn + (size_t)b * D : nullptr, (samp ? rnns : rnnp) + (size_t)b * D,
                samp ? (size_t)TP + (size_t)b * SS : (size_t)b * PS, samp ? 1 : PS / 64, n * 256, hf, !samp, tid); }
}
}

constexpr int NWAVES = 8;
constexpr int RING_BYTES = 139264;
constexpr int MISC_OFF = RING_BYTES + 320;
constexpr int LDS_BYTES = 147456;
using pg8::bf16_t;

__device__ __forceinline__ float lane_xor_f(float v, int lane4) { return __int_as_float(__builtin_amdgcn_ds_bpermute(lane4, __float_as_int(v))); }
__device__ __forceinline__ float wave_sum(float v, int lane) {
#pragma unroll
    for (int o = 1; o < 64; o <<= 1) v += lane_xor_f(v, (lane ^ o) << 2);
    return v;
}
__device__ __forceinline__ float wave_max(float v, int lane) {
#pragma unroll
    for (int o = 1; o < 64; o <<= 1) v = fmaxf(v, lane_xor_f(v, (lane ^ o) << 2));
    return v;
}

struct Args { const float* in[32]; float* out; unsigned char* ws; };
typedef const __attribute__((address_space(4))) unsigned char* kaptr_t;
__device__ __forceinline__ kaptr_t ka_fresh() { kaptr_t ka = (kaptr_t)__builtin_amdgcn_kernarg_segment_ptr(); asm volatile("" : "+s"(ka)); return ka; }
__device__ __forceinline__ const float* arg_in(kaptr_t ka, int i) { return *(const float* const __attribute__((address_space(4)))*)(ka + 8 * i); }
__device__ __forceinline__ float* arg_out(kaptr_t ka) { return *(float* const __attribute__((address_space(4)))*)(ka + 8 * 32); }
__device__ __forceinline__ unsigned char* arg_ws(kaptr_t ka) { return *(unsigned char* const __attribute__((address_space(4)))*)(ka + 8 * 33); }
#define GAS __attribute__((address_space(1)))
struct TItem { const GAS float* W; GAS bf16_t* WT; int K, N, mode, off, item; };
__device__ __forceinline__ void t_load(const TItem& t, float (&v)[32], int lane) {
    const int nblk = t.N / 32, kb = t.item / nblk, nb = t.item % nblk; const GAS float* p = t.W + (size_t)(64 * kb + (lane >> 5)) * t.N + 32 * nb + (lane & 31);
#pragma unroll
    for (int i = 0; i < 32; ++i) v[i] = p[(size_t)(2 * i) * t.N];
}
__device__ __forceinline__ void t_finish(const TItem& t, const float (&v)[32], LAS float* scr, int lane) {
    const int nblk = t.N / 32, kb = t.item / nblk, nb = t.item % nblk, k0 = 64 * kb, n0 = 32 * nb;
#pragma unroll
    for (int i = 0; i < 32; ++i) scr[(2 * i + (lane >> 5)) * 33 + (lane & 31)] = v[i];
    LDS_WAIT(); asm volatile("" ::: "memory");
    const int c = lane & 7;
#pragma unroll
    for (int j = 0; j < 4; ++j) { const int n = (lane >> 3) + 8 * j; const LAS float* s = scr + (8 * c) * 33 + n;
        u32x4 o; o.x = pk2(s[0 * 33], s[1 * 33]); o.y = pk2(s[2 * 33], s[3 * 33]); o.z = pk2(s[4 * 33], s[5 * 33]); o.w = pk2(s[6 * 33], s[7 * 33]);
        const int nc = n0 + n; const int drow = t.mode == 0 ? t.off + nc : (t.mode == 1 ? ((nc >> 7) * 256 + (nc & 127) + t.off) : (2 * nc + t.off));
        *(GAS u32x4*)(t.WT + (size_t)drow * t.K + k0 + 8 * c) = o; }
}
constexpr int T_IB = 2048;
constexpr int T_I13 = 32 * (DFF / 32);
constexpr int T_I2 = (DFF / 64) * 64;
constexpr int T_S0 = 6 * T_IB, T_S1 = T_S0 + 4 * T_IB, T_S2 = T_S1 + 2 * T_IB, T_S3 = T_S2 + 32 * 32, T_S4 = T_S3 + 8 * T_I13, T_S5 = T_S4 + 4 * T_I2;
__device__ __forceinline__ TItem t_decode(kaptr_t ka, int it) {
    unsigned char* ws = arg_ws(ka); TItem t;
    if (it < T_S0) { const int mi = it / T_IB, l = mi / 3, ty = mi % 3;
        t.W = (const GAS float*)((ty == 0 ? arg_in(ka, 13) : (ty == 1 ? arg_in(ka, 12) : arg_in(ka, 21))) + (size_t)l * D * D); t.WT = (GAS bf16_t*)(ty == 2 ? (bf16_t*)(ws + WS_WRGO) + (size_t)l * D * D : (bf16_t*)(ws + WS_WGI) + (size_t)l * 2 * D * D);
        t.K = D; t.N = D; t.mode = 0; t.off = ty == 1 ? D : 0; t.item = it % T_IB; }
    else if (it < T_S1) { const int q = it - T_S0, mi = q / T_IB, l = mi >> 1, ty = mi & 1;
        t.W = (const GAS float*)((ty == 0 ? arg_in(ka, 25) : arg_in(ka, 26)) + (size_t)l * D * D); t.WT = (GAS bf16_t*)((bf16_t*)(ws + (ty == 0 ? WS_WQ : WS_WO)) + (size_t)l * D * D); t.K = D; t.N = D; t.mode = 0; t.off = 0; t.item = q % T_IB; }
    else if (it < T_S2) { const int q = it - T_S1, ty = q / T_IB;
        t.W = (const GAS float*)(ty == 0 ? arg_in(ka, 23) : arg_in(ka, 24)); t.WT = (GAS bf16_t*)((bf16_t*)(ws + WS_WKV)); t.K = D; t.N = D; t.mode = 0; t.off = ty == 0 ? 0 : D; t.item = q % T_IB; }
    else if (it < T_S3) { const int q = it - T_S2, mi = q / 32, ln = mi >> 1, ty = mi & 1;
        t.W = (const GAS float*)((ty == 0 ? arg_in(ka, 16) : arg_in(ka, 18)) + (size_t)ln * 256 * 256); t.WT = (GAS bf16_t*)((bf16_t*)(ws + WS_WAI) + (size_t)ln * 512 * 256); t.K = 256; t.N = 256; t.mode = 2; t.off = ty; t.item = q % 32; }
    else if (it < T_S4) { const int q = it - T_S3, mi = q / T_I13, l = mi >> 1, ty = mi & 1;
        t.W = (const GAS float*)((ty == 0 ? arg_in(ka, 28) : arg_in(ka, 29)) + (size_t)l * D * DFF); t.WT = (GAS bf16_t*)((bf16_t*)(ws + WS_W13) + (size_t)l * 2 * DFF * D); t.K = D; t.N = DFF; t.mode = 1; t.off = ty * 128; t.item = q % T_I13; }
    else { const int q = it - T_S4, l = q / T_I2;
        t.W = (const GAS float*)(arg_in(ka, 30) + (size_t)l * DFF * D); t.WT = (GAS bf16_t*)((bf16_t*)(ws + WS_W2) + (size_t)l * D * DFF); t.K = DFF; t.N = D; t.mode = 0; t.off = 0; t.item = q % T_I2; }
    return t;
}
__device__ __forceinline__ void p0_weights(kaptr_t ka, LAS unsigned char* lds, int gw, int NGW, int wave, int lane) {
    LAS float* scr0 = (LAS float*)(lds + wave * 16896); LAS float* scr1 = scr0 + 64 * 33;
    for (int it = 2 * gw; it < T_S5; it += 2 * NGW) {
        const TItem t0 = t_decode(ka, it), t1 = t_decode(ka, it + 1);
        float v0[32], v1[32];
        t_load(t0, v0, lane); t_load(t1, v1, lane);
        t_finish(t0, v0, scr0, lane); t_finish(t1, v1, scr1, lane);
        LDS_WAIT(); asm volatile("" ::: "memory");
    }
}

__device__ __forceinline__ void p0_cache(const float* __restrict__ ck, const float* __restrict__ cv, bf16_t* __restrict__ KS, bf16_t* __restrict__ VS, int gw, int NGW, int lane) {
    constexpr int STEPS = SB * LEFT * D / 512;
    for (int it0 = 4 * gw; it0 < 2 * STEPS; it0 += 4 * NGW) {
        f32x4 x0[4], x1[4];
#pragma unroll
        for (int u = 0; u < 4; ++u) { const int it = it0 + u; const bool isv = it >= STEPS; const size_t e = (size_t)(isv ? it - STEPS : it) * 512 + lane * 8; const float* src = (isv ? cv : ck) + e; x0[u] = *(const f32x4*)src; x1[u] = *(const f32x4*)(src + 4); }
#pragma unroll
        for (int u = 0; u < 4; ++u) { const int it = it0 + u; const bool isv = it >= STEPS; const size_t e = (size_t)(isv ? it - STEPS : it) * 512 + lane * 8;
            const size_t bj = e >> 11, col = e & (D - 1), b = bj >> 9, j = bj & (LEFT - 1);
            u32x4 w; w.x = pk2(x0[u][0], x0[u][1]); w.y = pk2(x0[u][2], x0[u][3]); w.z = pk2(x1[u][0], x1[u][1]); w.w = pk2(x1[u][2], x1[u][3]);
            *(u32x4*)((isv ? VS : KS) + (b * BAND + j) * D + col) = w; }
    }
}

__device__ __forceinline__ void p0_mod(const float* __restrict__ c_p, const float* __restrict__ c_s, const float* __restrict__ ada_w, const float* __restrict__ ada_b, float* __restrict__ mod, LAS unsigned char* lds, int vcu, int G, int tid) {
    LAS float* cs = (LAS float*)lds;
    LAS float* red = (LAS float*)lds;
    const int cp = tid & 31, ks = tid >> 5, lane = tid & 63, wv = tid >> 6;
    for (int item = vcu; item < 4 * 192; item += G) {
        const int l = item / 192, j0 = (item % 192) * 64;
        f32x2 acc[NBB];
#pragma unroll
        for (int bb = 0; bb < NBB; ++bb) acc[bb] = (f32x2){0.f, 0.f};
        for (int kc = 0; kc < 8; ++kc) {
            __syncthreads();
#pragma unroll 4
            for (int i = 0; i < 24; ++i) { const int idx = tid + 512 * i, bb = idx >> 8, kk = idx & 255; const float c = bb < PB ? c_p[bb * D + kc * 256 + kk] : c_s[(bb - PB) * D + kc * 256 + kk]; cs[kk * NBB + bb] = c / (1.0f + __expf(-c)); }
            __syncthreads();
            f32x2 w2[16];
            const float* wp = ada_w + ((size_t)l * D + kc * 256 + ks * 16) * MODW + j0 + 2 * cp;
#pragma unroll
            for (int i = 0; i < 16; ++i) w2[i] = *(const f32x2*)(wp + (size_t)i * MODW);
#pragma unroll
            for (int i = 0; i < 16; ++i) { const LAS f32x4* cr = (const LAS f32x4*)(cs + (ks * 16 + i) * NBB);
#pragma unroll
                for (int q = 0; q < 12; ++q) { const f32x4 c4 = cr[q];
#pragma unroll
                    for (int e = 0; e < 4; ++e) acc[4 * q + e] += w2[i] * c4[e]; } }
        }
#pragma unroll
        for (int bb = 0; bb < NBB; ++bb) {
            { auto r = __builtin_amdgcn_permlane32_swap(__float_as_uint(acc[bb][0]), __float_as_uint(acc[bb][0]), false, false); acc[bb][0] = __uint_as_float(r[0]) + __uint_as_float(r[1]); }
            { auto r = __builtin_amdgcn_permlane32_swap(__float_as_uint(acc[bb][1]), __float_as_uint(acc[bb][1]), false, false); acc[bb][1] = __uint_as_float(r[0]) + __uint_as_float(r[1]); } }
        __syncthreads();
        if (lane < 32) {
#pragma unroll
            for (int bb = 0; bb < NBB; ++bb) { red[(wv * 96 + 2 * bb) * 32 + lane] = acc[bb][0]; red[(wv * 96 + 2 * bb + 1) * 32 + lane] = acc[bb][1]; } }
        __syncthreads();
#pragma unroll
        for (int i = 0; i < 6; ++i) { const int o = tid + 512 * i, bb = o >> 6, col = o & 63, v = 2 * bb + (col & 1), c2 = col >> 1; float s = ada_b[l * MODW + j0 + col];
#pragma unroll
            for (int w = 0; w < 8; ++w) s += red[(w * 96 + v) * 32 + c2];
            mod[((size_t)l * NBB + bb) * MODW + j0 + col] = s; }
    }
    __syncthreads();
}

__device__ __forceinline__ void gm_tables(const float* __restrict__ g_mix, const float* __restrict__ g_ffn, const float* __restrict__ mod, float* __restrict__ gm, int gtid, int nthreads) {
    for (int e = gtid; e < 8 * NBB * (D / 4); e += nthreads) { const int k4 = e % (D / 4), b = (e / (D / 4)) % NBB, i = e / ((D / 4) * NBB), l = i >> 1;
        const f32x4 g = *(const f32x4*)((i & 1 ? g_ffn : g_mix) + (size_t)l * D + 4 * k4), sc = *(const f32x4*)(mod + ((size_t)l * NBB + b) * MODW + (i & 1 ? 4 * D : D) + 4 * k4);
        *(f32x4*)(gm + ((size_t)i * NBB + b) * D + 4 * k4) = g * (sc + 1.0f); }
}
__device__ __forceinline__ void norm0_pass(const float* __restrict__ xp_, const float* __restrict__ xs_, bf16_t* __restrict__ X, bf16_t* __restrict__ xg, const float* __restrict__ g, const float* __restrict__ mod0, pg8::ssq_t* __restrict__ ssq0, int gw, int NGW, int lane) {
    for (int m0 = gw; m0 < T; m0 += 2 * NGW) {
        const int m1 = m0 + NGW; const bool two = m1 < T; const int mb = two ? m1 : m0;
        const f32x4* xr0 = (const f32x4*)(m0 < TP ? xp_ + (size_t)m0 * D : xs_ + (size_t)(m0 - TP) * D) + lane;
        const f32x4* xr1 = (const f32x4*)(mb < TP ? xp_ + (size_t)mb * D : xs_ + (size_t)(mb - TP) * D) + lane;
        f32x4 v0[8], v1[8];
#pragma unroll
        for (int j = 0; j < 8; ++j) { v0[j] = xr0[64 * j]; v1[j] = xr1[64 * j]; }
#pragma unroll
        for (int r = 0; r < 2; ++r) { if (r == 1 && !two) break; const int m = r ? m1 : m0; const f32x4* v = r ? v1 : v0; float ss = 0.f;
#pragma unroll
            for (int j = 0; j < 8; ++j) ss += (v[j][0] * v[j][0] + v[j][1] * v[j][1]) + (v[j][2] * v[j][2] + v[j][3] * v[j][3]);
            ss = wave_sum(ss, lane); if (lane == 0) ssq0[m] = pg8::ssq_fix(ss);
            const int bb = row_bb(m); const f32x4* gp = (const f32x4*)g + lane; const f32x4* sc = (const f32x4*)(mod0 + (size_t)bb * MODW + D) + lane;
            u32x2* xc = (u32x2*)(X + (size_t)m * XPITCH) + lane; u32x2* o = (u32x2*)(xg + (size_t)m * D) + lane;
#pragma unroll
            for (int j = 0; j < 8; ++j) { { u32x2 w; w.x = pk2(v[j][0], v[j][1]); w.y = pk2(v[j][2], v[j][3]); xc[64 * j] = w; } const f32x4 z = v[j] * (gp[64 * j] * (sc[64 * j] + 1.0f)); u32x2 w; w.x = pk2(z[0], z[1]); w.y = pk2(z[2], z[3]); o[64 * j] = w; } }
    }
}
__device__ __forceinline__ void shw_tile(const float* __restrict__ sh, const bf16_t* __restrict__ Wt, float* __restrict__ dst, int N, int n0, int lane) {
    const int fr = lane & 15, fq = lane >> 4;
    f32x4 acc[3][4];
#pragma unroll
    for (int m = 0; m < 3; ++m)
#pragma unroll
        for (int j = 0; j < 4; ++j) acc[m][j] = (f32x4){0.f, 0.f, 0.f, 0.f};
    const float* ap = sh + (size_t)fr * MODW + 8 * fq; const bf16_t* bp = Wt + (size_t)(n0 + fr) * D + 8 * fq;
#pragma unroll 4
    for (int k0 = 0; k0 < D; k0 += 32) { bf16x8 af[3], bfr[4];
#pragma unroll
        for (int m = 0; m < 3; ++m) { const f32x4 x0 = *(const f32x4*)(ap + (size_t)(16 * m) * MODW + k0), x1 = *(const f32x4*)(ap + (size_t)(16 * m) * MODW + k0 + 4); u32x4 w; w.x = pk2(x0[0], x0[1]); w.y = pk2(x0[2], x0[3]); w.z = pk2(x1[0], x1[1]); w.w = pk2(x1[2], x1[3]); af[m] = *reinterpret_cast<bf16x8*>(&w); }
#pragma unroll
        for (int j = 0; j < 4; ++j) bfr[j] = *reinterpret_cast<const bf16x8*>(bp + (size_t)(16 * j) * D + k0);
#pragma unroll
        for (int m = 0; m < 3; ++m)
#pragma unroll
            for (int j = 0; j < 4; ++j) acc[m][j] = __builtin_amdgcn_mfma_f32_16x16x32_bf16(af[m], bfr[j], acc[m][j], 0, 0, 0); }
#pragma unroll
    for (int m = 0; m < 3; ++m)
#pragma unroll
        for (int j = 0; j < 4; ++j)
#pragma unroll
            for (int r = 0; r < 4; ++r) dst[(size_t)(16 * m + 4 * fq + r) * N + n0 + 16 * j + fr] = acc[m][j][r];
}
__device__ __forceinline__ void shw_phase(const float* __restrict__ mod, unsigned char* ws, int vcu, int G, int wave, int lane) {
    float* shw = (float*)(ws + WS_SHW);
    for (int t = vcu + G * wave; t < 896; t += G * NWAVES) {
        if (t < 128) { const int l = t >> 6, n0 = (t & 63) * 64; shw_tile(mod + (size_t)l * NBB * MODW, (const bf16_t*)(ws + WS_WGI) + (size_t)l * 2 * D * D, shw + SHW_GI + (size_t)l * NBB * 2 * D, 2 * D, n0, lane); }
        else if (t < 192) { const int bl = (t - 128) >> 5, n0 = ((t - 128) & 31) * 64; shw_tile(mod + (size_t)(2 + bl) * NBB * MODW, (const bf16_t*)(ws + WS_WQ) + (size_t)bl * D * D, shw + SHW_Q + (size_t)bl * NBB * D, D, n0, lane); }
        else { const int q = t - 192, l = q / 176, n0 = (q % 176) * 64; shw_tile(mod + (size_t)l * NBB * MODW + 3 * D, (const bf16_t*)(ws + WS_W13) + (size_t)l * 2 * DFF * D, shw + SHW_13 + (size_t)l * NBB * 2 * DFF, 2 * DFF, n0, lane); }
    }
}
__device__ __forceinline__ void final_pass(float* Y, const float* __restrict__ g, const pg8::ssq_t* __restrict__ ssq, int gw, int NGW, int lane) {
    for (int m0 = gw; m0 < T; m0 += 2 * NGW) {
        const int m1 = m0 + NGW; const bool two = m1 < T; const int mb = two ? m1 : m0;
        const u32x2* x0 = (const u32x2*)((const bf16_t*)(Y + (size_t)m0 * D) + D) + lane; const u32x2* x1 = (const u32x2*)((const bf16_t*)(Y + (size_t)mb * D) + D) + lane; const f32x4* gp = (const f32x4*)g + lane;
        u32x2 v0[8], v1[8];
#pragma unroll
        for (int j = 0; j < 8; ++j) { v0[j] = x0[64 * j]; v1[j] = x1[64 * j]; }
        const float r0 = pg8::rstd_of(ssq[m0]), r1 = pg8::rstd_of(ssq[mb]);
        asm volatile("s_waitcnt vmcnt(0)" ::: "memory");
        f32x4* y0 = (f32x4*)(Y + (size_t)m0 * D) + lane; f32x4* y1 = (f32x4*)(Y + (size_t)mb * D) + lane;
#pragma unroll
        for (int j = 0; j < 8; ++j) { const f32x4 xv = {__uint_as_float(v0[j].x << 16), __uint_as_float(v0[j].x & 0xffff0000u), __uint_as_float(v0[j].y << 16), __uint_as_float(v0[j].y & 0xffff0000u)}; y0[64 * j] = (xv * r0) * gp[64 * j]; }
        if (two) {
#pragma unroll
            for (int j = 0; j < 8; ++j) { const f32x4 xv = {__uint_as_float(v1[j].x << 16), __uint_as_float(v1[j].x & 0xffff0000u), __uint_as_float(v1[j].y << 16), __uint_as_float(v1[j].y & 0xffff0000u)}; y1[64 * j] = (xv * r1) * gp[64 * j]; } }
    }
}

#define fresh_tid() ({ int t_ = (wave_s_ << 6) | (int)__builtin_amdgcn_mbcnt_hi(~0u, __builtin_amdgcn_mbcnt_lo(~0u, 0u)); asm volatile("" : "+v"(t_)); t_; })
__device__ __forceinline__ int fresh_s(int v) { asm volatile("" : "+s"(v)); return v; }
#define WSP(off) ((bf16_t*)(arg_ws(ka) + (off)))

__global__ void __launch_bounds__(NWAVES * 64, 2) mega_fwd(Args a_unused) {
    extern __shared__ __attribute__((aligned(16))) unsigned char lds_raw[];
    LAS unsigned char* lds = (LAS unsigned char*)lds_raw;
    const int G_ = gridDim.x, bx_ = blockIdx.x; const int wave_s_ = __builtin_amdgcn_readfirstlane((int)threadIdx.x >> 6);
#define G (fresh_s(G_))
#define bx (fresh_s(bx_))
#define TID (fresh_tid())
#define LANE (fresh_tid() & 63)
#define WAVE (__builtin_amdgcn_readfirstlane(fresh_tid() >> 6))
#define VCU ((G % 8 == 0) ? (bx % 8) * (G / 8) + bx / 8 : bx)
#define GW (VCU * NWAVES + WAVE)
#define NGW (G * NWAVES)
    for (int u = TID; u < (LDS_BYTES - RING_BYTES) / 4; u += NWAVES * 64) ((LAS unsigned*)(lds + RING_BYTES))[u] = 0u;
    __syncthreads();
    XcdBarrier bar;
    { kaptr_t ka = ka_fresh(); bar = xcd_barrier_post((unsigned*)(arg_ws(ka) + WS_CTL) + CW_BAR, (volatile LAS unsigned*)(lds + MISC_OFF) + 8); }
#define GRID_BAR() do { XcdBarrier b2_ = bar; __attribute__((address_space(1))) unsigned* gb_ = (__attribute__((address_space(1))) unsigned*)bar.bar; asm volatile("" : "+s"(gb_), "+s"(b2_.x)); b2_.bar = (unsigned*)gb_; xcd_barrier(b2_); } while (0)

    { kaptr_t ka = ka_fresh(); pg8::ssq_t* sq = (pg8::ssq_t*)(arg_ws(ka) + WS_SSQ);
      for (int i = VCU * (NWAVES * 64) + TID; i < 9 * T; i += G * NWAVES * 64) sq[i] = 0ull; }
    { kaptr_t ka = ka_fresh(); p0_weights(ka, lds, GW, NGW, WAVE, LANE); }
    { kaptr_t ka = ka_fresh(); p0_cache(arg_in(ka, 6), arg_in(ka, 7), WSP(WS_KS), WSP(WS_VS), GW, NGW, LANE); }
    __syncthreads();
    { kaptr_t ka = ka_fresh(); p0_mod(arg_in(ka, 2), arg_in(ka, 3), arg_in(ka, 8), arg_in(ka, 9), (float*)(arg_ws(ka) + WS_MOD), lds, VCU, G, TID); }
    GRID_BAR();

    { kaptr_t ka = ka_fresh(); const float* mod = (const float*)(arg_ws(ka) + WS_MOD);
      gm_tables(arg_in(ka, 10), arg_in(ka, 11), mod, (float*)(arg_ws(ka) + WS_GM), VCU * (NWAVES * 64) + TID, G * NWAVES * 64); }
    { kaptr_t ka = ka_fresh(); shw_phase((const float*)(arg_ws(ka) + WS_MOD), arg_ws(ka), VCU, G, WAVE, LANE); }
    { kaptr_t ka = ka_fresh();
      norm0_pass(arg_in(ka, 0), arg_in(ka, 1), (bf16_t*)(arg_out(ka) + O_Y) + D, WSP(WS_HN), arg_in(ka, 10), (const float*)(arg_ws(ka) + WS_MOD), (pg8::ssq_t*)(arg_ws(ka) + WS_SSQ), GW, NGW, LANE); }
    GRID_BAR();

#define SSQP(i) ((pg8::ssq_t*)(arg_ws(ka) + WS_SSQ) + (size_t)(i) * T)
#define GMP(i) ((const float*)(arg_ws(ka) + WS_GM) + (size_t)(i) * NBB * D)
#define MODL(l) ((const float*)(arg_ws(ka) + WS_MOD) + (size_t)(l) * NBB * MODW)
#define SHWP(off) ((const float*)(arg_ws(ka) + WS_SHW) + (off))
#pragma unroll 1
    for (int l = 0; l < 4; ++l) {
        if (l < 2) {
            { kaptr_t ka = ka_fresh(); float* out = arg_out(ka);
              pg8::Gemm g{WSP(WS_HN), WSP(WS_WGI) + (size_t)l * 2 * D * D, T, 2 * D, D}; pg8::ORD_GI S; S.init(T, 2 * D, G, bx);
              pg8::EpiGateInP E{WSP(WS_BA), WSP(WS_BB), out + O_CONVP + (size_t)l * PB * 3 * D, out + O_CONVS + (size_t)l * SB * 3 * D, SSQP(2 * l), SHWP(SHW_GI + (size_t)l * NBB * 2 * D)};
              pg8::gemm_phase<pg8::EpiGateInP, pg8::ORD_GI, true, true>(lds, g, S, E, TID); }
            GRID_BAR();
            { kaptr_t ka = ka_fresh(); float* out = arg_out(ka);
              rg::rglru_phase((char*)lds_raw, WSP(WS_BB), WSP(WS_BA), WSP(WS_HN), WSP(WS_WAI) + (size_t)l * 8 * 512 * 256, arg_in(ka, 14) + (size_t)l * 4 * D, arg_in(ka, 15) + (size_t)l * D, arg_in(ka, 17) + (size_t)l * D, arg_in(ka, 19) + (size_t)l * D,
                              arg_in(ka, 20) + (size_t)l * D, arg_in(ka, 4) + (size_t)l * SB * 3 * D, arg_in(ka, 5) + (size_t)l * SB * D, out + O_RNNP + (size_t)l * PB * D, out + O_RNNS + (size_t)l * SB * D, VCU, G, TID); }
            GRID_BAR();
            { kaptr_t ka = ka_fresh();
              pg8::Gemm g{WSP(WS_HN), WSP(WS_WRGO) + (size_t)l * D * D, T, D, D}; pg8::ORD_R S; S.init(T, D, G, bx);
              pg8::EpiResidP E{(bf16_t*)(arg_out(ka) + O_Y) + D, MODL(l) + 2 * D, WSP(WS_BA), GMP(2 * l + 1), nullptr, nullptr, SSQP(2 * l + 1)};
              pg8::gemm_phase<pg8::EpiResidP, pg8::ORD_R, true, true>(lds, g, S, E, TID); }
        } else {
            if (l == 2) { kaptr_t ka = ka_fresh();
              pg8::Gemm g{WSP(WS_BA), WSP(WS_WKV), T, 2 * D, D}; pg8::ORD_KV S; S.init(T, 2 * D, G, bx);
              pg8::EpiKVP E{WSP(WS_BB), WSP(WS_BC), WSP(WS_KS), WSP(WS_VS), arg_out(ka), SSQP(4)};
              pg8::gemm_phase<pg8::EpiKVP, pg8::ORD_KV, true, true>(lds, g, S, E, TID); }
            { kaptr_t ka = ka_fresh();
              pg8::Gemm g{WSP(WS_HN), WSP(WS_WQ) + (size_t)(l - 2) * D * D, T, D, D}; pg8::ORD_Q S; S.init(T, D, G, bx);
              pg8::EpiQP E{WSP(WS_HID), SSQP(2 * l), SHWP(SHW_Q + (size_t)(l - 2) * NBB * D)};
              pg8::gemm_phase<pg8::EpiQP, pg8::ORD_Q, true, true>(lds, g, S, E, TID); }
            GRID_BAR();
            { kaptr_t ka = ka_fresh();
              att::attn_phase((char*)lds_raw, WSP(WS_HID), WSP(WS_HN), WSP(WS_BB), WSP(WS_BC), WSP(WS_KS), WSP(WS_VS), arg_in(ka, 27) + (size_t)(l - 2) * (2 * RELC + 1) * NH, VCU, G, TID); }
            GRID_BAR();
            { kaptr_t ka = ka_fresh();
              pg8::Gemm g{WSP(WS_HN), WSP(WS_WO) + (size_t)(l - 2) * D * D, T, D, D}; pg8::ORD_R S; S.init(T, D, G, bx);
              pg8::EpiResidP E{(bf16_t*)(arg_out(ka) + O_Y) + D, MODL(l) + 2 * D, WSP(WS_BA), GMP(2 * l + 1), nullptr, nullptr, SSQP(2 * l + 1)};
              pg8::gemm_phase<pg8::EpiResidP, pg8::ORD_R, true, true>(lds, g, S, E, TID); }
        }
        GRID_BAR();
        { kaptr_t ka = ka_fresh();
          pg8::Gemm g{WSP(WS_BA), WSP(WS_W13) + (size_t)l * 2 * DFF * D, T, 2 * DFF, D}; pg8::ORD_F13 S; S.init(T, 2 * DFF, G, bx);
          pg8::EpiFfn13P E{WSP(WS_HID), SSQP(2 * l + 1), SHWP(SHW_13 + (size_t)l * NBB * 2 * DFF)};
          pg8::gemm_phase<pg8::EpiFfn13P, pg8::ORD_F13, true, true>(lds, g, S, E, TID);
          }
        GRID_BAR();
        { kaptr_t ka = ka_fresh();
          pg8::Gemm g{WSP(WS_HID), WSP(WS_W2) + (size_t)l * D * DFF, T, D, DFF}; pg8::ORD_F2 S; S.init(T, D, G, bx);
          pg8::EpiResidP E{(bf16_t*)(arg_out(ka) + O_Y) + D, MODL(l) + 5 * D, l < 3 ? WSP(WS_HN) : nullptr, GMP(l < 3 ? 2 * l + 2 : 0), l == 1 ? WSP(WS_BA) : nullptr, arg_in(ka, 22), SSQP(2 * l + 2)};
          pg8::gemm_phase<pg8::EpiResidP, pg8::ORD_F2, true, true>(lds, g, S, E, TID); }
        GRID_BAR();
    }
    { kaptr_t ka = ka_fresh(); final_pass(arg_out(ka) + O_Y, arg_in(ka, 31), SSQP(8), GW, NGW, LANE); }
}

extern "C" void kernel_launch(void* const* d_in, const int* in_sizes, int n_in, void* d_out, int out_size, void* d_ws, size_t ws_size, hipStream_t stream) {
    (void)in_sizes; (void)out_size;
    static int grid = 0;
    if (grid == 0) {
        if (n_in != 32 || ws_size < WS_END) { fprintf(stderr, "kernel_launch: unexpected n_in %d / ws %zu\n", n_in, ws_size); grid = -1; return; }
        int dev = 0, cus = 0, per_cu = 0;
        if (hipGetDevice(&dev) != hipSuccess || hipDeviceGetAttribute(&cus, hipDeviceAttributeMultiprocessorCount, dev) != hipSuccess) { grid = -1; return; }
        if (hipFuncSetAttribute((const void*)mega_fwd, hipFuncAttributeMaxDynamicSharedMemorySize, LDS_BYTES) != hipSuccess) { fprintf(stderr, "kernel_launch: hipFuncSetAttribute failed\n"); grid = -1; return; }
        if (hipOccupancyMaxActiveBlocksPerMultiprocessor(&per_cu, (const void*)mega_fwd, NWAVES * 64, LDS_BYTES) != hipSuccess || per_cu < 1) fprintf(stderr, "kernel_launch: occupancy query says %d\n", per_cu);
        (void)hipGetLastError();
        grid = cus;
    }
    if (grid < 0) return;
    if (hipMemsetAsync((char*)d_ws + WS_CTL, 0, CTL_ZERO_BYTES, stream) != hipSuccess) return;
    Args a{};
    for (int i = 0; i < 32; ++i) a.in[i] = (const float*)d_in[i];
    a.out = (float*)d_out; a.ws = (unsigned char*)d_ws;
    hipLaunchKernelGGL(mega_fwd, dim3(grid), dim3(NWAVES * 64), LDS_BYTES, stream, a);
}
```

```cpp
#include <hip/hip_runtime.h>
#include <cstdio>
#include <cstdint>

typedef unsigned short bf16_t;
typedef short bf16x8 __attribute__((ext_vector_type(8)));
typedef float f32x4 __attribute__((ext_vector_type(4)));
typedef float f32x2 __attribute__((ext_vector_type(2)));
typedef unsigned u32x2 __attribute__((ext_vector_type(2)));
typedef unsigned u32x4 __attribute__((ext_vector_type(4)));
#define LAS __attribute__((address_space(3)))

constexpr int D = 2048, DFF = 5632, NH = 16, HD = 128;
constexpr int PB = 16, PS = 2048, SB = 32, SS = 64;
constexpr int TP = PB * PS;
constexpr int TS = SB * SS;
constexpr int T = TP + TS;
constexpr int NBB = PB + SB;
constexpr int MODW = 6 * D;
constexpr int LEFT = 512, BAND = 576, RELC = 128;
constexpr float EPS = 1e-6f;

constexpr size_t O_Y = 0;
constexpr int XPITCH = 2 * 2048;
constexpr size_t O_CONVP = (size_t)T * D;
constexpr size_t O_RNNP = O_CONVP + 2 * PB * 3 * D;
constexpr size_t O_KP = O_RNNP + 2 * PB * D;
constexpr size_t O_VP = O_KP + (size_t)PB * LEFT * D;
constexpr size_t O_CONVS = O_VP + (size_t)PB * LEFT * D;
constexpr size_t O_RNNS = O_CONVS + 2 * SB * 3 * D;
constexpr size_t O_KS = O_RNNS + 2 * SB * D;
constexpr size_t O_VS = O_KS + (size_t)SB * SS * D;
constexpr size_t O_END = O_VS + (size_t)SB * SS * D;
static_assert(O_END == 114032640, "output size");

constexpr size_t MiB = 1u << 20;
constexpr size_t WS_CTL = 0, CTL_ZERO_BYTES = 1 * MiB;
constexpr size_t WS_MOD = 1 * MiB;
constexpr size_t WS_WGI = 10 * MiB;
constexpr size_t WS_WRGO = 42 * MiB;
constexpr size_t WS_WAI = 58 * MiB;
constexpr size_t WS_WKV = 62 * MiB;
constexpr size_t WS_WQ = 78 * MiB;
constexpr size_t WS_WO = 94 * MiB;
constexpr size_t WS_W13 = 110 * MiB;
constexpr size_t WS_W2 = 286 * MiB;
constexpr size_t WS_HN = 374 * MiB;
constexpr size_t WS_BA = 510 * MiB;
constexpr size_t WS_BB = 646 * MiB;
constexpr size_t WS_BC = 782 * MiB;
constexpr size_t WS_HID = 918 * MiB;
constexpr size_t WS_KS = 1292 * MiB;
constexpr size_t WS_VS = 1364 * MiB;
constexpr size_t WS_SSQ = 1454 * MiB;
constexpr size_t SSQ_BYTES = 9 * (size_t)34816 * 8;
constexpr size_t WS_GM = 1438 * MiB;
constexpr size_t WS_SHW = 1442 * MiB;
constexpr size_t SHW_GI = 0, SHW_Q = 2 * 48 * 4096, SHW_13 = SHW_Q + 2 * 48 * 2048;
constexpr size_t WS_END = 1458 * MiB;
constexpr int EPI_LDS_OFF = 139264 + 2048, EPI_LDS_HALF = 6144;
constexpr int CW_BAR = 4096;

__device__ __forceinline__ float bf2f(bf16_t b) { return __uint_as_float(((unsigned)b) << 16); }
__device__ __forceinline__ unsigned f2bf(float f) { unsigned u = __float_as_uint(f); return (u + 0x7fffu + ((u >> 16) & 1u)) >> 16; }
__device__ __forceinline__ unsigned pk2(float lo, float hi) { return f2bf(lo) | (f2bf(hi) << 16); }
__device__ __forceinline__ int row_bb(int m) { return m < TP ? (m >> 11) : PB + ((m - TP) >> 6); }
__device__ __forceinline__ float fast_sigmoid(float x) { return __builtin_amdgcn_rcpf(1.0f + __expf(-x)); }
__device__ __forceinline__ f32x4 sigmoid4(const f32x4& x) { const f32x4 t = x * (-1.4426950408889634f); f32x4 e; e[0] = __builtin_amdgcn_exp2f(t[0]); e[1] = __builtin_amdgcn_exp2f(t[1]); e[2] = __builtin_amdgcn_exp2f(t[2]); e[3] = __builtin_amdgcn_exp2f(t[3]);
    const f32x4 d = e + 1.0f; f32x4 s; s[0] = __builtin_amdgcn_rcpf(d[0]); s[1] = __builtin_amdgcn_rcpf(d[1]); s[2] = __builtin_amdgcn_rcpf(d[2]); s[3] = __builtin_amdgcn_rcpf(d[3]); return s; }
__device__ __forceinline__ f32x4 gelu_tanh4(const f32x4& x) { const f32x4 u = (x * x * 0.044715f + 1.0f) * x * 1.5957691216057308f; return x * sigmoid4(u); }
__device__ __forceinline__ float gelu_tanh_fast(float x) { const float u = 1.5957691216057308f * (x + 0.044715f * x * x * x); return x * __builtin_amdgcn_rcpf(1.0f + __expf(-u)); }
#define LDS_WAIT() asm volatile("s_waitcnt lgkmcnt(0)" ::: "memory")
#define VM_WAIT() asm volatile("s_waitcnt vmcnt(0)" ::: "memory")

namespace pg8 {
#define PG8_LAS __attribute__((address_space(3)))
typedef unsigned short bf16_t;
typedef short bf16x8 __attribute__((ext_vector_type(8)));
typedef float f32x4 __attribute__((ext_vector_type(4)));
typedef unsigned u32x4 __attribute__((ext_vector_type(4)));
constexpr int BM = 256, BK = 64, HALF = 128, HTB = HALF * BK * 2  , STAGE_BYTES = 8 * HTB, NXCD = 8, WGM = 8;

__host__ __device__ __forceinline__ int lds_byte(int r, int c) { const int st = (r >> 4) * 2 + (c >> 5), rr = r & 15, cc = c & 31, ob = rr * 64 + cc * 2; return st * 1024 + (ob ^ (((ob >> 9) & 1) << 5)); }
__host__ __device__ __forceinline__ void stage_rc(int b, int& R, int& C) { const int st = b / 1024, sb = b % 1024, swz = sb ^ (((sb >> 9) & 1) << 5); R = (st >> 1) * 16 + swz / 64; C = (st & 1) * 32 + (swz % 64) / 2; }
__host__ __device__ __forceinline__ int perm32(int rho) { const int n = rho >> 4, i = rho & 15; return 8 * (i >> 2) + 4 * n + (i & 3); }

struct Unit { int pm, pn; };
struct Gemm { const bf16_t* A; const bf16_t* Bt; int M, N, K; };

template <int WG  > struct StaticOrderT {
    int nM, nN, nwg, G, c;
    __host__ __device__ void init(int M, int N, int G_, int c_) { nM = M / BM; nN = N / BM; nwg = nM * nN; G = G_; c = c_; }
    __host__ __device__ bool next(int i, Unit& u) const {
        const long L = (long)i * G + c; if (L >= nwg) return false;
        int wgid = (int)L; { const int q = nwg / NXCD, r = nwg % NXCD, xcd = wgid % NXCD, off = wgid / NXCD; wgid = (xcd < r ? xcd * (q + 1) : r * (q + 1) + (xcd - r) * q) + off; }
        const int nig = WG * nN, gid = wgid / nig, fm = gid * WG, gsz = (nM - fm) < WG ? (nM - fm) : WG;
        u.pm = fm + ((wgid % nig) % gsz); u.pn = (wgid % nig) / gsz; return true;
    }
    __device__ __forceinline__ void a_ready(const Unit&) const {}
    __device__ __forceinline__ void done(const Unit&) const {}
};
typedef StaticOrderT<WGM> StaticOrder;
#ifndef WG_GI
#define WG_GI 4
#endif
#ifndef WG_KV
#define WG_KV 4
#endif
#ifndef WG_Q
#define WG_Q 4
#endif
#ifndef WG_F13
#define WG_F13 4
#endif
#ifndef WG_R
#define WG_R 4
#endif
#ifndef WG_F2
#define WG_F2 4
#endif
typedef StaticOrderT<WG_GI> ORD_GI; typedef StaticOrderT<WG_KV> ORD_KV; typedef StaticOrderT<WG_Q> ORD_Q; typedef StaticOrderT<WG_F13> ORD_F13; typedef StaticOrderT<WG_R> ORD_R; typedef StaticOrderT<WG_F2> ORD_F2;
__device__ __forceinline__ unsigned cvt_pk_bf16(float lo, float hi) { unsigned r; asm volatile("v_cvt_pk_bf16_f32 %0, %1, %2" : "=v"(r) : "v"(lo), "v"(hi)); return r; }
typedef unsigned long long ssq_t;
constexpr float SSQ_SCALE = 65536.0f;
__device__ __forceinline__ ssq_t ssq_fix(float s) { return (ssq_t)(s * SSQ_SCALE + 0.5f); }
__device__ __forceinline__ float rstd_of(ssq_t ssq) { return __builtin_amdgcn_rsqf((float)ssq * (1.0f / (SSQ_SCALE * D)) + EPS); }
__device__ __forceinline__ void dma1k(const void* gsrc_lane, PG8_LAS unsigned char* dst_wave) { __builtin_amdgcn_global_load_lds((const unsigned*)gsrc_lane, (PG8_LAS unsigned*)dst_wave, 16, 0, 0); }
__device__ __forceinline__ void prefetch_norm(PG8_LAS unsigned char* area, const ssq_t* ssq, const float* shw, int shw_pitch, int pm, int pn, int wid, int lane) {
    if (wid < 2) dma1k(ssq + (size_t)pm * BM + wid * 128 + 2 * lane, area + wid * 1024);
    else if (wid < 6 && shw) { const int k = wid - 2, bb = row_bb(pm * BM + (k >> 1) * HALF + (k & 1) * 64); dma1k(shw + (size_t)bb * shw_pitch + pn * BM + 4 * lane, area + 2048 + k * 1024); }
}
__device__ __forceinline__ ssq_t lds_ssq(PG8_LAS unsigned char* area, int lrow) { return *(const PG8_LAS ssq_t*)(area + lrow * 8); }
__device__ __forceinline__ f32x4 lds_shw(PG8_LAS unsigned char* area, int k, int lcol) { return *(const PG8_LAS f32x4*)(area + 2048 + k * 1024 + lcol * 4); }
__device__ __forceinline__ u32x4 pack8(const f32x4& v0, const f32x4& v1) { u32x4 w; w.x = cvt_pk_bf16(v0[0], v0[1]); w.y = cvt_pk_bf16(v0[2], v0[3]); w.z = cvt_pk_bf16(v1[0], v1[1]); w.w = cvt_pk_bf16(v1[2], v1[3]); return w; }
__device__ __forceinline__ float sq4(const f32x4& o) { return (o[0] * o[0] + o[1] * o[1]) + (o[2] * o[2] + o[3] * o[3]); }

__device__ __forceinline__ void unpack8(const u32x4& w, f32x4& lo, f32x4& hi) {
    lo[0] = __uint_as_float(w.x << 16); lo[1] = __uint_as_float(w.x & 0xffff0000u); lo[2] = __uint_as_float(w.y << 16); lo[3] = __uint_as_float(w.y & 0xffff0000u);
    hi[0] = __uint_as_float(w.z << 16); hi[1] = __uint_as_float(w.z & 0xffff0000u); hi[2] = __uint_as_float(w.w << 16); hi[3] = __uint_as_float(w.w & 0xffff0000u); }
__device__ __forceinline__ void resid_body(const f32x4 (&acc)[2][2][4][2], int row0  , int col0  , int fq,
                                           bf16_t* __restrict__ x, const float* __restrict__ gvec, bf16_t* __restrict__ xg, const float* __restrict__ gm, bf16_t* __restrict__ xkv, const float* __restrict__ gkv, ssq_t* __restrict__ ssq) {
#pragma unroll
    for (int ai = 0; ai < 2; ++ai) { const int bb = row_bb(row0 + ai * HALF);
        f32x4 g[2][2], q[2][2]; u32x4 xw[4][2];
#pragma unroll
        for (int bj = 0; bj < 2; ++bj)
#pragma unroll
            for (int n = 0; n < 2; ++n) { g[bj][n] = *(const f32x4*)(gvec + (size_t)bb * MODW + col0 + bj * HALF + 4 * n); q[bj][n] = xg ? *(const f32x4*)(gm + (size_t)bb * D + col0 + bj * HALF + 4 * n) : (f32x4){0.f, 0.f, 0.f, 0.f}; }
#pragma unroll
        for (int m = 0; m < 4; ++m)
#pragma unroll
            for (int bj = 0; bj < 2; ++bj) xw[m][bj] = *(const u32x4*)(x + (size_t)(row0 + ai * HALF + m * 16) * XPITCH + col0 + bj * HALF);
        asm volatile("s_waitcnt vmcnt(0)" ::: "memory");
#pragma unroll
        for (int m = 0; m < 4; ++m) { const int row = row0 + ai * HALF + m * 16; float s = 0.f;
#pragma unroll
            for (int bj = 0; bj < 2; ++bj) { f32x4 o0, o1; unpack8(xw[m][bj], o0, o1); o0 = o0 + g[bj][0] * acc[ai][bj][m][0]; o1 = o1 + g[bj][1] * acc[ai][bj][m][1];
                const u32x4 pw = pack8(o0, o1); *(u32x4*)(x + (size_t)row * XPITCH + col0 + bj * HALF) = pw;
                unpack8(pw, o0, o1);
                s += sq4(o0) + sq4(o1);
                if (xg) *(u32x4*)(xg + (size_t)row * D + col0 + bj * HALF) = pack8(o0 * q[bj][0], o1 * q[bj][1]);
                if (xkv) *(u32x4*)(xkv + (size_t)row * D + col0 + bj * HALF) = pack8(o0 * *(const f32x4*)(gkv + col0 + bj * HALF), o1 * *(const f32x4*)(gkv + col0 + bj * HALF + 4)); }
            s += __int_as_float(__builtin_amdgcn_ds_swizzle(__float_as_int(s), 0x401f));
            { auto r2 = __builtin_amdgcn_permlane32_swap(__float_as_uint(s), __float_as_uint(s), false, false); s = __uint_as_float(r2[0]) + __uint_as_float(r2[1]); }
            if (fq == 0) __hip_atomic_fetch_add(ssq + row, ssq_fix(s), __ATOMIC_RELAXED, __HIP_MEMORY_SCOPE_AGENT); }
    }
}
struct EpiResidP {
    static constexpr bool PERM = true, AFTER_DRAIN = false;
    bf16_t* x; const float* gvec;
    bf16_t* xg; const float* gm;
    bf16_t* xkv; const float* gkv;
    ssq_t* ssq;
    __device__ __forceinline__ void prefetch(PG8_LAS unsigned char*, const Unit&, int, int) const {}
    __device__ __forceinline__ void operator()(const f32x4 (&acc)[2][2][4][2], const Unit& u, int wr, int wc, int fr, int fq, PG8_LAS unsigned char*) const {
        resid_body(acc, u.pm * BM + wr * 64 + fr, u.pn * BM + wc * 32 + 8 * fq, fq, x, gvec, xg, gm, xkv, gkv, ssq);
    }
};
__device__ __forceinline__ void gatein_body(const f32x4 (&acc)[2][2][4][2], int row0, int n0  , bool isx, bf16_t* __restrict__ gate, bf16_t* __restrict__ xb, float* __restrict__ convp, float* __restrict__ convs,
                                            PG8_LAS unsigned char* area, int lrow0  , int lcol0  , int wr) {
    const int col0 = n0 - (isx ? D : 0);
    ssq_t rs[2][4]; f32x4 sh[2][2][2];
#pragma unroll
    for (int ai = 0; ai < 2; ++ai) {
#pragma unroll
        for (int m = 0; m < 4; ++m) rs[ai][m] = lds_ssq(area, lrow0 + ai * HALF + m * 16);
#pragma unroll
        for (int bj = 0; bj < 2; ++bj)
#pragma unroll
            for (int n = 0; n < 2; ++n) sh[ai][bj][n] = lds_shw(area, ai * 2 + wr, lcol0 + bj * HALF + 4 * n); }
#pragma unroll
    for (int ai = 0; ai < 2; ++ai)
#pragma unroll
        for (int m = 0; m < 4; ++m) { const int row = row0 + ai * HALF + m * 16; const float r = rstd_of(rs[ai][m]);
            float* cdst = nullptr;
            if (isx) { if (row < TP) { const int b = row >> 11, t = row & (PS - 1); if (t >= PS - 3) cdst = convp + ((size_t)b * 3 + (t - (PS - 3))) * D; }
                       else { const int mm = row - TP, b = mm >> 6, t = mm & (SS - 1); if (t >= SS - 3) cdst = convs + ((size_t)b * 3 + (t - (SS - 3))) * D; } }
#pragma unroll
            for (int bj = 0; bj < 2; ++bj) { f32x4 v0 = acc[ai][bj][m][0] * r + sh[ai][bj][0], v1 = acc[ai][bj][m][1] * r + sh[ai][bj][1]; const int c = col0 + bj * HALF;
                if (!isx) {
                    v0 = gelu_tanh4(v0); v1 = gelu_tanh4(v1);
                    *(u32x4*)(gate + (size_t)row * D + c) = pack8(v0, v1);
                } else {
                    *(u32x4*)(xb + (size_t)row * D + c) = pack8(v0, v1);
                    if (cdst) { *(f32x4*)(cdst + c) = v0; *(f32x4*)(cdst + c + 4) = v1; }
                } } }
}
struct EpiGateInP {
    static constexpr bool PERM = true, AFTER_DRAIN = false;
    bf16_t* gate; bf16_t* xb; float* convp; float* convs; const ssq_t* ssq; const float* shw;
    __device__ __forceinline__ void prefetch(PG8_LAS unsigned char* area, const Unit& u, int wid, int lane) const { prefetch_norm(area, ssq, shw, 2 * D, u.pm, u.pn, wid, lane); }
    __device__ __forceinline__ void operator()(const f32x4 (&acc)[2][2][4][2], const Unit& u, int wr, int wc, int fr, int fq, PG8_LAS unsigned char* area) const {
        gatein_body(acc, u.pm * BM + wr * 64 + fr, u.pn * BM + wc * 32 + 8 * fq, u.pn >= 8, gate, xb, convp, convs, area, wr * 64 + fr, wc * 32 + 8 * fq, wr);
    }
};
__device__ __forceinline__ void ffn13_body(const f32x4 (&acc)[2][2][4][2], int row0, int hcol0, bf16_t* __restrict__ hid, PG8_LAS unsigned char* area, int lrow0, int lcol0, int wr) {
    ssq_t rs[2][4]; f32x4 sh[2][2][2];
#pragma unroll
    for (int ai = 0; ai < 2; ++ai) {
#pragma unroll
        for (int m = 0; m < 4; ++m) rs[ai][m] = lds_ssq(area, lrow0 + ai * HALF + m * 16);
#pragma unroll
        for (int bj = 0; bj < 2; ++bj)
#pragma unroll
            for (int n = 0; n < 2; ++n) sh[ai][bj][n] = lds_shw(area, ai * 2 + wr, lcol0 + bj * HALF + 4 * n); }
#pragma unroll
    for (int ai = 0; ai < 2; ++ai)
#pragma unroll
        for (int m = 0; m < 4; ++m) { const int row = row0 + ai * HALF + m * 16; const float r = rstd_of(rs[ai][m]);
            const f32x4 a0 = acc[ai][0][m][0] * r + sh[ai][0][0], a1 = acc[ai][0][m][1] * r + sh[ai][0][1], b0 = acc[ai][1][m][0] * r + sh[ai][1][0], b1 = acc[ai][1][m][1] * r + sh[ai][1][1];
            const f32x4 h0 = a0 * sigmoid4(a0) * b0, h1 = a1 * sigmoid4(a1) * b1;
            *(u32x4*)(hid + (size_t)row * DFF + hcol0) = pack8(h0, h1); }
}
struct EpiFfn13P {
    static constexpr bool PERM = true, AFTER_DRAIN = false;
    bf16_t* hid; const ssq_t* ssq; const float* shw;
    __device__ __forceinline__ void prefetch(PG8_LAS unsigned char* area, const Unit& u, int wid, int lane) const { prefetch_norm(area, ssq, shw, 2 * DFF, u.pm, u.pn, wid, lane); }
    __device__ __forceinline__ void operator()(const f32x4 (&acc)[2][2][4][2], const Unit& u, int wr, int wc, int fr, int fq, PG8_LAS unsigned char* area) const {
        ffn13_body(acc, u.pm * BM + wr * 64 + fr, u.pn * HALF + wc * 32 + 8 * fq, hid, area, wr * 64 + fr, wc * 32 + 8 * fq, wr);
    }
};
__device__ __forceinline__ void kv_body(const f32x4 (&acc)[2][2][4][2], int row0, int col0, bool isv, bf16_t* __restrict__ kvp  , bf16_t* __restrict__ kvs  , float* __restrict__ out, PG8_LAS unsigned char* area, int lrow0) {
    ssq_t rs[2][4];
#pragma unroll
    for (int ai = 0; ai < 2; ++ai)
#pragma unroll
        for (int m = 0; m < 4; ++m) rs[ai][m] = lds_ssq(area, lrow0 + ai * HALF + m * 16);
#pragma unroll
    for (int ai = 0; ai < 2; ++ai)
#pragma unroll
        for (int m = 0; m < 4; ++m) { const int row = row0 + ai * HALF + m * 16; const float r = rstd_of(rs[ai][m]);
            float* fdst = nullptr; bf16_t* dst;
            if (row < TP) { const int b = row >> 11, t = row & (PS - 1); dst = kvp + (size_t)row * D; if (t >= PS - LEFT) fdst = out + (isv ? O_VP : O_KP) + ((size_t)b * LEFT + (t - (PS - LEFT))) * D; }
            else { const int mm = row - TP, b = mm >> 6, t = mm & (SS - 1); dst = kvs + ((size_t)b * BAND + LEFT + t) * D; fdst = out + (isv ? O_VS : O_KS) + (size_t)mm * D; }
#pragma unroll
            for (int bj = 0; bj < 2; ++bj) { const f32x4 v0 = acc[ai][bj][m][0] * r, v1 = acc[ai][bj][m][1] * r; const int c = col0 + bj * HALF;
                *(u32x4*)(dst + c) = pack8(v0, v1);
                if (fdst) { *(f32x4*)(fdst + c) = v0; *(f32x4*)(fdst + c + 4) = v1; } } }
}
struct EpiKVP {
    static constexpr bool PERM = true, AFTER_DRAIN = false;
    bf16_t* kb; bf16_t* vb; bf16_t* ks; bf16_t* vs; float* out; const ssq_t* ssq;
    __device__ __forceinline__ void prefetch(PG8_LAS unsigned char* area, const Unit& u, int wid, int lane) const { prefetch_norm(area, ssq, nullptr, 0, u.pm, u.pn, wid, lane); }
    __device__ __forceinline__ void operator()(const f32x4 (&acc)[2][2][4][2], const Unit& u, int wr, int wc, int fr, int fq, PG8_LAS unsigned char* area) const {
        const bool isv = u.pn >= 8;
        kv_body(acc, u.pm * BM + wr * 64 + fr, (isv ? u.pn - 8 : u.pn) * BM + wc * 32 + 8 * fq, isv, isv ? vb : kb, isv ? vs : ks, out, area, wr * 64 + fr);
    }
};
__device__ __forceinline__ void q_body(const f32x4 (&acc)[2][2][4][2], int row0, int col0, bf16_t* __restrict__ q, PG8_LAS unsigned char* area, int lrow0, int lcol0, int wr) {
    ssq_t rs[2][4]; f32x4 sh[2][2][2];
#pragma unroll
    for (int ai = 0; ai < 2; ++ai) {
#pragma unroll
        for (int m = 0; m < 4; ++m) rs[ai][m] = lds_ssq(area, lrow0 + ai * HALF + m * 16);
#pragma unroll
        for (int bj = 0; bj < 2; ++bj)
#pragma unroll
            for (int n = 0; n < 2; ++n) sh[ai][bj][n] = lds_shw(area, ai * 2 + wr, lcol0 + bj * HALF + 4 * n); }
#pragma unroll
    for (int ai = 0; ai < 2; ++ai)
#pragma unroll
        for (int m = 0; m < 4; ++m) { const int row = row0 + ai * HALF + m * 16; const float r = rstd_of(rs[ai][m]);
#pragma unroll
            for (int bj = 0; bj < 2; ++bj) *(u32x4*)(q + (size_t)row * D + col0 + bj * HALF) = pack8(acc[ai][bj][m][0] * r + sh[ai][bj][0], acc[ai][bj][m][1] * r + sh[ai][bj][1]); }
}
struct EpiQP {
    static constexpr bool PERM = true, AFTER_DRAIN = false;
    bf16_t* q; const ssq_t* ssq; const float* shw;
    __device__ __forceinline__ void prefetch(PG8_LAS unsigned char* area, const Unit& u, int wid, int lane) const { prefetch_norm(area, ssq, shw, D, u.pm, u.pn, wid, lane); }
    __device__ __forceinline__ void operator()(const f32x4 (&acc)[2][2][4][2], const Unit& u, int wr, int wc, int fr, int fq, PG8_LAS unsigned char* area) const {
        q_body(acc, u.pm * BM + wr * 64 + fr, u.pn * BM + wc * 32 + 8 * fq, q, area, wr * 64 + fr, wc * 32 + 8 * fq, wr);
    }
};

template <class Epi, class Sched, bool ALIGN_EPI = false, bool SP2 = false, int AUXA = 0, int AUXB = 0  >
__device__ __forceinline__ void gemm_phase(PG8_LAS unsigned char* lds, const Gemm g, const Sched& S, const Epi& E, int tid_in) {
    int tid_ = tid_in; asm volatile("" : "+v"(tid_));
    const int tid = tid_, wid = __builtin_amdgcn_readfirstlane(tid >> 6), lane = tid & 63, wr = wid >> 2, wc = wid & 3, fr = lane & 15, fq = lane >> 4;
    const int K = g.K, nt = K / BK;
    unsigned voffA[2], voffB[2];
#pragma unroll
    for (int i = 0; i < 2; ++i) { int R, C; stage_rc(tid * 16 + i * 8192, R, C); const int Rb = Epi::PERM ? ((R & ~31) + perm32(R & 31)) : R;
        voffA[i] = (unsigned)(R * K + C) * 2u; voffB[i] = (unsigned)(Rb * K + C) * 2u; }
    const size_t kstep = (size_t)(BK * 2);
    const size_t hstep = (size_t)HALF * K * 2;
    const size_t tstep = 2 * hstep;
    const unsigned ldsw = (unsigned)wid * 1024u;
    const int aoff = lds_byte(wr * 64 + fr, fq * 8), boff = lds_byte(wc * 32 + fr, fq * 8);
#define PG8_SA(b, h) (((b) * 2 + (h)) * HTB)
#define PG8_SB(b, h) ((4 + (b) * 2 + (h)) * HTB)
    constexpr int AUX_voffA = AUXA, AUX_voffB = AUXB;
#define PG8_STAGE(bufoff, gbase, voff) do { _Pragma("unroll") for (int _i = 0; _i < 2; ++_i) \
        __builtin_amdgcn_global_load_lds((const unsigned*)((const char*)(gbase) + (voff)[_i]), (PG8_LAS unsigned*)(lds + (bufoff) + ldsw + _i * 8192), 16, 0, AUX_##voff); } while (0)
#define PG8_LDA(dst, b, h) do { _Pragma("unroll") for (int m = 0; m < 4; ++m) _Pragma("unroll") for (int k = 0; k < 2; ++k) dst[m][k] = *(const PG8_LAS bf16x8*)(lds + PG8_SA(b, h) + aoff + m * 2048 + k * 1024); } while (0)
#define PG8_LDB(dst, b, h) do { _Pragma("unroll") for (int n = 0; n < 2; ++n) _Pragma("unroll") for (int k = 0; k < 2; ++k) dst[n][k] = *(const PG8_LAS bf16x8*)(lds + PG8_SB(b, h) + boff + n * 2048 + k * 1024); } while (0)
#define PG8_MMA(ai, bj, At, Bt) do { __builtin_amdgcn_s_setprio(1); _Pragma("unroll") for (int m = 0; m < 4; ++m) _Pragma("unroll") for (int n = 0; n < 2; ++n) _Pragma("unroll") for (int k = 0; k < 2; ++k) \
        acc[ai][bj][m][n] = __builtin_amdgcn_mfma_f32_16x16x32_bf16(Bt[n][k], At[m][k], acc[ai][bj][m][n], 0, 0, 0); __builtin_amdgcn_s_setprio(0); } while (0)
#define PG8_WAIT_V(n) asm volatile("s_waitcnt vmcnt(" #n ")" ::: "memory")
#define PG8_WAIT_L(n) asm volatile("s_waitcnt lgkmcnt(" #n ")" ::: "memory")
#define PG8_BAR __builtin_amdgcn_s_barrier()
#define PG8_SCHED __builtin_amdgcn_sched_barrier(0)
    Unit cur, nxt; int ui = 0;
    if (!S.next(0, cur)) return;
    f32x4 acc[2][2][4][2];
#pragma unroll
    for (int a = 0; a < 2; ++a)
#pragma unroll
        for (int b = 0; b < 2; ++b)
#pragma unroll
            for (int m = 0; m < 4; ++m)
#pragma unroll
                for (int n = 0; n < 2; ++n) acc[a][b][m][n] = (f32x4){0.f, 0.f, 0.f, 0.f};
    bf16x8 At[4][2], B0[2][2], B1[2][2];
    const char* cA = (const char*)g.A + (size_t)cur.pm * tstep; const char* cB = (const char*)g.Bt + (size_t)cur.pn * tstep;
    S.a_ready(cur);
    if constexpr (SP2) {
        PG8_STAGE(PG8_SB(0, 0), cB, voffB); PG8_STAGE(PG8_SB(0, 1), cB + hstep, voffB); PG8_STAGE(PG8_SA(0, 0), cA, voffA); PG8_STAGE(PG8_SA(0, 1), cA + hstep, voffA);
        if (wr == 1) PG8_BAR;
        PG8_WAIT_V(2); PG8_BAR;
        PG8_STAGE(PG8_SB(1, 0), cB + kstep, voffB); PG8_STAGE(PG8_SA(1, 0), cA + kstep, voffA); PG8_STAGE(PG8_SB(1, 1), cB + hstep + kstep, voffB);
        PG8_WAIT_V(6); PG8_BAR;
    } else {
        PG8_STAGE(PG8_SB(0, 0), cB, voffB); PG8_STAGE(PG8_SA(0, 0), cA, voffA); PG8_STAGE(PG8_SB(0, 1), cB + hstep, voffB); PG8_STAGE(PG8_SA(0, 1), cA + hstep, voffA);
        if (wr == 1) PG8_BAR;
        PG8_WAIT_V(4); PG8_BAR;
        PG8_STAGE(PG8_SB(1, 0), cB + kstep, voffB); PG8_STAGE(PG8_SA(1, 0), cA + kstep, voffA); PG8_STAGE(PG8_SB(1, 1), cB + hstep + kstep, voffB);
        PG8_WAIT_V(6); PG8_BAR;
    }
    for (;;) {
        const bool has_next = S.next(ui + 1, nxt);
        const char* nA = has_next ? (const char*)g.A + (size_t)nxt.pm * tstep : cA; const char* nB = has_next ? (const char*)g.Bt + (size_t)nxt.pn * tstep : cB;
        PG8_LAS unsigned char* epi_lds = lds + EPI_LDS_OFF + (ui & 1) * EPI_LDS_HALF;
        E.prefetch(epi_lds, cur, wid, lane);
        for (int t = 0; t < nt; t += 2) {
            const bool last = (t == nt - 2);
            const char* a1 = cA + (size_t)(t + 1) * kstep;
            const char* a2 = last ? nA : cA + (size_t)(t + 2) * kstep; const char* b2 = last ? nB : cB + (size_t)(t + 2) * kstep;
            const char* a3 = a2 + kstep; const char* b3 = b2 + kstep;
            if (last && has_next) S.a_ready(nxt);
            if constexpr (SP2) {
            PG8_LDB(B0, 0, 0); PG8_LDB(B1, 0, 1); PG8_SCHED; PG8_LDA(At, 0, 0); PG8_STAGE(PG8_SA(1, 1), a1 + hstep, voffA);
            PG8_WAIT_V(8); PG8_WAIT_L(0); PG8_BAR; PG8_MMA(0, 0, At, B0); PG8_MMA(0, 1, At, B1); PG8_BAR; PG8_SCHED;
            PG8_LDA(At, 0, 1); PG8_STAGE(PG8_SB(0, 0), b2, voffB); PG8_STAGE(PG8_SB(0, 1), b2 + hstep, voffB); PG8_STAGE(PG8_SA(0, 0), a2, voffA);
            PG8_WAIT_V(8); PG8_WAIT_L(0); PG8_BAR; PG8_MMA(1, 0, At, B0); PG8_MMA(1, 1, At, B1); PG8_BAR; PG8_SCHED;
            PG8_LDB(B0, 1, 0); PG8_LDB(B1, 1, 1); PG8_SCHED; PG8_LDA(At, 1, 0); PG8_STAGE(PG8_SA(0, 1), a2 + hstep, voffA);
            PG8_WAIT_V(8); PG8_WAIT_L(0); PG8_BAR; PG8_MMA(0, 0, At, B0); PG8_MMA(0, 1, At, B1); PG8_BAR; PG8_SCHED;
            PG8_LDA(At, 1, 1); PG8_STAGE(PG8_SB(1, 0), b3, voffB); PG8_STAGE(PG8_SB(1, 1), b3 + hstep, voffB); PG8_STAGE(PG8_SA(1, 0), a3, voffA);
            PG8_WAIT_V(8); PG8_WAIT_L(0); PG8_BAR; PG8_MMA(1, 0, At, B0); PG8_MMA(1, 1, At, B1); PG8_BAR; PG8_SCHED;
            } else {
            PG8_LDB(B0, 0, 0); PG8_SCHED; PG8_LDA(At, 0, 0); PG8_STAGE(PG8_SA(1, 1), a1 + hstep, voffA);
            PG8_WAIT_L(8); PG8_BAR; PG8_WAIT_L(0); PG8_MMA(0, 0, At, B0); PG8_BAR; PG8_SCHED;
            PG8_LDB(B1, 0, 1); PG8_STAGE(PG8_SB(0, 0), b2, voffB);
            PG8_BAR; PG8_WAIT_L(0); PG8_MMA(0, 1, At, B1); PG8_BAR;
            PG8_LDA(At, 0, 1); PG8_STAGE(PG8_SA(0, 0), a2, voffA);
            PG8_BAR; PG8_WAIT_L(0); PG8_MMA(1, 0, At, B0); PG8_BAR; PG8_SCHED;
            PG8_STAGE(PG8_SB(0, 1), b2 + hstep, voffB);
            PG8_WAIT_V(6); PG8_BAR; PG8_MMA(1, 1, At, B1); PG8_BAR;
            PG8_LDB(B0, 1, 0); PG8_SCHED; PG8_LDA(At, 1, 0); PG8_STAGE(PG8_SA(0, 1), a2 + hstep, voffA);
            PG8_WAIT_L(8); PG8_BAR; PG8_WAIT_L(0); PG8_MMA(0, 0, At, B0); PG8_BAR; PG8_SCHED;
            PG8_LDB(B1, 1, 1); PG8_STAGE(PG8_SB(1, 0), b3, voffB);
            PG8_BAR; PG8_WAIT_L(0); PG8_MMA(0, 1, At, B1); PG8_BAR;
            PG8_LDA(At, 1, 1); PG8_STAGE(PG8_SA(1, 0), a3, voffA);
            PG8_BAR; PG8_WAIT_L(0); PG8_MMA(1, 0, At, B0); PG8_BAR; PG8_SCHED;
            PG8_STAGE(PG8_SB(1, 1), b3 + hstep, voffB);
            PG8_WAIT_V(6); PG8_BAR; PG8_MMA(1, 1, At, B1); PG8_BAR;
            }
        }
        if constexpr (ALIGN_EPI) { if (wr == 0) PG8_BAR; }
        if constexpr (!Epi::AFTER_DRAIN) { E(acc, cur, wr, wc, fr, fq, epi_lds); S.done(cur); }
        if (!has_next) break;
#pragma unroll
        for (int a = 0; a < 2; ++a)
#pragma unroll
            for (int b = 0; b < 2; ++b)
#pragma unroll
                for (int m = 0; m < 4; ++m)
#pragma unroll
                    for (int n = 0; n < 2; ++n) acc[a][b][m][n] = (f32x4){0.f, 0.f, 0.f, 0.f};
        cur = nxt; cA = nA; cB = nB; ++ui;
        if constexpr (ALIGN_EPI) { if (wr == 1) PG8_BAR; }
    }
    PG8_WAIT_V(0);
    if constexpr (!ALIGN_EPI) { if (wr == 0) PG8_BAR; }
    PG8_BAR;
    if constexpr (Epi::AFTER_DRAIN) { E.fused(acc, cur, wr, wc, fr, fq, lds, wid, lane); S.done(cur); }
#undef PG8_SA
#undef PG8_SB
#undef PG8_STAGE
#undef PG8_LDA
#undef PG8_LDB
#undef PG8_MMA
#undef PG8_WAIT_V
#undef PG8_WAIT_L
#undef PG8_BAR
#undef PG8_SCHED
}
}
#undef LAS
#define LAS __attribute__((address_space(3)))
#define XB_TMO      128
#define XB_XCNT(j)  (256  + 64 * (j))
#define XB_XSUB(j)  (1280 + 64 * (j))
#define XB_XGEN(j)  (2304 + 64 * (j))
#define XB_TOP      3328
#define XB_TOPGEN   3392
#define XCD_BAR_WORDS 3456
#define XB_SPIN_CAP (1u << 22)

__device__ __forceinline__ unsigned xb_ld(unsigned* p)              { return __hip_atomic_load(p, __ATOMIC_RELAXED, __HIP_MEMORY_SCOPE_AGENT); }
__device__ __forceinline__ unsigned xb_add(unsigned* p, unsigned v) { return __hip_atomic_fetch_add(p, v, __ATOMIC_RELAXED, __HIP_MEMORY_SCOPE_AGENT); }
__device__ __forceinline__ unsigned xb_xcc_id() { return (unsigned)__builtin_amdgcn_s_getreg((3 << 11) | 20) & 0xFu; }
#define XB_SPIN(cond, bar) do { unsigned _sp = 0; while (cond) { __builtin_amdgcn_s_sleep(1); \
    if ((++_sp & 255u) == 0u) { if (xb_ld(&(bar)[XB_TMO])) break; if (_sp > XB_SPIN_CAP) { atomicAdd(&(bar)[XB_TMO], 1u); break; } } } } while (0)

struct XcdBarrier {
    unsigned* bar; unsigned x;
    volatile LAS unsigned* st;
};

__device__ __forceinline__ XcdBarrier xcd_barrier_post(unsigned* bar, volatile LAS unsigned* st) {
    XcdBarrier b; b.bar = bar; b.x = xb_xcc_id(); b.st = st;
    if (threadIdx.x == 0) (void)xb_add(&bar[XB_XCNT(b.x)], 1u);
    return b;
}
__device__ __forceinline__ void xcd_barrier_complete(unsigned* bar, unsigned x, unsigned& nloc, unsigned& nx) {
    const unsigned G = gridDim.x * gridDim.y * gridDim.z;
    unsigned sum, cnt, mine, sp = 0u;
    for (;;) {
        sum = 0u; cnt = 0u; mine = 0u;
#pragma unroll
        for (unsigned j = 0; j < 16; ++j) { const unsigned c = xb_ld(&bar[XB_XCNT(j)]); sum += c; cnt += (c > 0u) ? 1u : 0u; mine = (j == x) ? c : mine; }
        if (sum == G) break;
        __builtin_amdgcn_s_sleep(1);
        if ((++sp & 255u) == 0u) { if (xb_ld(&bar[XB_TMO])) break; if (sp > XB_SPIN_CAP) { atomicAdd(&bar[XB_TMO], 1u); break; } }
    }
    nloc = mine > 0u ? mine : 1u; nx = cnt > 0u ? cnt : 1u;
}

__device__ __forceinline__ void xcd_barrier(const XcdBarrier& b) {
    asm volatile("s_waitcnt vmcnt(0)" ::: "memory");
    __syncthreads();
    if (threadIdx.x == 0) {
        unsigned* bar = b.bar;
        __builtin_amdgcn_s_waitcnt(0);
        unsigned nloc = b.st[0], nx = b.st[1];
        if (nloc == 0u) { xcd_barrier_complete(bar, b.x, nloc, nx); b.st[0] = nloc; b.st[1] = nx; }
        const unsigned old = xb_add(&bar[XB_XSUB(b.x)], 1u);
        const unsigned gen = old / nloc;
        if (old + 1u == (gen + 1u) * nloc) {
            __builtin_amdgcn_fence(__ATOMIC_RELEASE, "agent");
            asm volatile("s_waitcnt vmcnt(0)" ::: "memory");
            const unsigned og = xb_add(&bar[XB_TOP], 1u);
            const unsigned tg = og / nx;
            if (og + 1u == (tg + 1u) * nx) xb_add(&bar[XB_TOPGEN], 1u);
            else XB_SPIN(xb_ld(&bar[XB_TOPGEN]) == tg, bar);
            __builtin_amdgcn_fence(__ATOMIC_ACQUIRE, "agent");
            xb_add(&bar[XB_XGEN(b.x)], 1u);
            asm volatile("s_waitcnt vmcnt(0)" ::: "memory");
        } else {
            XB_SPIN(xb_ld(&bar[XB_XGEN(b.x)]) == gen, bar);
            __builtin_amdgcn_fence(__ATOMIC_ACQUIRE, "agent");
            asm volatile("s_waitcnt vmcnt(0)" ::: "memory");
        }
    }
    __syncthreads();
}
namespace att {
typedef short s16x4 __attribute__((ext_vector_type(4)));
typedef float f32x16 __attribute__((ext_vector_type(16)));
constexpr int SHM_V = 16384, SHM_K = 16384;
constexpr int OFF_V = 0, OFF_K = 2 * SHM_V, OFF_WS = OFF_K + 2 * SHM_K, OFF_TB = OFF_WS + 8 * 64 * 4;
constexpr float SCALE = 0.088388347648318440f, LOG2E = 1.4426950408889634f, CS = SCALE * LOG2E;
constexpr float THR2 = 8.0f * LOG2E;
#define KSWZ(row, colB) ((row) * 256 + ((colB) ^ (((row) & 7) << 4)))
#define SBAR() __builtin_amdgcn_sched_barrier(0)
__device__ __forceinline__ int crow(int r, int hi) { return (r & 3) + 8 * (r >> 2) + 4 * hi; }
__device__ __forceinline__ unsigned cvtpk(float lo, float hi) { unsigned r; asm volatile("v_cvt_pk_bf16_f32 %0, %1, %2" : "=v"(r) : "v"(lo), "v"(hi)); return r; }
__device__ __forceinline__ void qkt(f32x16& p0, f32x16& p1, const char* Ks, const bf16x8* qr, int r32, int hi) {
  p0 = f32x16{}; p1 = f32x16{};
#pragma unroll
  for (int d0 = 0; d0 < 8; ++d0) { const int cb = (d0 * 16 + hi * 8) * 2;
    const bf16x8 b0 = *reinterpret_cast<const bf16x8*>(Ks + KSWZ(r32, cb));
    const bf16x8 b1 = *reinterpret_cast<const bf16x8*>(Ks + KSWZ(32 + r32, cb));
    p0 = __builtin_amdgcn_mfma_f32_32x32x16_bf16(b0, qr[d0], p0, 0, 0, 0);
    p1 = __builtin_amdgcn_mfma_f32_32x32x16_bf16(b1, qr[d0], p1, 0, 0, 0); }
}
__device__ __forceinline__ int v_st(int k, int c) { const int kk = (k & ~0xC) | ((k & 4) << 1) | ((k & 8) >> 1); return ((kk >> 3) * 4 + (c >> 5)) * 512 + ((kk & 7) * 32 + (c & 31)) * 2; }
__device__ __forceinline__ int v_rd_base(int lane) { return ((lane & 3) << 3) | (((lane >> 2) & 3) << 6) | (((lane >> 4) & 1) << 5) | (((lane >> 5) & 1) << 8); }
constexpr int v_rd_off(int d0, int ks, int half) { return d0 * 512 + ks * 4096 + half * 2048; }
template <int OFF> __device__ __forceinline__ s16x4 tr_read(int vb) { s16x4 r; asm volatile("ds_read_b64_tr_b16 %0, %1 offset:%2" : "=&v"(r) : "v"(vb), "i"(OFF) : "memory"); return r; }
template <int D0> __device__ __forceinline__ void pv_one(f32x16& od, int vb, bf16x8 pa0, bf16x8 pa1, bf16x8 pa2, bf16x8 pa3) {
  const s16x4 l0 = tr_read<v_rd_off(D0, 0, 0)>(vb), h0 = tr_read<v_rd_off(D0, 0, 1)>(vb), l1 = tr_read<v_rd_off(D0, 1, 0)>(vb), h1 = tr_read<v_rd_off(D0, 1, 1)>(vb);
  const s16x4 l2 = tr_read<v_rd_off(D0, 2, 0)>(vb), h2 = tr_read<v_rd_off(D0, 2, 1)>(vb), l3 = tr_read<v_rd_off(D0, 3, 0)>(vb), h3 = tr_read<v_rd_off(D0, 3, 1)>(vb);
  asm volatile("s_waitcnt lgkmcnt(0)" ::: "memory"); SBAR();
#define PK(L, H) (bf16x8){L[0], L[1], L[2], L[3], H[0], H[1], H[2], H[3]}
  od = __builtin_amdgcn_mfma_f32_32x32x16_bf16(pa0, PK(l0, h0), od, 0, 0, 0);
  od = __builtin_amdgcn_mfma_f32_32x32x16_bf16(pa1, PK(l1, h1), od, 0, 0, 0);
  od = __builtin_amdgcn_mfma_f32_32x32x16_bf16(pa2, PK(l2, h2), od, 0, 0, 0);
  od = __builtin_amdgcn_mfma_f32_32x32x16_bf16(pa3, PK(l3, h3), od, 0, 0, 0);
#undef PK
}
__device__ __forceinline__ void band_unit(const bf16_t* __restrict__ Qb, bf16_t* __restrict__ Ob, const bf16_t* __restrict__ Kh, const bf16_t* __restrict__ Vh, const float* __restrict__ relb, int h, int c0, int nw, char* lds, int tid_in) {
  int tid = tid_in; asm volatile("" : "+v"(tid));
  const int wid = __builtin_amdgcn_readfirstlane(tid >> 6), lane = tid & 63, r32 = lane & 31, hi = lane >> 5;
  char* V_lds = lds + OFF_V; char* K_lds = lds + OFF_K;
  float* wsf = (float*)(lds + OFF_WS) + wid * 64; float* li_l = wsf; float* al_l = wsf + 32; float* tb = (float*)(lds + OFF_TB);
  const bool won = wid < nw; const int cw = c0 + (wid >> 1);
  const int t_lo = c0 > 8 ? c0 - 8 : 0, t_hi = c0 + ((nw + 1) >> 1) - 1;
  if (tid < 257) tb[tid] = relb[tid * NH + h] * LOG2E;
  float m_reg = -1e30f, l_reg = 0.f; f32x16 o[4] = {}; bf16x8 qr[8];
  { const bf16_t* Qw = Qb + (size_t)((won ? wid : 0) * 32 + r32) * D + hi * 8;
#pragma unroll
    for (int d0 = 0; d0 < 8; ++d0) qr[d0] = *reinterpret_cast<const bf16x8*>(Qw + d0 * 16); }
  const int sr = tid >> 4, sc = (tid & 15) * 8, vst0 = v_st(sr, sc), vst1 = v_st(32 + sr, sc);
  const int vb0 = (int)(uintptr_t)V_lds + v_rd_base(lane);
  bf16x8 vs0, vs1, ks0, ks1;
#define SLOAD(k0) do { vs0 = *reinterpret_cast<const bf16x8*>(&Vh[(size_t)((k0) + sr) * D + sc]); vs1 = *reinterpret_cast<const bf16x8*>(&Vh[(size_t)((k0) + 32 + sr) * D + sc]); \
    ks0 = *reinterpret_cast<const bf16x8*>(&Kh[(size_t)((k0) + sr) * D + sc]); ks1 = *reinterpret_cast<const bf16x8*>(&Kh[(size_t)((k0) + 32 + sr) * D + sc]); } while (0)
#define SWRITE(b) do { *(bf16x8*)(V_lds + (b) * SHM_V + vst0) = vs0; *(bf16x8*)(V_lds + (b) * SHM_V + vst1) = vs1; const int kc = sc * 2; \
    *(bf16x8*)(K_lds + (b) * SHM_K + KSWZ(sr, kc)) = ks0; *(bf16x8*)(K_lds + (b) * SHM_K + KSWZ(32 + sr, kc)) = ks1; } while (0)
  SLOAD(t_lo * 64); asm volatile("s_waitcnt vmcnt(0)" ::: "memory"); SWRITE(0); __syncthreads();
  for (int t = t_lo; t <= t_hi; ++t) {
    const int buf = (t - t_lo) & 1;
    if (t < t_hi) SLOAD((t + 1) * 64);
    const int dch = cw - t;
    if (won && dch >= 0 && dch <= 8) {
      f32x16 p0, p1;
      qkt(p0, p1, K_lds + buf * SHM_K, qr, r32, hi);
      if (dch >= 3) { const float bc = tb[256];
#pragma unroll
        for (int r = 0; r < 16; ++r) { p0[r] = fmaf(p0[r], CS, bc); p1[r] = fmaf(p1[r], CS, bc); } }
      else { const int base = 64 * dch + 32 * (wid & 1) + r32 - 4 * hi;
#pragma unroll
        for (int r = 0; r < 16; ++r) { const int j0 = (r & 3) + 8 * (r >> 2); int i0 = base - j0, i1 = base - 32 - j0; i0 = (i0 > 128 ? 128 : i0) + 128; i1 = (i1 > 128 ? 128 : i1) + 128;
          p0[r] = fmaf(p0[r], CS, tb[i0]); p1[r] = fmaf(p1[r], CS, tb[i1]); } }
      float pmax = p0[0];
#pragma unroll
      for (int r = 1; r < 16; ++r) pmax = fmaxf(pmax, p0[r]);
#pragma unroll
      for (int r = 0; r < 16; ++r) pmax = fmaxf(pmax, p1[r]);
      { auto rr = __builtin_amdgcn_permlane32_swap(__float_as_uint(pmax), __float_as_uint(pmax), false, false); pmax = fmaxf(__uint_as_float(rr[0]), __uint_as_float(rr[1])); }
      float mn, alpha;
      if (__all(pmax - m_reg <= THR2)) { mn = m_reg; alpha = 1.f; } else { mn = fmaxf(m_reg, pmax); alpha = __builtin_amdgcn_exp2f(m_reg - mn); m_reg = mn; }
      float ps = 0.f;
#pragma unroll
      for (int r = 0; r < 16; ++r) { p0[r] = __builtin_amdgcn_exp2f(p0[r] - mn); p1[r] = __builtin_amdgcn_exp2f(p1[r] - mn); ps += p0[r] + p1[r]; }
      { auto rr = __builtin_amdgcn_permlane32_swap(__float_as_uint(ps), __float_as_uint(ps), false, false); ps = __uint_as_float(rr[0]) + __uint_as_float(rr[1]); }
      l_reg = l_reg * alpha + ps;
      if (__any(alpha < 1.f)) { if (hi == 0) al_l[r32] = alpha; asm volatile("s_waitcnt lgkmcnt(0)" ::: "memory");
#pragma unroll
        for (int d = 0; d < 4; ++d)
#pragma unroll
          for (int r = 0; r < 16; ++r) o[d][r] *= al_l[crow(r, hi)]; }
      bf16x8 pa0, pa1, pa2, pa3;
#define PK4(P, BASE, OUT) do { unsigned a0 = cvtpk(P[BASE + 0], P[BASE + 1]), a1 = cvtpk(P[BASE + 2], P[BASE + 3]); unsigned b0 = cvtpk(P[BASE + 4], P[BASE + 5]), b1 = cvtpk(P[BASE + 6], P[BASE + 7]); \
    auto r0 = __builtin_amdgcn_permlane32_swap(a0, b0, false, false); auto r1 = __builtin_amdgcn_permlane32_swap(a1, b1, false, false); u32x4 w = {r0[0], r1[0], r0[1], r1[1]}; OUT = *reinterpret_cast<bf16x8*>(&w); } while (0)
      PK4(p0, 0, pa0); PK4(p0, 8, pa1); PK4(p1, 0, pa2); PK4(p1, 8, pa3);
#undef PK4
      const int vb = vb0 + buf * SHM_V;
      pv_one<0>(o[0], vb, pa0, pa1, pa2, pa3); pv_one<1>(o[1], vb, pa0, pa1, pa2, pa3); pv_one<2>(o[2], vb, pa0, pa1, pa2, pa3); pv_one<3>(o[3], vb, pa0, pa1, pa2, pa3);
    }
    if (t < t_hi) { asm volatile("s_waitcnt vmcnt(0)" ::: "memory"); SWRITE(buf ^ 1); }
    __syncthreads();
  }
  if (hi == 0) li_l[r32] = l_reg; asm volatile("s_waitcnt lgkmcnt(0)" ::: "memory");
  if (won) {
    char* ost = lds + wid * 8192;
#pragma unroll
    for (int r = 0; r < 16; ++r) { const int orow = crow(r, hi); const float rl = __builtin_amdgcn_rcpf(li_l[orow]);
#pragma unroll
      for (int d0 = 0; d0 < 4; ++d0) *(bf16_t*)(ost + orow * 256 + (d0 * 32 + r32) * 2) = (bf16_t)f2bf(o[d0][r] * rl); }
    asm volatile("s_waitcnt lgkmcnt(0)" ::: "memory");
    bf16_t* Ow = Ob + (size_t)(wid * 32) * D;
#pragma unroll
    for (int k = 0; k < 8; ++k) { const int row = (lane >> 4) + 4 * k, c16 = lane & 15; const u32x4 v = *(const u32x4*)(ost + row * 256 + c16 * 16); *(u32x4*)(Ow + (size_t)row * D + c16 * 8) = v; }
  }
  __syncthreads();
#undef SLOAD
#undef SWRITE
}
#undef KSWZ
#undef SBAR

__device__ __forceinline__ void attn_phase(char* lds, const bf16_t* Q, bf16_t* O, const bf16_t* Kp, const bf16_t* Vp, const bf16_t* Ks, const bf16_t* Vs, const float* relb, int vcu, int G, int tid) {
  for (int bh = vcu; bh < PB * NH; bh += G) { const int b = bh >> 4, h = bh & 15;
    const bf16_t* Kh = Kp + (size_t)b * PS * D + h * HD; const bf16_t* Vh = Vp + (size_t)b * PS * D + h * HD;
    for (int qb = 0; qb < 8; ++qb) band_unit(Q + ((size_t)b * PS + qb * 256) * D + h * HD, O + ((size_t)b * PS + qb * 256) * D + h * HD, Kh, Vh, relb, h, 4 * qb, 8, lds, tid); }
  for (int u = vcu; u < SB * NH; u += G) { const int b = u >> 4, h = u & 15;
    band_unit(Q + ((size_t)TP + (size_t)b * SS) * D + h * HD, O + ((size_t)TP + (size_t)b * SS) * D + h * HD, Ks + (size_t)b * BAND * D + h * HD, Vs + (size_t)b * BAND * D + h * HD, relb, h, 8, 2, lds, tid); }
}
}

namespace rg {
constexpr int XP = 264, GP = 136;
constexpr int OFF_XB = 0, OFF_XC = 35840, OFF_GT = 69632, OFF_CW = 87040;
constexpr float LOG2E = 1.4426950408889634f;
__device__ __forceinline__ float softplus_neg(float l) {
    const float y = __expf(-fabsf(l)); const float lp = y < 0.02f ? y * (1.f - y * (0.5f - y * (0.33333334f - 0.25f * y))) : __logf(1.f + y); return (l > 0.f ? 0.f : -l) + lp; }
__device__ __forceinline__ float neg_expm1(float x) {
    const float s = -x * (1.f + x * (0.5f + x * (0.16666667f + x * (0.041666668f + x * (0.0083333338f + x * 0.0013888889f))))); const float e = 1.f - __expf(x); return x > -0.3f ? s : e; }
__device__ __forceinline__ float neg_expm1_series(float x) { return -x * (1.f + x * (0.5f + x * (0.16666667f + x * (0.041666668f + x * (0.0083333338f + x * 0.0013888889f))))); }
__device__ __forceinline__ float bperm(float v, int addr) { return __int_as_float(__builtin_amdgcn_ds_bpermute(addr, __float_as_int(v))); }
__device__ __forceinline__ bf16x8 cvt8(const float* p) { const f32x4 a = *(const f32x4*)p, b = *(const f32x4*)(p + 4); u32x4 w; w.x = pk2(a[0], a[1]); w.y = pk2(a[2], a[3]); w.z = pk2(b[0], b[1]); w.w = pk2(b[2], b[3]); return *reinterpret_cast<bf16x8*>(&w); }

__device__ __forceinline__ void rg_unit(char* lds, const bf16_t* __restrict__ xb, const bf16_t* __restrict__ gin, bf16_t* __restrict__ hgo, const bf16_t* __restrict__ wai, const float* __restrict__ cw, const float* __restrict__ cb,
                                        const float* __restrict__ b_a, const float* __restrict__ b_i, const float* __restrict__ lam, const float* __restrict__ sconv, const float* __restrict__ h0p, float* __restrict__ rnn_out,
                                        size_t m0, int nchunks, int cbase, int hf, bool pos0, int tid_in) {
    int tid = tid_in; asm volatile("" : "+v"(tid));
    const int wid = __builtin_amdgcn_readfirstlane(tid >> 6), lane = tid & 63, fr = lane & 15, fq = lane >> 4;
    bf16_t* XB = (bf16_t*)(lds + OFF_XB); bf16_t* XC = (bf16_t*)(lds + OFF_XC); bf16_t* GT = (bf16_t*)(lds + OFF_GT); float* CW = (float*)(lds + OFF_CW);
    const int chl = hf * 128 + 16 * wid + fr, ch = cbase + chl, gcol = cbase + hf * 128;
    bf16x8 Bf[2][8];
#pragma unroll
    for (int nt = 0; nt < 2; ++nt)
#pragma unroll
        for (int ks = 0; ks < 8; ++ks) Bf[nt][ks] = *reinterpret_cast<const bf16x8*>(wai + (size_t)(2 * chl + nt) * 256 + 32 * ks + 8 * fq);
    if (tid < 256) {
#pragma unroll
        for (int k = 0; k < 4; ++k) CW[k * 256 + tid] = cw[k * D + cbase + tid];
        CW[4 * 256 + tid] = cb[cbase + tid]; }
    const float ba = b_a[ch], bi = b_i[ch], sp = softplus_neg(lam[ch]), c8l = -8.f * sp * LOG2E, c2 = -16.f * sp;
    float H = h0p ? h0p[ch] : 0.f;
    const bool small_x = __all(c2 > -0.3f);
#pragma unroll
    for (int i = 0; i < 5; ++i) { const int p = tid + 512 * i; if (p < 67 * 32) { const int row = p >> 5, pc = p & 31; bf16x8 v;
        if (row >= 3) v = *reinterpret_cast<const bf16x8*>(xb + (m0 + row - 3) * D + cbase + 8 * pc);
        else if (sconv) v = cvt8(sconv + (size_t)row * D + cbase + 8 * pc); else v = (bf16x8){0, 0, 0, 0, 0, 0, 0, 0};
        *reinterpret_cast<bf16x8*>(XB + row * XP + 8 * pc) = v; } }
#pragma unroll
    for (int i = 0; i < 2; ++i) { const int p = tid + 512 * i, row = p >> 4, pc = p & 15; *reinterpret_cast<bf16x8*>(GT + row * GP + 8 * pc) = *reinterpret_cast<const bf16x8*>(gin + (m0 + row) * D + gcol + 8 * pc); }
    __syncthreads();
    const int a16 = (lane >= 16 ? lane - 16 : lane) << 2, a32 = (lane >= 32 ? lane - 32 : lane) << 2, a48 = (fr + 48) << 2;
    for (int c = 0; c < nchunks; ++c) {
        const size_t mc = m0 + (size_t)c * 64; const bool more = c + 1 < nchunks;
        { const int pc = tid & 31, r4 = (tid >> 5) * 4; f32x2 y[4][4], wk[4][4];
          { const f32x4 b0 = *(const f32x4*)(CW + 4 * 256 + 8 * pc), b1 = *(const f32x4*)(CW + 4 * 256 + 8 * pc + 4);
#pragma unroll
            for (int o = 0; o < 4; ++o) { y[o][0] = (f32x2){b0[0], b0[1]}; y[o][1] = (f32x2){b0[2], b0[3]}; y[o][2] = (f32x2){b1[0], b1[1]}; y[o][3] = (f32x2){b1[2], b1[3]}; } }
#pragma unroll
          for (int k = 0; k < 4; ++k) { const f32x4 w0 = *(const f32x4*)(CW + k * 256 + 8 * pc), w1 = *(const f32x4*)(CW + k * 256 + 8 * pc + 4);
              wk[k][0] = (f32x2){w0[0], w0[1]}; wk[k][1] = (f32x2){w0[2], w0[3]}; wk[k][2] = (f32x2){w1[0], w1[1]}; wk[k][3] = (f32x2){w1[2], w1[3]}; }
#pragma unroll
          for (int j = 0; j < 7; ++j) { const u32x4 xr = *reinterpret_cast<const u32x4*>(XB + (r4 + j) * XP + 8 * pc); f32x2 xv[4];
              xv[0] = (f32x2){__uint_as_float(xr.x << 16), __uint_as_float(xr.x & 0xffff0000u)}; xv[1] = (f32x2){__uint_as_float(xr.y << 16), __uint_as_float(xr.y & 0xffff0000u)};
              xv[2] = (f32x2){__uint_as_float(xr.z << 16), __uint_as_float(xr.z & 0xffff0000u)}; xv[3] = (f32x2){__uint_as_float(xr.w << 16), __uint_as_float(xr.w & 0xffff0000u)};
#pragma unroll
              for (int o = 0; o < 4; ++o) { const int k = j - o; if (k >= 0 && k < 4) {
#pragma unroll
                  for (int p = 0; p < 4; ++p) y[o][p] = wk[k][p] * xv[p] + y[o][p]; } } }
#pragma unroll
          for (int o = 0; o < 4; ++o) { u32x4 w; w.x = pk2(y[o][0][0], y[o][0][1]); w.y = pk2(y[o][1][0], y[o][1][1]); w.z = pk2(y[o][2][0], y[o][2][1]); w.w = pk2(y[o][3][0], y[o][3][1]); *(u32x4*)(XC + (r4 + o) * XP + 8 * pc) = w; } }
        __syncthreads();
        bf16x8 px[5], pg[2]; int t2 = tid; asm volatile("" : "+v"(t2));
        if (more) {
#pragma unroll
            for (int i = 0; i < 5; ++i) { const int p = t2 + 512 * i; if (p < 67 * 32) px[i] = *reinterpret_cast<const bf16x8*>(xb + (mc + 61 + (p >> 5)) * D + cbase + 8 * (p & 31)); }
#pragma unroll
            for (int i = 0; i < 2; ++i) { const int p = t2 + 512 * i; pg[i] = *reinterpret_cast<const bf16x8*>(gin + (mc + 64 + (p >> 4)) * D + gcol + 8 * (p & 15)); } }
        f32x4 acc[4][2];
#pragma unroll
        for (int m = 0; m < 4; ++m) { acc[m][0] = (f32x4){0.f, 0.f, 0.f, 0.f}; acc[m][1] = (f32x4){0.f, 0.f, 0.f, 0.f}; }
#pragma unroll
        for (int ks = 0; ks < 8; ++ks) { bf16x8 af[4];
#pragma unroll
            for (int m = 0; m < 4; ++m) af[m] = *reinterpret_cast<const bf16x8*>(XC + (16 * m + fr) * XP + 32 * ks + 8 * fq);
#pragma unroll
            for (int m = 0; m < 4; ++m) { acc[m][0] = __builtin_amdgcn_mfma_f32_16x16x32_bf16(af[m], Bf[0][ks], acc[m][0], 0, 0, 0); acc[m][1] = __builtin_amdgcn_mfma_f32_16x16x32_bf16(af[m], Bf[1][ks], acc[m][1], 0, 0, 0); } }
#pragma unroll
        for (int m = 0; m < 4; ++m)
#pragma unroll
            for (int rgi = 0; rgi < 4; ++rgi) { const int tok = 16 * m + 4 * fq + rgi;
                const float xcv = bf2f(XC[tok * XP + chl]);
                const float r = __builtin_amdgcn_rcpf(1.f + __expf(-(acc[m][0][rgi] + ba))), ig = __builtin_amdgcn_rcpf(1.f + __expf(-(acc[m][1][rgi] + bi)));
                const float av = __builtin_amdgcn_exp2f(r * c8l); const float x2 = r * c2;
                float mult = __builtin_amdgcn_sqrtf(small_x ? neg_expm1_series(x2) : neg_expm1(x2)); if (pos0 && c == 0 && tok == 0) mult = 1.f;
                acc[m][0][rgi] = av; acc[m][1][rgi] = mult * ig * xcv; }
#pragma unroll
        for (int m = 0; m < 4; ++m) {
            float A = 1.f, B = 0.f;
#pragma unroll
            for (int rgi = 0; rgi < 4; ++rgi) { B = acc[m][0][rgi] * B + acc[m][1][rgi]; A *= acc[m][0][rgi]; }
            { const float Ap = bperm(A, a16), Bp = bperm(B, a16); if (fq >= 1) { B = A * Bp + B; A = A * Ap; } }
            { const float Ap = bperm(A, a32), Bp = bperm(B, a32); if (fq >= 2) { B = A * Bp + B; A = A * Ap; } }
            float Ae = bperm(A, a16), Be = bperm(B, a16); if (fq == 0) { Ae = 1.f; Be = 0.f; }
            const float At = bperm(A, a48), Bt = bperm(B, a48);
            float h = Ae * H + Be; H = At * H + Bt;
#pragma unroll
            for (int rgi = 0; rgi < 4; ++rgi) { h = acc[m][0][rgi] * h + acc[m][1][rgi]; acc[m][1][rgi] = h; } }
#pragma unroll
        for (int m = 0; m < 4; ++m)
#pragma unroll
            for (int rgi = 0; rgi < 4; ++rgi) { bf16_t* gp = GT + (16 * m + 4 * fq + rgi) * GP + 16 * wid + fr; *gp = (bf16_t)f2bf(acc[m][1][rgi] * bf2f(*gp)); }
        if (!more && fq == 0) rnn_out[ch] = H;
        __syncthreads();
#pragma unroll
        for (int i = 0; i < 2; ++i) { const int p = tid + 512 * i, row = p >> 4, pc = p & 15; *(u32x4*)(hgo + (mc + row) * D + gcol + 8 * pc) = *(const u32x4*)(GT + row * GP + 8 * pc); }
        __syncthreads();
        if (more) {
#pragma unroll
            for (int i = 0; i < 5; ++i) { const int p = t2 + 512 * i; if (p < 67 * 32) *reinterpret_cast<bf16x8*>(XB + (p >> 5) * XP + 8 * (p & 31)) = px[i]; }
#pragma unroll
            for (int i = 0; i < 2; ++i) { const int p = t2 + 512 * i; *reinterpret_cast<bf16x8*>(GT + (p >> 4) * GP + 8 * (p & 15)) = pg[i]; }
            __syncthreads(); }
    }
    __syncthreads();
}

__device__ __forceinline__ void rglru_phase(char* lds, const bf16_t* xb, const bf16_t* gin, bf16_t* hgo, const bf16_t* wai, const float* cw, const float* cb, const float* b_a, const float* b_i, const float* lam,
                                            const float* sconv, const float* srnn, float* rnnp, float* rnns, int vcu, int G, int tid) {
    for (int uu = vcu; uu < (PB + SB) * 16; uu += G) { const bool samp = uu >= PB * 16; const int u = samp ? uu - PB * 16 : uu; const int b = u >> 4, n = (u >> 1) & 7, hf = u & 1;
        rg_unit(lds, xb, gin, hgo, wai + (size_t)n * 512 * 256, cw, cb, b_a, b_i, lam, samp ? sconv + (size_t)b * 3 * D : nullptr, samp ? srnn + (size_t)b * D : nullptr, (samp ? rnns : rnnp) + (size_t)b * D,
                samp ? (size_t)TP + (size_t)b * SS : (size_t)b * PS, samp ? 1 : PS / 64, n * 256, hf, !samp, tid); }
}
}

constexpr int NWAVES = 8;
constexpr int RING_BYTES = 139264;
constexpr int MISC_OFF = RING_BYTES + 320;
constexpr int LDS_BYTES = 155648;
static_assert(EPI_LDS_OFF >= MISC_OFF + 256 && EPI_LDS_OFF + 2 * EPI_LDS_HALF <= LDS_BYTES, "epilogue prefetch area inside the LDS allocation");
using pg8::bf16_t;

__device__ __forceinline__ float lane_xor_f(float v, int lane4) { return __int_as_float(__builtin_amdgcn_ds_bpermute(lane4, __float_as_int(v))); }
__device__ __forceinline__ float wave_sum(float v, int lane) {
#pragma unroll
    for (int o = 1; o < 64; o <<= 1) v += lane_xor_f(v, (lane ^ o) << 2);
    return v;
}
__device__ __forceinline__ float wave_max(float v, int lane) {
#pragma unroll
    for (int o = 1; o < 64; o <<= 1) v = fmaxf(v, lane_xor_f(v, (lane ^ o) << 2));
    return v;
}

struct Args { const float* in[32]; float* out; unsigned char* ws; };
typedef const __attribute__((address_space(4))) unsigned char* kaptr_t;
__device__ __forceinline__ kaptr_t ka_fresh() { kaptr_t ka = (kaptr_t)__builtin_amdgcn_kernarg_segment_ptr(); asm volatile("" : "+s"(ka)); return ka; }
__device__ __forceinline__ const float* arg_in(kaptr_t ka, int i) { return *(const float* const __attribute__((address_space(4)))*)(ka + 8 * i); }
__device__ __forceinline__ float* arg_out(kaptr_t ka) { return *(float* const __attribute__((address_space(4)))*)(ka + 8 * 32); }
__device__ __forceinline__ unsigned char* arg_ws(kaptr_t ka) { return *(unsigned char* const __attribute__((address_space(4)))*)(ka + 8 * 33); }
#define GAS __attribute__((address_space(1)))
struct TItem { const GAS float* W; GAS bf16_t* WT; int K, N, mode, off, item; };
__device__ __forceinline__ void t_load(const TItem& t, float (&v)[32], int lane) {
    const int nblk = t.N / 32, kb = t.item / nblk, nb = t.item % nblk; const GAS float* p = t.W + (size_t)(64 * kb + (lane >> 5)) * t.N + 32 * nb + (lane & 31);
#pragma unroll
    for (int i = 0; i < 32; ++i) v[i] = p[(size_t)(2 * i) * t.N];
}
__device__ __forceinline__ void t_finish(const TItem& t, const float (&v)[32], LAS float* scr, int lane) {
    const int nblk = t.N / 32, kb = t.item / nblk, nb = t.item % nblk, k0 = 64 * kb, n0 = 32 * nb;
#pragma unroll
    for (int i = 0; i < 32; ++i) scr[(2 * i + (lane >> 5)) * 33 + (lane & 31)] = v[i];
    LDS_WAIT(); asm volatile("" ::: "memory");
    const int c = lane & 7;
#pragma unroll
    for (int j = 0; j < 4; ++j) { const int n = (lane >> 3) + 8 * j; const LAS float* s = scr + (8 * c) * 33 + n;
        u32x4 o; o.x = pk2(s[0 * 33], s[1 * 33]); o.y = pk2(s[2 * 33], s[3 * 33]); o.z = pk2(s[4 * 33], s[5 * 33]); o.w = pk2(s[6 * 33], s[7 * 33]);
        const int nc = n0 + n; const int drow = t.mode == 0 ? t.off + nc : (t.mode == 1 ? ((nc >> 7) * 256 + (nc & 127) + t.off) : (2 * nc + t.off));
        *(GAS u32x4*)(t.WT + (size_t)drow * t.K + k0 + 8 * c) = o; }
}
constexpr int T_IB = 2048;
constexpr int T_I13 = 32 * (DFF / 32);
constexpr int T_I2 = (DFF / 64) * 64;
constexpr int T_S0 = 6 * T_IB, T_S1 = T_S0 + 4 * T_IB, T_S2 = T_S1 + 2 * T_IB, T_S3 = T_S2 + 32 * 32, T_S4 = T_S3 + 8 * T_I13, T_S5 = T_S4 + 4 * T_I2;
__device__ __forceinline__ TItem t_decode(kaptr_t ka, int it) {
    unsigned char* ws = arg_ws(ka); TItem t;
    if (it < T_S0) { const int mi = it / T_IB, l = mi / 3, ty = mi % 3;
        t.W = (const GAS float*)((ty == 0 ? arg_in(ka, 13) : (ty == 1 ? arg_in(ka, 12) : arg_in(ka, 21))) + (size_t)l * D * D); t.WT = (GAS bf16_t*)(ty == 2 ? (bf16_t*)(ws + WS_WRGO) + (size_t)l * D * D : (bf16_t*)(ws + WS_WGI) + (size_t)l * 2 * D * D);
        t.K = D; t.N = D; t.mode = 0; t.off = ty == 1 ? D : 0; t.item = it % T_IB; }
    else if (it < T_S1) { const int q = it - T_S0, mi = q / T_IB, l = mi >> 1, ty = mi & 1;
        t.W = (const GAS float*)((ty == 0 ? arg_in(ka, 25) : arg_in(ka, 26)) + (size_t)l * D * D); t.WT = (GAS bf16_t*)((bf16_t*)(ws + (ty == 0 ? WS_WQ : WS_WO)) + (size_t)l * D * D); t.K = D; t.N = D; t.mode = 0; t.off = 0; t.item = q % T_IB; }
    else if (it < T_S2) { const int q = it - T_S1, ty = q / T_IB;
        t.W = (const GAS float*)(ty == 0 ? arg_in(ka, 23) : arg_in(ka, 24)); t.WT = (GAS bf16_t*)((bf16_t*)(ws + WS_WKV)); t.K = D; t.N = D; t.mode = 0; t.off = ty == 0 ? 0 : D; t.item = q % T_IB; }
    else if (it < T_S3) { const int q = it - T_S2, mi = q / 32, ln = mi >> 1, ty = mi & 1;
        t.W = (const GAS float*)((ty == 0 ? arg_in(ka, 16) : arg_in(ka, 18)) + (size_t)ln * 256 * 256); t.WT = (GAS bf16_t*)((bf16_t*)(ws + WS_WAI) + (size_t)ln * 512 * 256); t.K = 256; t.N = 256; t.mode = 2; t.off = ty; t.item = q % 32; }
    else if (it < T_S4) { const int q = it - T_S3, mi = q / T_I13, l = mi >> 1, ty = mi & 1;
        t.W = (const GAS float*)((ty == 0 ? arg_in(ka, 28) : arg_in(ka, 29)) + (size_t)l * D * DFF); t.WT = (GAS bf16_t*)((bf16_t*)(ws + WS_W13) + (size_t)l * 2 * DFF * D); t.K = D; t.N = DFF; t.mode = 1; t.off = ty * 128; t.item = q % T_I13; }
    else { const int q = it - T_S4, l = q / T_I2;
        t.W = (const GAS float*)(arg_in(ka, 30) + (size_t)l * DFF * D); t.WT = (GAS bf16_t*)((bf16_t*)(ws + WS_W2) + (size_t)l * D * DFF); t.K = DFF; t.N = D; t.mode = 0; t.off = 0; t.item = q % T_I2; }
    return t;
}
__device__ __forceinline__ void p0_weights(kaptr_t ka, LAS unsigned char* lds, int gw, int NGW, int wave, int lane) {
    LAS float* scr0 = (LAS float*)(lds + wave * 16896); LAS float* scr1 = scr0 + 64 * 33;
    for (int it = 2 * gw; it < T_S5; it += 2 * NGW) {
        const TItem t0 = t_decode(ka, it), t1 = t_decode(ka, it + 1);
        float v0[32], v1[32];
        t_load(t0, v0, lane); t_load(t1, v1, lane);
        t_finish(t0, v0, scr0, lane); t_finish(t1, v1, scr1, lane);
        LDS_WAIT(); asm volatile("" ::: "memory");
    }
}

__device__ __forceinline__ void p0_cache(const float* __restrict__ ck, const float* __restrict__ cv, bf16_t* __restrict__ KS, bf16_t* __restrict__ VS, int gw, int NGW, int lane) {
    constexpr int STEPS = SB * LEFT * D / 512;
    for (int it0 = 4 * gw; it0 < 2 * STEPS; it0 += 4 * NGW) {
        f32x4 x0[4], x1[4];
#pragma unroll
        for (int u = 0; u < 4; ++u) { const int it = it0 + u; const bool isv = it >= STEPS; const size_t e = (size_t)(isv ? it - STEPS : it) * 512 + lane * 8; const float* src = (isv ? cv : ck) + e; x0[u] = *(const f32x4*)src; x1[u] = *(const f32x4*)(src + 4); }
#pragma unroll
        for (int u = 0; u < 4; ++u) { const int it = it0 + u; const bool isv = it >= STEPS; const size_t e = (size_t)(isv ? it - STEPS : it) * 512 + lane * 8;
            const size_t bj = e >> 11, col = e & (D - 1), b = bj >> 9, j = bj & (LEFT - 1);
            u32x4 w; w.x = pk2(x0[u][0], x0[u][1]); w.y = pk2(x0[u][2], x0[u][3]); w.z = pk2(x1[u][0], x1[u][1]); w.w = pk2(x1[u][2], x1[u][3]);
            *(u32x4*)((isv ? VS : KS) + (b * BAND + j) * D + col) = w; }
    }
}

__device__ __forceinline__ void p0_mod(const float* __restrict__ c_p, const float* __restrict__ c_s, const float* __restrict__ ada_w, const float* __restrict__ ada_b, float* __restrict__ mod, LAS unsigned char* lds, int vcu, int G, int tid) {
    LAS float* cs = (LAS float*)lds;
    LAS float* red = (LAS float*)lds;
    const int cp = tid & 31, ks = tid >> 5, lane = tid & 63, wv = tid >> 6;
    for (int item = vcu; item < 4 * 192; item += G) {
        const int l = item / 192, j0 = (item % 192) * 64;
        f32x2 acc[NBB];
#pragma unroll
        for (int bb = 0; bb < NBB; ++bb) acc[bb] = (f32x2){0.f, 0.f};
        for (int kc = 0; kc < 8; ++kc) {
            __syncthreads();
#pragma unroll 4
            for (int i = 0; i < 24; ++i) { const int idx = tid + 512 * i, bb = idx >> 8, kk = idx & 255; const float c = bb < PB ? c_p[bb * D + kc * 256 + kk] : c_s[(bb - PB) * D + kc * 256 + kk]; cs[kk * NBB + bb] = c / (1.0f + __expf(-c)); }
            __syncthreads();
            f32x2 w2[16];
            const float* wp = ada_w + ((size_t)l * D + kc * 256 + ks * 16) * MODW + j0 + 2 * cp;
#pragma unroll
            for (int i = 0; i < 16; ++i) w2[i] = *(const f32x2*)(wp + (size_t)i * MODW);
#pragma unroll
            for (int i = 0; i < 16; ++i) { const LAS f32x4* cr = (const LAS f32x4*)(cs + (ks * 16 + i) * NBB);
#pragma unroll
                for (int q = 0; q < 12; ++q) { const f32x4 c4 = cr[q];
#pragma unroll
                    for (int e = 0; e < 4; ++e) acc[4 * q + e] += w2[i] * c4[e]; } }
        }
#pragma unroll
        for (int bb = 0; bb < NBB; ++bb) {
            { auto r = __builtin_amdgcn_permlane32_swap(__float_as_uint(acc[bb][0]), __float_as_uint(acc[bb][0]), false, false); acc[bb][0] = __uint_as_float(r[0]) + __uint_as_float(r[1]); }
            { auto r = __builtin_amdgcn_permlane32_swap(__float_as_uint(acc[bb][1]), __float_as_uint(acc[bb][1]), false, false); acc[bb][1] = __uint_as_float(r[0]) + __uint_as_float(r[1]); } }
        __syncthreads();
        if (lane < 32) {
#pragma unroll
            for (int bb = 0; bb < NBB; ++bb) { red[(wv * 96 + 2 * bb) * 32 + lane] = acc[bb][0]; red[(wv * 96 + 2 * bb + 1) * 32 + lane] = acc[bb][1]; } }
        __syncthreads();
#pragma unroll
        for (int i = 0; i < 6; ++i) { const int o = tid + 512 * i, bb = o >> 6, col = o & 63, v = 2 * bb + (col & 1), c2 = col >> 1; float s = ada_b[l * MODW + j0 + col];
#pragma unroll
            for (int w = 0; w < 8; ++w) s += red[(w * 96 + v) * 32 + c2];
            mod[((size_t)l * NBB + bb) * MODW + j0 + col] = s; }
    }
    __syncthreads();
}

__device__ __forceinline__ void gm_tables(const float* __restrict__ g_mix, const float* __restrict__ g_ffn, const float* __restrict__ mod, float* __restrict__ gm, int gtid, int nthreads) {
    for (int e = gtid; e < 8 * NBB * (D / 4); e += nthreads) { const int k4 = e % (D / 4), b = (e / (D / 4)) % NBB, i = e / ((D / 4) * NBB), l = i >> 1;
        const f32x4 g = *(const f32x4*)((i & 1 ? g_ffn : g_mix) + (size_t)l * D + 4 * k4), sc = *(const f32x4*)(mod + ((size_t)l * NBB + b) * MODW + (i & 1 ? 4 * D : D) + 4 * k4);
        *(f32x4*)(gm + ((size_t)i * NBB + b) * D + 4 * k4) = g * (sc + 1.0f); }
}
__device__ __forceinline__ void norm0_pass(const float* __restrict__ xp_, const float* __restrict__ xs_, bf16_t* __restrict__ X, bf16_t* __restrict__ xg, const float* __restrict__ g, const float* __restrict__ mod0, pg8::ssq_t* __restrict__ ssq0, int gw, int NGW, int lane) {
    for (int m0 = gw; m0 < T; m0 += 2 * NGW) {
        const int m1 = m0 + NGW; const bool two = m1 < T; const int mb = two ? m1 : m0;
        const f32x4* xr0 = (const f32x4*)(m0 < TP ? xp_ + (size_t)m0 * D : xs_ + (size_t)(m0 - TP) * D) + lane;
        const f32x4* xr1 = (const f32x4*)(mb < TP ? xp_ + (size_t)mb * D : xs_ + (size_t)(mb - TP) * D) + lane;
        f32x4 v0[8], v1[8];
#pragma unroll
        for (int j = 0; j < 8; ++j) { v0[j] = xr0[64 * j]; v1[j] = xr1[64 * j]; }
#pragma unroll
        for (int r = 0; r < 2; ++r) { if (r == 1 && !two) break; const int m = r ? m1 : m0; const f32x4* v = r ? v1 : v0; float ss = 0.f;
#pragma unroll
            for (int j = 0; j < 8; ++j) ss += (v[j][0] * v[j][0] + v[j][1] * v[j][1]) + (v[j][2] * v[j][2] + v[j][3] * v[j][3]);
            ss = wave_sum(ss, lane); if (lane == 0) ssq0[m] = pg8::ssq_fix(ss);
            const int bb = row_bb(m); const f32x4* gp = (const f32x4*)g + lane; const f32x4* sc = (const f32x4*)(mod0 + (size_t)bb * MODW + D) + lane;
            u32x2* xc = (u32x2*)(X + (size_t)m * XPITCH) + lane; u32x2* o = (u32x2*)(xg + (size_t)m * D) + lane;
#pragma unroll
            for (int j = 0; j < 8; ++j) { { u32x2 w; w.x = pk2(v[j][0], v[j][1]); w.y = pk2(v[j][2], v[j][3]); xc[64 * j] = w; } const f32x4 z = v[j] * (gp[64 * j] * (sc[64 * j] + 1.0f)); u32x2 w; w.x = pk2(z[0], z[1]); w.y = pk2(z[2], z[3]); o[64 * j] = w; } }
    }
}
__device__ __forceinline__ void shw_tile(const float* __restrict__ sh, const bf16_t* __restrict__ Wt, float* __restrict__ dst, int N, int n0, int lane) {
    const int fr = lane & 15, fq = lane >> 4;
    f32x4 acc[3][4];
#pragma unroll
    for (int m = 0; m < 3; ++m)
#pragma unroll
        for (int j = 0; j < 4; ++j) acc[m][j] = (f32x4){0.f, 0.f, 0.f, 0.f};
    const float* ap = sh + (size_t)fr * MODW + 8 * fq; const bf16_t* bp = Wt + (size_t)(n0 + fr) * D + 8 * fq;
#pragma unroll 4
    for (int k0 = 0; k0 < D; k0 += 32) { bf16x8 af[3], bfr[4];
#pragma unroll
        for (int m = 0; m < 3; ++m) { const f32x4 x0 = *(const f32x4*)(ap + (size_t)(16 * m) * MODW + k0), x1 = *(const f32x4*)(ap + (size_t)(16 * m) * MODW + k0 + 4); u32x4 w; w.x = pk2(x0[0], x0[1]); w.y = pk2(x0[2], x0[3]); w.z = pk2(x1[0], x1[1]); w.w = pk2(x1[2], x1[3]); af[m] = *reinterpret_cast<bf16x8*>(&w); }
#pragma unroll
        for (int j = 0; j < 4; ++j) bfr[j] = *reinterpret_cast<const bf16x8*>(bp + (size_t)(16 * j) * D + k0);
#pragma unroll
        for (int m = 0; m < 3; ++m)
#pragma unroll
            for (int j = 0; j < 4; ++j) acc[m][j] = __builtin_amdgcn_mfma_f32_16x16x32_bf16(af[m], bfr[j], acc[m][j], 0, 0, 0); }
#pragma unroll
    for (int m = 0; m < 3; ++m)
#pragma unroll
        for (int j = 0; j < 4; ++j)
#pragma unroll
            for (int r = 0; r < 4; ++r) dst[(size_t)(16 * m + 4 * fq + r) * N + n0 + 16 * j + fr] = acc[m][j][r];
}
__device__ __forceinline__ void shw_phase(const float* __restrict__ mod, unsigned char* ws, int vcu, int G, int wave, int lane) {
    float* shw = (float*)(ws + WS_SHW);
    for (int t = vcu + G * wave; t < 896; t += G * NWAVES) {
        if (t < 128) { const int l = t >> 6, n0 = (t & 63) * 64; shw_tile(mod + (size_t)l * NBB * MODW, (const bf16_t*)(ws + WS_WGI) + (size_t)l * 2 * D * D, shw + SHW_GI + (size_t)l * NBB * 2 * D, 2 * D, n0, lane); }
        else if (t < 192) { const int bl = (t - 128) >> 5, n0 = ((t - 128) & 31) * 64; shw_tile(mod + (size_t)(2 + bl) * NBB * MODW, (const bf16_t*)(ws + WS_WQ) + (size_t)bl * D * D, shw + SHW_Q + (size_t)bl * NBB * D, D, n0, lane); }
        else { const int q = t - 192, l = q / 176, n0 = (q % 176) * 64; shw_tile(mod + (size_t)l * NBB * MODW + 3 * D, (const bf16_t*)(ws + WS_W13) + (size_t)l * 2 * DFF * D, shw + SHW_13 + (size_t)l * NBB * 2 * DFF, 2 * DFF, n0, lane); }
    }
}
__device__ __forceinline__ void final_pass(float* Y, const float* __restrict__ g, const pg8::ssq_t* __restrict__ ssq, int gw, int NGW, int lane) {
    for (int m0 = gw; m0 < T; m0 += 2 * NGW) {
        const int m1 = m0 + NGW; const bool two = m1 < T; const int mb = two ? m1 : m0;
        const u32x2* x0 = (const u32x2*)((const bf16_t*)(Y + (size_t)m0 * D) + D) + lane; const u32x2* x1 = (const u32x2*)((const bf16_t*)(Y + (size_t)mb * D) + D) + lane; const f32x4* gp = (const f32x4*)g + lane;
        u32x2 v0[8], v1[8];
#pragma unroll
        for (int j = 0; j < 8; ++j) { v0[j] = x0[64 * j]; v1[j] = x1[64 * j]; }
        const float r0 = pg8::rstd_of(ssq[m0]), r1 = pg8::rstd_of(ssq[mb]);
        asm volatile("s_waitcnt vmcnt(0)" ::: "memory");
        f32x4* y0 = (f32x4*)(Y + (size_t)m0 * D) + lane; f32x4* y1 = (f32x4*)(Y + (size_t)mb * D) + lane;
#pragma unroll
        for (int j = 0; j < 8; ++j) { const f32x4 xv = {__uint_as_float(v0[j].x << 16), __uint_as_float(v0[j].x & 0xffff0000u), __uint_as_float(v0[j].y << 16), __uint_as_float(v0[j].y & 0xffff0000u)}; y0[64 * j] = (xv * r0) * gp[64 * j]; }
        if (two) {
#pragma unroll
            for (int j = 0; j < 8; ++j) { const f32x4 xv = {__uint_as_float(v1[j].x << 16), __uint_as_float(v1[j].x & 0xffff0000u), __uint_as_float(v1[j].y << 16), __uint_as_float(v1[j].y & 0xffff0000u)}; y1[64 * j] = (xv * r1) * gp[64 * j]; } }
    }
}

#define fresh_tid() ({ int t_ = (wave_s_ << 6) | (int)__builtin_amdgcn_mbcnt_hi(~0u, __builtin_amdgcn_mbcnt_lo(~0u, 0u)); asm volatile("" : "+v"(t_)); t_; })
__device__ __forceinline__ int fresh_s(int v) { asm volatile("" : "+s"(v)); return v; }
#define WSP(off) ((bf16_t*)(arg_ws(ka) + (off)))

__global__ void __launch_bounds__(NWAVES * 64, 2) mega_fwd(Args a_unused) {
    extern __shared__ __attribute__((aligned(16))) unsigned char lds_raw[];
    LAS unsigned char* lds = (LAS unsigned char*)lds_raw;
    const int G_ = gridDim.x, bx_ = blockIdx.x; const int wave_s_ = __builtin_amdgcn_readfirstlane((int)threadIdx.x >> 6);
#define G (fresh_s(G_))
#define bx (fresh_s(bx_))
#define TID (fresh_tid())
#define LANE (fresh_tid() & 63)
#define WAVE (__builtin_amdgcn_readfirstlane(fresh_tid() >> 6))
#define VCU ((G % 8 == 0) ? (bx % 8) * (G / 8) + bx / 8 : bx)
#define GW (VCU * NWAVES + WAVE)
#define NGW (G * NWAVES)
    for (int u = TID; u < (LDS_BYTES - RING_BYTES) / 4; u += NWAVES * 64) ((LAS unsigned*)(lds + RING_BYTES))[u] = 0u;
    __syncthreads();
    XcdBarrier bar;
    { kaptr_t ka = ka_fresh(); bar = xcd_barrier_post((unsigned*)(arg_ws(ka) + WS_CTL) + CW_BAR, (volatile LAS unsigned*)(lds + MISC_OFF) + 8); }
#define GRID_BAR() do { XcdBarrier b2_ = bar; __attribute__((address_space(1))) unsigned* gb_ = (__attribute__((address_space(1))) unsigned*)bar.bar; asm volatile("" : "+s"(gb_), "+s"(b2_.x)); b2_.bar = (unsigned*)gb_; xcd_barrier(b2_); } while (0)

    { kaptr_t ka = ka_fresh(); pg8::ssq_t* sq = (pg8::ssq_t*)(arg_ws(ka) + WS_SSQ);
      for (int i = VCU * (NWAVES * 64) + TID; i < 9 * T; i += G * NWAVES * 64) sq[i] = 0ull; }
    { kaptr_t ka = ka_fresh(); p0_weights(ka, lds, GW, NGW, WAVE, LANE); }
    { kaptr_t ka = ka_fresh(); p0_cache(arg_in(ka, 6), arg_in(ka, 7), WSP(WS_KS), WSP(WS_VS), GW, NGW, LANE); }
    __syncthreads();
    { kaptr_t ka = ka_fresh(); p0_mod(arg_in(ka, 2), arg_in(ka, 3), arg_in(ka, 8), arg_in(ka, 9), (float*)(arg_ws(ka) + WS_MOD), lds, VCU, G, TID); }
    GRID_BAR();

    { kaptr_t ka = ka_fresh(); const float* mod = (const float*)(arg_ws(ka) + WS_MOD);
      gm_tables(arg_in(ka, 10), arg_in(ka, 11), mod, (float*)(arg_ws(ka) + WS_GM), VCU * (NWAVES * 64) + TID, G * NWAVES * 64); }
    { kaptr_t ka = ka_fresh(); shw_phase((const float*)(arg_ws(ka) + WS_MOD), arg_ws(ka), VCU, G, WAVE, LANE); }
    { kaptr_t ka = ka_fresh();
      norm0_pass(arg_in(ka, 0), arg_in(ka, 1), (bf16_t*)(arg_out(ka) + O_Y) + D, WSP(WS_HN), arg_in(ka, 10), (const float*)(arg_ws(ka) + WS_MOD), (pg8::ssq_t*)(arg_ws(ka) + WS_SSQ), GW, NGW, LANE); }
    GRID_BAR();

#define SSQP(i) ((pg8::ssq_t*)(arg_ws(ka) + WS_SSQ) + (size_t)(i) * T)
#define GMP(i) ((const float*)(arg_ws(ka) + WS_GM) + (size_t)(i) * NBB * D)
#define MODL(l) ((const float*)(arg_ws(ka) + WS_MOD) + (size_t)(l) * NBB * MODW)
#define SHWP(off) ((const float*)(arg_ws(ka) + WS_SHW) + (off))
#pragma unroll 1
    for (int l = 0; l < 4; ++l) {
        if (l < 2) {
            { kaptr_t ka = ka_fresh(); float* out = arg_out(ka);
              pg8::Gemm g{WSP(WS_HN), WSP(WS_WGI) + (size_t)l * 2 * D * D, T, 2 * D, D}; pg8::ORD_GI S; S.init(T, 2 * D, G, bx);
              pg8::EpiGateInP E{WSP(WS_BA), WSP(WS_BB), out + O_CONVP + (size_t)l * PB * 3 * D, out + O_CONVS + (size_t)l * SB * 3 * D, SSQP(2 * l), SHWP(SHW_GI + (size_t)l * NBB * 2 * D)};
              pg8::gemm_phase<pg8::EpiGateInP, pg8::ORD_GI, true, true>(lds, g, S, E, TID); }
            GRID_BAR();
            { kaptr_t ka = ka_fresh(); float* out = arg_out(ka);
              rg::rglru_phase((char*)lds_raw, WSP(WS_BB), WSP(WS_BA), WSP(WS_HN), WSP(WS_WAI) + (size_t)l * 8 * 512 * 256, arg_in(ka, 14) + (size_t)l * 4 * D, arg_in(ka, 15) + (size_t)l * D, arg_in(ka, 17) + (size_t)l * D, arg_in(ka, 19) + (size_t)l * D,
                              arg_in(ka, 20) + (size_t)l * D, arg_in(ka, 4) + (size_t)l * SB * 3 * D, arg_in(ka, 5) + (size_t)l * SB * D, out + O_RNNP + (size_t)l * PB * D, out + O_RNNS + (size_t)l * SB * D, VCU, G, TID); }
            GRID_BAR();
            { kaptr_t ka = ka_fresh();
              pg8::Gemm g{WSP(WS_HN), WSP(WS_WRGO) + (size_t)l * D * D, T, D, D}; pg8::ORD_R S; S.init(T, D, G, bx);
              pg8::EpiResidP E{(bf16_t*)(arg_out(ka) + O_Y) + D, MODL(l) + 2 * D, WSP(WS_BA), GMP(2 * l + 1), nullptr, nullptr, SSQP(2 * l + 1)};
              pg8::gemm_phase<pg8::EpiResidP, pg8::ORD_R, true, true>(lds, g, S, E, TID); }
        } else {
            if (l == 2) { kaptr_t ka = ka_fresh();
              pg8::Gemm g{WSP(WS_BA), WSP(WS_WKV), T, 2 * D, D}; pg8::ORD_KV S; S.init(T, 2 * D, G, bx);
              pg8::EpiKVP E{WSP(WS_BB), WSP(WS_BC), WSP(WS_KS), WSP(WS_VS), arg_out(ka), SSQP(4)};
              pg8::gemm_phase<pg8::EpiKVP, pg8::ORD_KV, true, true>(lds, g, S, E, TID); }
            { kaptr_t ka = ka_fresh();
              pg8::Gemm g{WSP(WS_HN), WSP(WS_WQ) + (size_t)(l - 2) * D * D, T, D, D}; pg8::ORD_Q S; S.init(T, D, G, bx);
              pg8::EpiQP E{WSP(WS_HID), SSQP(2 * l), SHWP(SHW_Q + (size_t)(l - 2) * NBB * D)};
              pg8::gemm_phase<pg8::EpiQP, pg8::ORD_Q, true, true>(lds, g, S, E, TID); }
            GRID_BAR();
            { kaptr_t ka = ka_fresh();
              att::attn_phase((char*)lds_raw, WSP(WS_HID), WSP(WS_HN), WSP(WS_BB), WSP(WS_BC), WSP(WS_KS), WSP(WS_VS), arg_in(ka, 27) + (size_t)(l - 2) * (2 * RELC + 1) * NH, VCU, G, TID); }
            GRID_BAR();
            { kaptr_t ka = ka_fresh();
              pg8::Gemm g{WSP(WS_HN), WSP(WS_WO) + (size_t)(l - 2) * D * D, T, D, D}; pg8::ORD_R S; S.init(T, D, G, bx);
              pg8::EpiResidP E{(bf16_t*)(arg_out(ka) + O_Y) + D, MODL(l) + 2 * D, WSP(WS_BA), GMP(2 * l + 1), nullptr, nullptr, SSQP(2 * l + 1)};
              pg8::gemm_phase<pg8::EpiResidP, pg8::ORD_R, true, true>(lds, g, S, E, TID); }
        }
        GRID_BAR();
        { kaptr_t ka = ka_fresh();
          pg8::Gemm g{WSP(WS_BA), WSP(WS_W13) + (size_t)l * 2 * DFF * D, T, 2 * DFF, D}; pg8::ORD_F13 S; S.init(T, 2 * DFF, G, bx);
          pg8::EpiFfn13P E{WSP(WS_HID), SSQP(2 * l + 1), SHWP(SHW_13 + (size_t)l * NBB * 2 * DFF)};
          pg8::gemm_phase<pg8::EpiFfn13P, pg8::ORD_F13, true, true>(lds, g, S, E, TID);
          }
        GRID_BAR();
        { kaptr_t ka = ka_fresh();
          pg8::Gemm g{WSP(WS_HID), WSP(WS_W2) + (size_t)l * D * DFF, T, D, DFF}; pg8::ORD_F2 S; S.init(T, D, G, bx);
          pg8::EpiResidP E{(bf16_t*)(arg_out(ka) + O_Y) + D, MODL(l) + 5 * D, l < 3 ? WSP(WS_HN) : nullptr, GMP(l < 3 ? 2 * l + 2 : 0), l == 1 ? WSP(WS_BA) : nullptr, arg_in(ka, 22), SSQP(2 * l + 2)};
          pg8::gemm_phase<pg8::EpiResidP, pg8::ORD_F2, true, true>(lds, g, S, E, TID); }
        GRID_BAR();
    }
    { kaptr_t ka = ka_fresh(); final_pass(arg_out(ka) + O_Y, arg_in(ka, 31), SSQP(8), GW, NGW, LANE); }
}

extern "C" void kernel_launch(void* const* d_in, const int* in_sizes, int n_in, void* d_out, int out_size, void* d_ws, size_t ws_size, hipStream_t stream) {
    (void)in_sizes; (void)out_size;
    static int grid = 0;
    if (grid == 0) {
        if (n_in != 32 || ws_size < WS_END) { fprintf(stderr, "kernel_launch: unexpected n_in %d / ws %zu\n", n_in, ws_size); grid = -1; return; }
        int dev = 0, cus = 0, per_cu = 0;
        if (hipGetDevice(&dev) != hipSuccess || hipDeviceGetAttribute(&cus, hipDeviceAttributeMultiprocessorCount, dev) != hipSuccess) { grid = -1; return; }
        if (hipFuncSetAttribute((const void*)mega_fwd, hipFuncAttributeMaxDynamicSharedMemorySize, LDS_BYTES) != hipSuccess) { fprintf(stderr, "kernel_launch: hipFuncSetAttribute failed\n"); grid = -1; return; }
        if (hipOccupancyMaxActiveBlocksPerMultiprocessor(&per_cu, (const void*)mega_fwd, NWAVES * 64, LDS_BYTES) != hipSuccess || per_cu < 1) fprintf(stderr, "kernel_launch: occupancy query says %d\n", per_cu);
        (void)hipGetLastError();
        grid = cus;
    }
    if (grid < 0) return;
    if (hipMemsetAsync((char*)d_ws + WS_CTL, 0, CTL_ZERO_BYTES, stream) != hipSuccess) return;
    Args a{};
    for (int i = 0; i < 32; ++i) a.in[i] = (const float*)d_in[i];
    a.out = (float*)d_out; a.ws = (unsigned char*)d_ws;
    hipLaunchKernelGGL(mega_fwd, dim3(grid), dim3(NWAVES * 64), LDS_BYTES, stream, a);
}
```

```cpp
#include <hip/hip_runtime.h>
#include <cstdio>
#include <cstdint>

typedef unsigned short bf16_t;
typedef short bf16x8 __attribute__((ext_vector_type(8)));
typedef float f32x4 __attribute__((ext_vector_type(4)));
typedef float f32x2 __attribute__((ext_vector_type(2)));
typedef unsigned u32x2 __attribute__((ext_vector_type(2)));
typedef unsigned u32x4 __attribute__((ext_vector_type(4)));
#define LAS __attribute__((address_space(3)))

constexpr int D = 2048, DFF = 5632, NH = 16, HD = 128;
constexpr int PB = 16, PS = 2048, SB = 32, SS = 64;
constexpr int TP = PB * PS;
constexpr int TS = SB * SS;
constexpr int T = TP + TS;
constexpr int NBB = PB + SB;
constexpr int MODW = 6 * D;
constexpr int LEFT = 512, BAND = 576, RELC = 128;
constexpr float EPS = 1e-6f;

constexpr size_t O_Y = 0;
constexpr int XPITCH = 2 * 2048;
constexpr size_t O_CONVP = (size_t)T * D;
constexpr size_t O_RNNP = O_CONVP + 2 * PB * 3 * D;
constexpr size_t O_KP = O_RNNP + 2 * PB * D;
constexpr size_t O_VP = O_KP + (size_t)PB * LEFT * D;
constexpr size_t O_CONVS = O_VP + (size_t)PB * LEFT * D;
constexpr size_t O_RNNS = O_CONVS + 2 * SB * 3 * D;
constexpr size_t O_KS = O_RNNS + 2 * SB * D;
constexpr size_t O_VS = O_KS + (size_t)SB * SS * D;
constexpr size_t O_END = O_VS + (size_t)SB * SS * D;
static_assert(O_END == 114032640, "output size");

constexpr size_t MiB = 1u << 20;
constexpr size_t WS_CTL = 0, CTL_ZERO_BYTES = 1 * MiB;
constexpr size_t WS_MOD = 1 * MiB;
constexpr size_t WS_WGI = 10 * MiB;
constexpr size_t WS_WRGO = 42 * MiB;
constexpr size_t WS_WAI = 58 * MiB;
constexpr size_t WS_WKV = 62 * MiB;
constexpr size_t WS_WQ = 78 * MiB;
constexpr size_t WS_WO = 94 * MiB;
constexpr size_t WS_W13 = 110 * MiB;
constexpr size_t WS_W2 = 286 * MiB;
constexpr size_t WS_HN = 374 * MiB;
constexpr size_t WS_BA = 510 * MiB;
constexpr size_t WS_BB = 646 * MiB;
constexpr size_t WS_BC = 782 * MiB;
constexpr size_t WS_HID = 918 * MiB;
constexpr size_t WS_KS = 1292 * MiB;
constexpr size_t WS_VS = 1364 * MiB;
constexpr size_t WS_SSQ = 1454 * MiB;
constexpr size_t SSQ_BYTES = 9 * (size_t)34816 * 8;
constexpr size_t WS_GM = 1438 * MiB;
constexpr size_t WS_SHW = 1442 * MiB;
constexpr size_t SHW_GI = 0, SHW_Q = 2 * 48 * 4096, SHW_13 = SHW_Q + 2 * 48 * 2048;
constexpr size_t WS_END = 1458 * MiB;
constexpr int EPI_LDS_OFF = 139264 + 2048, EPI_LDS_HALF = 8192;
constexpr int CW_BAR = 4096;

__device__ __forceinline__ float bf2f(bf16_t b) { return __uint_as_float(((unsigned)b) << 16); }
__device__ __forceinline__ unsigned f2bf(float f) { unsigned u = __float_as_uint(f); return (u + 0x7fffu + ((u >> 16) & 1u)) >> 16; }
__device__ __forceinline__ unsigned pk2(float lo, float hi) { return f2bf(lo) | (f2bf(hi) << 16); }
__device__ __forceinline__ int row_bb(int m) { return m < TP ? (m >> 11) : PB + ((m - TP) >> 6); }
__device__ __forceinline__ float fast_sigmoid(float x) { return __builtin_amdgcn_rcpf(1.0f + __expf(-x)); }
__device__ __forceinline__ f32x4 sigmoid4(const f32x4& x) { const f32x4 t = x * (-1.4426950408889634f); f32x4 e; e[0] = __builtin_amdgcn_exp2f(t[0]); e[1] = __builtin_amdgcn_exp2f(t[1]); e[2] = __builtin_amdgcn_exp2f(t[2]); e[3] = __builtin_amdgcn_exp2f(t[3]);
    const f32x4 d = e + 1.0f; f32x4 s; s[0] = __builtin_amdgcn_rcpf(d[0]); s[1] = __builtin_amdgcn_rcpf(d[1]); s[2] = __builtin_amdgcn_rcpf(d[2]); s[3] = __builtin_amdgcn_rcpf(d[3]); return s; }
__device__ __forceinline__ f32x4 gelu_tanh4(const f32x4& x) { const f32x4 u = (x * x * 0.044715f + 1.0f) * x * 1.5957691216057308f; return x * sigmoid4(u); }
__device__ __forceinline__ float gelu_tanh_fast(float x) { const float u = 1.5957691216057308f * (x + 0.044715f * x * x * x); return x * __builtin_amdgcn_rcpf(1.0f + __expf(-u)); }
#define LDS_WAIT() asm volatile("s_waitcnt lgkmcnt(0)" ::: "memory")
#define VM_WAIT() asm volatile("s_waitcnt vmcnt(0)" ::: "memory")

namespace pg8 {
#define PG8_LAS __attribute__((address_space(3)))
typedef unsigned short bf16_t;
typedef short bf16x8 __attribute__((ext_vector_type(8)));
typedef float f32x4 __attribute__((ext_vector_type(4)));
typedef unsigned u32x4 __attribute__((ext_vector_type(4)));
constexpr int BM = 256, BK = 64, HALF = 128, HTB = HALF * BK * 2  , STAGE_BYTES = 8 * HTB, NXCD = 8, WGM = 8;

__host__ __device__ __forceinline__ int lds_byte(int r, int c) { const int st = (r >> 4) * 2 + (c >> 5), rr = r & 15, cc = c & 31, ob = rr * 64 + cc * 2; return st * 1024 + (ob ^ (((ob >> 9) & 1) << 5)); }
__host__ __device__ __forceinline__ void stage_rc(int b, int& R, int& C) { const int st = b / 1024, sb = b % 1024, swz = sb ^ (((sb >> 9) & 1) << 5); R = (st >> 1) * 16 + swz / 64; C = (st & 1) * 32 + (swz % 64) / 2; }
__host__ __device__ __forceinline__ int perm32(int rho) { const int n = rho >> 4, i = rho & 15; return 8 * (i >> 2) + 4 * n + (i & 3); }

struct Unit { int pm, pn; };
struct Gemm { const bf16_t* A; const bf16_t* Bt; int M, N, K; int lda; };

template <int WG  > struct StaticOrderT {
    int nM, nN, nwg, G, c;
    __host__ __device__ void init(int M, int N, int G_, int c_) { nM = M / BM; nN = N / BM; nwg = nM * nN; G = G_; c = c_; }
    __host__ __device__ bool next(int i, Unit& u) const {
        const long L = (long)i * G + c; if (L >= nwg) return false;
        int wgid = (int)L; { const int q = nwg / NXCD, r = nwg % NXCD, xcd = wgid % NXCD, off = wgid / NXCD; wgid = (xcd < r ? xcd * (q + 1) : r * (q + 1) + (xcd - r) * q) + off; }
        const int nig = WG * nN, gid = wgid / nig, fm = gid * WG, gsz = (nM - fm) < WG ? (nM - fm) : WG;
        u.pm = fm + ((wgid % nig) % gsz); u.pn = (wgid % nig) / gsz; return true;
    }
    __device__ __forceinline__ void a_ready(const Unit&) const {}
    __device__ __forceinline__ void done(const Unit&) const {}
};
typedef StaticOrderT<WGM> StaticOrder;
#ifndef WG_GI
#define WG_GI 4
#endif
#ifndef WG_KV
#define WG_KV 4
#endif
#ifndef WG_Q
#define WG_Q 4
#endif
#ifndef WG_F13
#define WG_F13 4
#endif
#ifndef WG_R
#define WG_R 4
#endif
#ifndef WG_F2
#define WG_F2 4
#endif
typedef StaticOrderT<WG_GI> ORD_GI; typedef StaticOrderT<WG_KV> ORD_KV; typedef StaticOrderT<WG_Q> ORD_Q; typedef StaticOrderT<WG_F13> ORD_F13; typedef StaticOrderT<WG_R> ORD_R; typedef StaticOrderT<WG_F2> ORD_F2;
__device__ __forceinline__ unsigned cvt_pk_bf16(float lo, float hi) { unsigned r; asm volatile("v_cvt_pk_bf16_f32 %0, %1, %2" : "=v"(r) : "v"(lo), "v"(hi)); return r; }
typedef unsigned long long ssq_t;
constexpr float SSQ_SCALE = 65536.0f;
__device__ __forceinline__ ssq_t ssq_fix(float s) { return (ssq_t)(s * SSQ_SCALE + 0.5f); }
__device__ __forceinline__ float rstd_of(ssq_t ssq) { return __builtin_amdgcn_rsqf((float)ssq * (1.0f / (SSQ_SCALE * D)) + EPS); }
__device__ __forceinline__ void dma1k(const void* gsrc_lane, PG8_LAS unsigned char* dst_wave) { __builtin_amdgcn_global_load_lds((const unsigned*)gsrc_lane, (PG8_LAS unsigned*)dst_wave, 16, 0, 0); }
__device__ __forceinline__ void prefetch_norm(PG8_LAS unsigned char* area, const ssq_t* ssq, const float* shw, int shw_pitch, int pm, int pn, int wid, int lane) {
    if (wid < 2) dma1k(ssq + (size_t)pm * BM + wid * 128 + 2 * lane, area + wid * 1024);
    else if (wid < 6 && shw) { const int k = wid - 2, bb = row_bb(pm * BM + (k >> 1) * HALF + (k & 1) * 64); dma1k(shw + (size_t)bb * shw_pitch + pn * BM + 4 * lane, area + 2048 + k * 1024); }
}
__device__ __forceinline__ ssq_t lds_ssq(PG8_LAS unsigned char* area, int lrow) { return *(const PG8_LAS ssq_t*)(area + lrow * 8); }
__device__ __forceinline__ f32x4 lds_shw(PG8_LAS unsigned char* area, int k, int lcol) { return *(const PG8_LAS f32x4*)(area + 2048 + k * 1024 + lcol * 4); }
__device__ __forceinline__ u32x4 pack8(const f32x4& v0, const f32x4& v1) { u32x4 w; w.x = cvt_pk_bf16(v0[0], v0[1]); w.y = cvt_pk_bf16(v0[2], v0[3]); w.z = cvt_pk_bf16(v1[0], v1[1]); w.w = cvt_pk_bf16(v1[2], v1[3]); return w; }
__device__ __forceinline__ float sq4(const f32x4& o) { return (o[0] * o[0] + o[1] * o[1]) + (o[2] * o[2] + o[3] * o[3]); }

__device__ __forceinline__ void unpack8(const u32x4& w, f32x4& lo, f32x4& hi) {
    lo[0] = __uint_as_float(w.x << 16); lo[1] = __uint_as_float(w.x & 0xffff0000u); lo[2] = __uint_as_float(w.y << 16); lo[3] = __uint_as_float(w.y & 0xffff0000u);
    hi[0] = __uint_as_float(w.z << 16); hi[1] = __uint_as_float(w.z & 0xffff0000u); hi[2] = __uint_as_float(w.w << 16); hi[3] = __uint_as_float(w.w & 0xffff0000u); }
__device__ __forceinline__ void resid_body(const f32x4 (&acc)[2][2][4][2], int row0  , int col0  , int fq,
                                           bf16_t* __restrict__ x, bf16_t* __restrict__ xg, ssq_t* __restrict__ ssq,
                                           PG8_LAS unsigned char* area  , int lcol0  , int wr) {
    u32x4 xw[2][4][2];
#pragma unroll
    for (int ai = 0; ai < 2; ++ai)
#pragma unroll
        for (int m = 0; m < 4; ++m)
#pragma unroll
            for (int bj = 0; bj < 2; ++bj) xw[ai][m][bj] = *(const u32x4*)((const char*)x + ((unsigned)(row0 + ai * HALF + m * 16) * (unsigned)(XPITCH * 2) + (unsigned)((col0 + bj * HALF) * 2)));
    asm volatile("s_waitcnt vmcnt(0)" ::: "memory");
#pragma unroll
    for (int ai = 0; ai < 2; ++ai) {
        f32x4 g[2][2], q[2][2];
#pragma unroll
        for (int bj = 0; bj < 2; ++bj)
#pragma unroll
            for (int n = 0; n < 2; ++n) { g[bj][n] = *(const PG8_LAS f32x4*)(area + (ai * 2 + wr) * 1024 + (lcol0 + bj * HALF + 4 * n) * 4); q[bj][n] = *(const PG8_LAS f32x4*)(area + 4096 + (ai * 2 + wr) * 1024 + (lcol0 + bj * HALF + 4 * n) * 4); }
#pragma unroll
        for (int m = 0; m < 4; ++m) { const int row = row0 + ai * HALF + m * 16; float s = 0.f;
#pragma unroll
            for (int bj = 0; bj < 2; ++bj) { f32x4 o0, o1; unpack8(xw[ai][m][bj], o0, o1); o0 = o0 + g[bj][0] * acc[ai][bj][m][0]; o1 = o1 + g[bj][1] * acc[ai][bj][m][1];
                const u32x4 pw = pack8(o0, o1); *(u32x4*)((char*)x + ((unsigned)row * (unsigned)(XPITCH * 2) + (unsigned)((col0 + bj * HALF) * 2))) = pw;
                unpack8(pw, o0, o1);
                s += sq4(o0) + sq4(o1);
                *(u32x4*)((char*)xg + ((unsigned)row * (unsigned)(D * 2) + (unsigned)((col0 + bj * HALF) * 2))) = pack8(o0 * q[bj][0], o1 * q[bj][1]); }
            s += __int_as_float(__builtin_amdgcn_ds_swizzle(__float_as_int(s), 0x401f));
            { auto r2 = __builtin_amdgcn_permlane32_swap(__float_as_uint(s), __float_as_uint(s), false, false); s = __uint_as_float(r2[0]) + __uint_as_float(r2[1]); }
            if (fq == 0) __hip_atomic_fetch_add((ssq_t*)((char*)ssq + (unsigned)row * 8u), ssq_fix(s), __ATOMIC_RELAXED, __HIP_MEMORY_SCOPE_AGENT); }
    }
}
struct EpiResidP {
    static constexpr bool PERM = true, AFTER_DRAIN = false;
    bf16_t* x; const float* gvec;
    bf16_t* xg; const float* gm;
    ssq_t* ssq;
    __device__ __forceinline__ void prefetch(PG8_LAS unsigned char* area, const Unit& u, int wid, int lane) const {
        const int k = wid & 3, bb = row_bb(u.pm * BM + (k >> 1) * HALF + (k & 1) * 64);
        if (wid < 4) dma1k(gvec + (size_t)bb * MODW + u.pn * BM + 4 * lane, area + k * 1024);
        else dma1k(gm + (size_t)bb * D + u.pn * BM + 4 * lane, area + 4096 + k * 1024);
    }
    __device__ __forceinline__ void operator()(const f32x4 (&acc)[2][2][4][2], const Unit& u, int wr, int wc, int fr, int fq, PG8_LAS unsigned char* area) const {
        resid_body(acc, u.pm * BM + wr * 64 + fr, u.pn * BM + wc * 32 + 8 * fq, fq, x, xg, ssq, area, wc * 32 + 8 * fq, wr);
    }
};
__device__ __forceinline__ void gatein_body(const f32x4 (&acc)[2][2][4][2], int row0, int n0  , bool isx, bf16_t* __restrict__ gate, bf16_t* __restrict__ xb, float* __restrict__ convp, float* __restrict__ convs,
                                            PG8_LAS unsigned char* area, int lrow0  , int lcol0  , int wr) {
    const int col0 = n0 - (isx ? D : 0);
    ssq_t rs[2][4]; f32x4 sh[2][2][2];
#pragma unroll
    for (int ai = 0; ai < 2; ++ai) {
#pragma unroll
        for (int m = 0; m < 4; ++m) rs[ai][m] = lds_ssq(area, lrow0 + ai * HALF + m * 16);
#pragma unroll
        for (int bj = 0; bj < 2; ++bj)
#pragma unroll
            for (int n = 0; n < 2; ++n) sh[ai][bj][n] = lds_shw(area, ai * 2 + wr, lcol0 + bj * HALF + 4 * n); }
#pragma unroll
    for (int ai = 0; ai < 2; ++ai)
#pragma unroll
        for (int m = 0; m < 4; ++m) { const int row = row0 + ai * HALF + m * 16; const float r = rstd_of(rs[ai][m]);
            float* cdst = nullptr;
            if (isx) { if (row < TP) { const int b = row >> 11, t = row & (PS - 1); if (t >= PS - 3) cdst = convp + ((size_t)b * 3 + (t - (PS - 3))) * D; }
                       else { const int mm = row - TP, b = mm >> 6, t = mm & (SS - 1); if (t >= SS - 3) cdst = convs + ((size_t)b * 3 + (t - (SS - 3))) * D; } }
#pragma unroll
            for (int bj = 0; bj < 2; ++bj) { f32x4 v0 = acc[ai][bj][m][0] * r + sh[ai][bj][0], v1 = acc[ai][bj][m][1] * r + sh[ai][bj][1]; const int c = col0 + bj * HALF;
                if (!isx) {
                    v0 = gelu_tanh4(v0); v1 = gelu_tanh4(v1);
                    *(u32x4*)(gate + (size_t)row * D + c) = pack8(v0, v1);
                } else {
                    *(u32x4*)(xb + (size_t)row * D + c) = pack8(v0, v1);
                    if (cdst) { *(f32x4*)(cdst + c) = v0; *(f32x4*)(cdst + c + 4) = v1; }
                } } }
}
struct EpiGateInP {
    static constexpr bool PERM = true, AFTER_DRAIN = false;
    bf16_t* gate; bf16_t* xb; float* convp; float* convs; const ssq_t* ssq; const float* shw;
    __device__ __forceinline__ void prefetch(PG8_LAS unsigned char* area, const Unit& u, int wid, int lane) const { prefetch_norm(area, ssq, shw, 2 * D, u.pm, u.pn, wid, lane); }
    __device__ __forceinline__ void operator()(const f32x4 (&acc)[2][2][4][2], const Unit& u, int wr, int wc, int fr, int fq, PG8_LAS unsigned char* area) const {
        gatein_body(acc, u.pm * BM + wr * 64 + fr, u.pn * BM + wc * 32 + 8 * fq, u.pn >= 8, gate, xb, convp, convs, area, wr * 64 + fr, wc * 32 + 8 * fq, wr);
    }
};
__device__ __forceinline__ void ffn13_body(const f32x4 (&acc)[2][2][4][2], int row0, int hcol0, bf16_t* __restrict__ hid, PG8_LAS unsigned char* area, int lrow0, int lcol0, int wr) {
    ssq_t rs[2][4]; f32x4 sh[2][2][2];
#pragma unroll
    for (int ai = 0; ai < 2; ++ai) {
#pragma unroll
        for (int m = 0; m < 4; ++m) rs[ai][m] = lds_ssq(area, lrow0 + ai * HALF + m * 16);
#pragma unroll
        for (int bj = 0; bj < 2; ++bj)
#pragma unroll
            for (int n = 0; n < 2; ++n) sh[ai][bj][n] = lds_shw(area, ai * 2 + wr, lcol0 + bj * HALF + 4 * n); }
#pragma unroll
    for (int ai = 0; ai < 2; ++ai)
#pragma unroll
        for (int m = 0; m < 4; ++m) { const int row = row0 + ai * HALF + m * 16; const float r = rstd_of(rs[ai][m]);
            const f32x4 a0 = acc[ai][0][m][0] * r + sh[ai][0][0], a1 = acc[ai][0][m][1] * r + sh[ai][0][1], b0 = acc[ai][1][m][0] * r + sh[ai][1][0], b1 = acc[ai][1][m][1] * r + sh[ai][1][1];
            const f32x4 h0 = a0 * sigmoid4(a0) * b0, h1 = a1 * sigmoid4(a1) * b1;
            *(u32x4*)(hid + (size_t)row * DFF + hcol0) = pack8(h0, h1); }
}
struct EpiFfn13P {
    static constexpr bool PERM = true, AFTER_DRAIN = false;
    bf16_t* hid; const ssq_t* ssq; const float* shw;
    __device__ __forceinline__ void prefetch(PG8_LAS unsigned char* area, const Unit& u, int wid, int lane) const { prefetch_norm(area, ssq, shw, 2 * DFF, u.pm, u.pn, wid, lane); }
    __device__ __forceinline__ void operator()(const f32x4 (&acc)[2][2][4][2], const Unit& u, int wr, int wc, int fr, int fq, PG8_LAS unsigned char* area) const {
        ffn13_body(acc, u.pm * BM + wr * 64 + fr, u.pn * HALF + wc * 32 + 8 * fq, hid, area, wr * 64 + fr, wc * 32 + 8 * fq, wr);
    }
};
__device__ __forceinline__ void kv_body(const f32x4 (&acc)[2][2][4][2], int row0, int col0, bool isv, bf16_t* __restrict__ kvp  , bf16_t* __restrict__ kvs  , float* __restrict__ out, PG8_LAS unsigned char* area, int lrow0) {
    ssq_t rs[2][4];
#pragma unroll
    for (int ai = 0; ai < 2; ++ai)
#pragma unroll
        for (int m = 0; m < 4; ++m) rs[ai][m] = lds_ssq(area, lrow0 + ai * HALF + m * 16);
#pragma unroll
    for (int ai = 0; ai < 2; ++ai)
#pragma unroll
        for (int m = 0; m < 4; ++m) { const int row = row0 + ai * HALF + m * 16; const float r = rstd_of(rs[ai][m]);
            float* fdst = nullptr; bf16_t* dst;
            if (row < TP) { const int b = row >> 11, t = row & (PS - 1); dst = kvp + (size_t)row * D; if (t >= PS - LEFT) fdst = out + (isv ? O_VP : O_KP) + ((size_t)b * LEFT + (t - (PS - LEFT))) * D; }
            else { const int mm = row - TP, b = mm >> 6, t = mm & (SS - 1); dst = kvs + ((size_t)b * BAND + LEFT + t) * D; fdst = out + (isv ? O_VS : O_KS) + (size_t)mm * D; }
#pragma unroll
            for (int bj = 0; bj < 2; ++bj) { const f32x4 v0 = acc[ai][bj][m][0] * r, v1 = acc[ai][bj][m][1] * r; const int c = col0 + bj * HALF;
                *(u32x4*)(dst + c) = pack8(v0, v1);
                if (fdst) { *(f32x4*)(fdst + c) = v0; *(f32x4*)(fdst + c + 4) = v1; } } }
}
struct EpiKVP {
    static constexpr bool PERM = true, AFTER_DRAIN = false;
    bf16_t* kb; bf16_t* vb; bf16_t* ks; bf16_t* vs; float* out; const ssq_t* ssq;
    __device__ __forceinline__ void prefetch(PG8_LAS unsigned char* area, const Unit& u, int wid, int lane) const { prefetch_norm(area, ssq, nullptr, 0, u.pm, u.pn, wid, lane); }
    __device__ __forceinline__ void operator()(const f32x4 (&acc)[2][2][4][2], const Unit& u, int wr, int wc, int fr, int fq, PG8_LAS unsigned char* area) const {
        const bool isv = u.pn >= 8;
        kv_body(acc, u.pm * BM + wr * 64 + fr, (isv ? u.pn - 8 : u.pn) * BM + wc * 32 + 8 * fq, isv, isv ? vb : kb, isv ? vs : ks, out, area, wr * 64 + fr);
    }
};
__device__ __forceinline__ void q_body(const f32x4 (&acc)[2][2][4][2], int row0, int col0, bf16_t* __restrict__ q, PG8_LAS unsigned char* area, int lrow0, int lcol0, int wr) {
    ssq_t rs[2][4]; f32x4 sh[2][2][2];
#pragma unroll
    for (int ai = 0; ai < 2; ++ai) {
#pragma unroll
        for (int m = 0; m < 4; ++m) rs[ai][m] = lds_ssq(area, lrow0 + ai * HALF + m * 16);
#pragma unroll
        for (int bj = 0; bj < 2; ++bj)
#pragma unroll
            for (int n = 0; n < 2; ++n) sh[ai][bj][n] = lds_shw(area, ai * 2 + wr, lcol0 + bj * HALF + 4 * n); }
#pragma unroll
    for (int ai = 0; ai < 2; ++ai)
#pragma unroll
        for (int m = 0; m < 4; ++m) { const int row = row0 + ai * HALF + m * 16; const float r = rstd_of(rs[ai][m]);
#pragma unroll
            for (int bj = 0; bj < 2; ++bj) *(u32x4*)(q + (size_t)row * D + col0 + bj * HALF) = pack8(acc[ai][bj][m][0] * r + sh[ai][bj][0], acc[ai][bj][m][1] * r + sh[ai][bj][1]); }
}
struct EpiQP {
    static constexpr bool PERM = true, AFTER_DRAIN = false;
    bf16_t* q; const ssq_t* ssq; const float* shw;
    __device__ __forceinline__ void prefetch(PG8_LAS unsigned char* area, const Unit& u, int wid, int lane) const { prefetch_norm(area, ssq, shw, D, u.pm, u.pn, wid, lane); }
    __device__ __forceinline__ void operator()(const f32x4 (&acc)[2][2][4][2], const Unit& u, int wr, int wc, int fr, int fq, PG8_LAS unsigned char* area) const {
        q_body(acc, u.pm * BM + wr * 64 + fr, u.pn * BM + wc * 32 + 8 * fq, q, area, wr * 64 + fr, wc * 32 + 8 * fq, wr);
    }
};

template <class Epi, class Sched, bool ALIGN_EPI = false, bool SP2 = false, int AUXA = 0, int AUXB = 0  >
__device__ __forceinline__ void gemm_phase(PG8_LAS unsigned char* lds, const Gemm g, const Sched& S, const Epi& E, int tid_in) {
    int tid_ = tid_in; asm volatile("" : "+v"(tid_));
    const int tid = tid_, wid = __builtin_amdgcn_readfirstlane(tid >> 6), lane = tid & 63, wr = wid >> 2, wc = wid & 3, fr = lane & 15, fq = lane >> 4;
    const int K = g.K, nt = K / BK, LDA = g.lda ? g.lda : g.K;
    unsigned voffA[2], voffB[2];
#pragma unroll
    for (int i = 0; i < 2; ++i) { int R, C; stage_rc(tid * 16 + i * 8192, R, C); const int Rb = Epi::PERM ? ((R & ~31) + perm32(R & 31)) : R;
        voffA[i] = (unsigned)(R * LDA + C) * 2u; voffB[i] = (unsigned)(Rb * K + C) * 2u; }
    const size_t kstep = (size_t)(BK * 2);
    const size_t hstepA = (size_t)HALF * LDA * 2, hstepB = (size_t)HALF * K * 2;
    const size_t tstepA = 2 * hstepA, tstepB = 2 * hstepB;
    const unsigned ldsw = (unsigned)wid * 1024u;
    const int aoff = lds_byte(wr * 64 + fr, fq * 8), boff = lds_byte(wc * 32 + fr, fq * 8);
#define PG8_SA(b, h) (((b) * 2 + (h)) * HTB)
#define PG8_SB(b, h) ((4 + (b) * 2 + (h)) * HTB)
    constexpr int AUX_voffA = AUXA, AUX_voffB = AUXB;
#define PG8_STAGE(bufoff, gbase, voff) do { _Pragma("unroll") for (int _i = 0; _i < 2; ++_i) \
        __builtin_amdgcn_global_load_lds((const unsigned*)((const char*)(gbase) + (voff)[_i]), (PG8_LAS unsigned*)(lds + (bufoff) + ldsw + _i * 8192), 16, 0, AUX_##voff); } while (0)
#define PG8_LDA(dst, b, h) do { _Pragma("unroll") for (int m = 0; m < 4; ++m) _Pragma("unroll") for (int k = 0; k < 2; ++k) dst[m][k] = *(const PG8_LAS bf16x8*)(lds + PG8_SA(b, h) + aoff + m * 2048 + k * 1024); } while (0)
#define PG8_LDB(dst, b, h) do { _Pragma("unroll") for (int n = 0; n < 2; ++n) _Pragma("unroll") for (int k = 0; k < 2; ++k) dst[n][k] = *(const PG8_LAS bf16x8*)(lds + PG8_SB(b, h) + boff + n * 2048 + k * 1024); } while (0)
#define PG8_MMA(ai, bj, At, Bt) do { __builtin_amdgcn_s_setprio(1); _Pragma("unroll") for (int m = 0; m < 4; ++m) _Pragma("unroll") for (int n = 0; n < 2; ++n) _Pragma("unroll") for (int k = 0; k < 2; ++k) \
        acc[ai][bj][m][n] = __builtin_amdgcn_mfma_f32_16x16x32_bf16(Bt[n][k], At[m][k], acc[ai][bj][m][n], 0, 0, 0); __builtin_amdgcn_s_setprio(0); } while (0)
#define PG8_WAIT_V(n) asm volatile("s_waitcnt vmcnt(" #n ")" ::: "memory")
#define PG8_WAIT_L(n) asm volatile("s_waitcnt lgkmcnt(" #n ")" ::: "memory")
#define PG8_BAR __builtin_amdgcn_s_barrier()
#define PG8_SCHED __builtin_amdgcn_sched_barrier(0)
    Unit cur, nxt; int ui = 0;
    if (!S.next(0, cur)) return;
    f32x4 acc[2][2][4][2];
#pragma unroll
    for (int a = 0; a < 2; ++a)
#pragma unroll
        for (int b = 0; b < 2; ++b)
#pragma unroll
            for (int m = 0; m < 4; ++m)
#pragma unroll
                for (int n = 0; n < 2; ++n) acc[a][b][m][n] = (f32x4){0.f, 0.f, 0.f, 0.f};
    bf16x8 At[4][2], B0[2][2], B1[2][2];
    const char* cA = (const char*)g.A + (size_t)cur.pm * tstepA; const char* cB = (const char*)g.Bt + (size_t)cur.pn * tstepB;
    S.a_ready(cur);
    if constexpr (SP2) {
        PG8_STAGE(PG8_SB(0, 0), cB, voffB); PG8_STAGE(PG8_SB(0, 1), cB + hstepB, voffB); PG8_STAGE(PG8_SA(0, 0), cA, voffA); PG8_STAGE(PG8_SA(0, 1), cA + hstepA, voffA);
        if (wr == 1) PG8_BAR;
        PG8_WAIT_V(2); PG8_BAR;
        PG8_STAGE(PG8_SB(1, 0), cB + kstep, voffB); PG8_STAGE(PG8_SA(1, 0), cA + kstep, voffA); PG8_STAGE(PG8_SB(1, 1), cB + hstepB + kstep, voffB);
        PG8_WAIT_V(6); PG8_BAR;
    } else {
        PG8_STAGE(PG8_SB(0, 0), cB, voffB); PG8_STAGE(PG8_SA(0, 0), cA, voffA); PG8_STAGE(PG8_SB(0, 1), cB + hstepB, voffB); PG8_STAGE(PG8_SA(0, 1), cA + hstepA, voffA);
        if (wr == 1) PG8_BAR;
        PG8_WAIT_V(4); PG8_BAR;
        PG8_STAGE(PG8_SB(1, 0), cB + kstep, voffB); PG8_STAGE(PG8_SA(1, 0), cA + kstep, voffA); PG8_STAGE(PG8_SB(1, 1), cB + hstepB + kstep, voffB);
        PG8_WAIT_V(6); PG8_BAR;
    }
    for (;;) {
        const bool has_next = S.next(ui + 1, nxt);
        const char* nA = has_next ? (const char*)g.A + (size_t)nxt.pm * tstepA : cA; const char* nB = has_next ? (const char*)g.Bt + (size_t)nxt.pn * tstepB : cB;
        PG8_LAS unsigned char* epi_lds = lds + EPI_LDS_OFF + (ui & 1) * EPI_LDS_HALF;
        E.prefetch(epi_lds, cur, wid, lane);
        for (int t = 0; t < nt; t += 2) {
            const bool last = (t == nt - 2);
            const char* a1 = cA + (size_t)(t + 1) * kstep;
            const char* a2 = last ? nA : cA + (size_t)(t + 2) * kstep; const char* b2 = last ? nB : cB + (size_t)(t + 2) * kstep;
            const char* a3 = a2 + kstep; const char* b3 = b2 + kstep;
            if (last && has_next) S.a_ready(nxt);
            if constexpr (SP2) {
            PG8_LDB(B0, 0, 0); PG8_LDB(B1, 0, 1); PG8_SCHED; PG8_LDA(At, 0, 0); PG8_STAGE(PG8_SA(1, 1), a1 + hstepA, voffA);
            PG8_WAIT_V(8); PG8_WAIT_L(0); PG8_BAR; PG8_MMA(0, 0, At, B0); PG8_MMA(0, 1, At, B1); PG8_BAR; PG8_SCHED;
            PG8_LDA(At, 0, 1); PG8_STAGE(PG8_SB(0, 0), b2, voffB); PG8_STAGE(PG8_SB(0, 1), b2 + hstepB, voffB); PG8_STAGE(PG8_SA(0, 0), a2, voffA);
            PG8_WAIT_V(8); PG8_WAIT_L(0); PG8_BAR; PG8_MMA(1, 0, At, B0); PG8_MMA(1, 1, At, B1); PG8_BAR; PG8_SCHED;
            PG8_LDB(B0, 1, 0); PG8_LDB(B1, 1, 1); PG8_SCHED; PG8_LDA(At, 1, 0); PG8_STAGE(PG8_SA(0, 1), a2 + hstepA, voffA);
            PG8_WAIT_V(8); PG8_WAIT_L(0); PG8_BAR; PG8_MMA(0, 0, At, B0); PG8_MMA(0, 1, At, B1); PG8_BAR; PG8_SCHED;
            PG8_LDA(At, 1, 1); PG8_STAGE(PG8_SB(1, 0), b3, voffB); PG8_STAGE(PG8_SB(1, 1), b3 + hstepB, voffB); PG8_STAGE(PG8_SA(1, 0), a3, voffA);
            PG8_WAIT_V(8); PG8_WAIT_L(0); PG8_BAR; PG8_MMA(1, 0, At, B0); PG8_MMA(1, 1, At, B1); PG8_BAR; PG8_SCHED;
            } else {
            PG8_LDB(B0, 0, 0); PG8_SCHED; PG8_LDA(At, 0, 0); PG8_STAGE(PG8_SA(1, 1), a1 + hstepA, voffA);
            PG8_WAIT_L(8); PG8_BAR; PG8_WAIT_L(0); PG8_MMA(0, 0, At, B0); PG8_BAR; PG8_SCHED;
            PG8_LDB(B1, 0, 1); PG8_STAGE(PG8_SB(0, 0), b2, voffB);
            PG8_BAR; PG8_WAIT_L(0); PG8_MMA(0, 1, At, B1); PG8_BAR;
            PG8_LDA(At, 0, 1); PG8_STAGE(PG8_SA(0, 0), a2, voffA);
            PG8_BAR; PG8_WAIT_L(0); PG8_MMA(1, 0, At, B0); PG8_BAR; PG8_SCHED;
            PG8_STAGE(PG8_SB(0, 1), b2 + hstepB, voffB);
            PG8_WAIT_V(6); PG8_BAR; PG8_MMA(1, 1, At, B1); PG8_BAR;
            PG8_LDB(B0, 1, 0); PG8_SCHED; PG8_LDA(At, 1, 0); PG8_STAGE(PG8_SA(0, 1), a2 + hstepA, voffA);
            PG8_WAIT_L(8); PG8_BAR; PG8_WAIT_L(0); PG8_MMA(0, 0, At, B0); PG8_BAR; PG8_SCHED;
            PG8_LDB(B1, 1, 1); PG8_STAGE(PG8_SB(1, 0), b3, voffB);
            PG8_BAR; PG8_WAIT_L(0); PG8_MMA(0, 1, At, B1); PG8_BAR;
            PG8_LDA(At, 1, 1); PG8_STAGE(PG8_SA(1, 0), a3, voffA);
            PG8_BAR; PG8_WAIT_L(0); PG8_MMA(1, 0, At, B0); PG8_BAR; PG8_SCHED;
            PG8_STAGE(PG8_SB(1, 1), b3 + hstepB, voffB);
            PG8_WAIT_V(6); PG8_BAR; PG8_MMA(1, 1, At, B1); PG8_BAR;
            }
        }
        if constexpr (ALIGN_EPI) { if (wr == 0) PG8_BAR; }
        if constexpr (!Epi::AFTER_DRAIN) { int ln_; asm volatile("v_mbcnt_lo_u32_b32 %0, -1, 0\n\tv_mbcnt_hi_u32_b32 %0, -1, %0" : "=v"(ln_));
            E(acc, cur, wr, wc, ln_ & 15, ln_ >> 4, epi_lds); S.done(cur); }
        if (!has_next) break;
#pragma unroll
        for (int a = 0; a < 2; ++a)
#pragma unroll
            for (int b = 0; b < 2; ++b)
#pragma unroll
                for (int m = 0; m < 4; ++m)
#pragma unroll
                    for (int n = 0; n < 2; ++n) acc[a][b][m][n] = (f32x4){0.f, 0.f, 0.f, 0.f};
        cur = nxt; cA = nA; cB = nB; ++ui;
        if constexpr (ALIGN_EPI) { if (wr == 1) PG8_BAR; }
    }
    PG8_WAIT_V(0);
    if constexpr (!ALIGN_EPI) { if (wr == 0) PG8_BAR; }
    PG8_BAR;
    if constexpr (Epi::AFTER_DRAIN) { E.fused(acc, cur, wr, wc, fr, fq, lds, wid, lane); S.done(cur); }
#undef PG8_SA
#undef PG8_SB
#undef PG8_STAGE
#undef PG8_LDA
#undef PG8_LDB
#undef PG8_MMA
#undef PG8_WAIT_V
#undef PG8_WAIT_L
#undef PG8_BAR
#undef PG8_SCHED
}
}
#undef LAS
#define LAS __attribute__((address_space(3)))
#define XB_TMO      128
#define XB_XCNT(j)  (256  + 64 * (j))
#define XB_XSUB(j)  (1280 + 64 * (j))
#define XB_XGEN(j)  (2304 + 64 * (j))
#define XB_TOP      3328
#define XB_TOPGEN   3392
#define XCD_BAR_WORDS 3456
#define XB_SPIN_CAP (1u << 22)

__device__ __forceinline__ unsigned xb_ld(unsigned* p)              { return __hip_atomic_load(p, __ATOMIC_RELAXED, __HIP_MEMORY_SCOPE_AGENT); }
__device__ __forceinline__ unsigned xb_add(unsigned* p, unsigned v) { return __hip_atomic_fetch_add(p, v, __ATOMIC_RELAXED, __HIP_MEMORY_SCOPE_AGENT); }
__device__ __forceinline__ unsigned xb_xcc_id() { return (unsigned)__builtin_amdgcn_s_getreg((3 << 11) | 20) & 0xFu; }
#define XB_SPIN(cond, bar) do { unsigned _sp = 0; while (cond) { __builtin_amdgcn_s_sleep(1); \
    if ((++_sp & 255u) == 0u) { if (xb_ld(&(bar)[XB_TMO])) break; if (_sp > XB_SPIN_CAP) { atomicAdd(&(bar)[XB_TMO], 1u); break; } } } } while (0)

struct XcdBarrier {
    unsigned* bar; unsigned x;
    volatile LAS unsigned* st;
};

__device__ __forceinline__ XcdBarrier xcd_barrier_post(unsigned* bar, volatile LAS unsigned* st) {
    XcdBarrier b; b.bar = bar; b.x = xb_xcc_id(); b.st = st;
    if (threadIdx.x == 0) (void)xb_add(&bar[XB_XCNT(b.x)], 1u);
    return b;
}
__device__ __forceinline__ void xcd_barrier_complete(unsigned* bar, unsigned x, unsigned& nloc, unsigned& nx) {
    const unsigned G = gridDim.x * gridDim.y * gridDim.z;
    unsigned sum, cnt, mine, sp = 0u;
    for (;;) {
        sum = 0u; cnt = 0u; mine = 0u;
#pragma unroll
        for (unsigned j = 0; j < 16; ++j) { const unsigned c = xb_ld(&bar[XB_XCNT(j)]); sum += c; cnt += (c > 0u) ? 1u : 0u; mine = (j == x) ? c : mine; }
        if (sum == G) break;
        __builtin_amdgcn_s_sleep(1);
        if ((++sp & 255u) == 0u) { if (xb_ld(&bar[XB_TMO])) break; if (sp > XB_SPIN_CAP) { atomicAdd(&bar[XB_TMO], 1u); break; } }
    }
    nloc = mine > 0u ? mine : 1u; nx = cnt > 0u ? cnt : 1u;
}

__device__ __forceinline__ void xcd_barrier(const XcdBarrier& b) {
    asm volatile("s_waitcnt vmcnt(0)" ::: "memory");
    __syncthreads();
    if (threadIdx.x == 0) {
        unsigned* bar = b.bar;
        __builtin_amdgcn_s_waitcnt(0);
        unsigned nloc = b.st[0], nx = b.st[1];
        if (nloc == 0u) { xcd_barrier_complete(bar, b.x, nloc, nx); b.st[0] = nloc; b.st[1] = nx; }
        const unsigned old = xb_add(&bar[XB_XSUB(b.x)], 1u);
        const unsigned gen = old / nloc;
        if (old + 1u == (gen + 1u) * nloc) {
            __builtin_amdgcn_fence(__ATOMIC_RELEASE, "agent");
            asm volatile("s_waitcnt vmcnt(0)" ::: "memory");
            const unsigned og = xb_add(&bar[XB_TOP], 1u);
            const unsigned tg = og / nx;
            if (og + 1u == (tg + 1u) * nx) xb_add(&bar[XB_TOPGEN], 1u);
            else XB_SPIN(xb_ld(&bar[XB_TOPGEN]) == tg, bar);
            __builtin_amdgcn_fence(__ATOMIC_ACQUIRE, "agent");
            xb_add(&bar[XB_XGEN(b.x)], 1u);
            asm volatile("s_waitcnt vmcnt(0)" ::: "memory");
        } else {
            XB_SPIN(xb_ld(&bar[XB_XGEN(b.x)]) == gen, bar);
            __builtin_amdgcn_fence(__ATOMIC_ACQUIRE, "agent");
            asm volatile("s_waitcnt vmcnt(0)" ::: "memory");
        }
    }
    __syncthreads();
}
namespace att {
typedef short s16x4 __attribute__((ext_vector_type(4)));
typedef float f32x16 __attribute__((ext_vector_type(16)));
constexpr int SHM_V = 16384, SHM_K = 16384;
constexpr int OFF_V = 0, OFF_K = 2 * SHM_V, OFF_WS = OFF_K + 2 * SHM_K, OFF_TB = OFF_WS + 8 * 64 * 4;
constexpr float SCALE = 0.088388347648318440f, LOG2E = 1.4426950408889634f, CS = SCALE * LOG2E;
constexpr float THR2 = 8.0f * LOG2E;
#define KSWZ(row, colB) ((row) * 256 + ((colB) ^ (((row) & 7) << 4)))
#define SBAR() __builtin_amdgcn_sched_barrier(0)
__device__ __forceinline__ int crow(int r, int hi) { return (r & 3) + 8 * (r >> 2) + 4 * hi; }
__device__ __forceinline__ unsigned cvtpk(float lo, float hi) { unsigned r; asm volatile("v_cvt_pk_bf16_f32 %0, %1, %2" : "=v"(r) : "v"(lo), "v"(hi)); return r; }
__device__ __forceinline__ void qkt(f32x16& p0, f32x16& p1, const char* Ks, const bf16x8* qr, int r32, int hi) {
  p0 = f32x16{}; p1 = f32x16{};
#pragma unroll
  for (int d0 = 0; d0 < 8; ++d0) { const int cb = (d0 * 16 + hi * 8) * 2;
    const bf16x8 b0 = *reinterpret_cast<const bf16x8*>(Ks + KSWZ(r32, cb));
    const bf16x8 b1 = *reinterpret_cast<const bf16x8*>(Ks + KSWZ(32 + r32, cb));
    p0 = __builtin_amdgcn_mfma_f32_32x32x16_bf16(b0, qr[d0], p0, 0, 0, 0);
    p1 = __builtin_amdgcn_mfma_f32_32x32x16_bf16(b1, qr[d0], p1, 0, 0, 0); }
}
__device__ __forceinline__ int v_st(int k, int c) { const int kk = (k & ~0xC) | ((k & 4) << 1) | ((k & 8) >> 1); return ((kk >> 3) * 4 + (c >> 5)) * 512 + ((kk & 7) * 32 + (c & 31)) * 2; }
__device__ __forceinline__ int v_rd_base(int lane) { return ((lane & 3) << 3) | (((lane >> 2) & 3) << 6) | (((lane >> 4) & 1) << 5) | (((lane >> 5) & 1) << 8); }
constexpr int v_rd_off(int d0, int ks, int half) { return d0 * 512 + ks * 4096 + half * 2048; }
template <int OFF> __device__ __forceinline__ s16x4 tr_read(int vb) { s16x4 r; asm volatile("ds_read_b64_tr_b16 %0, %1 offset:%2" : "=&v"(r) : "v"(vb), "i"(OFF) : "memory"); return r; }
template <int D0> __device__ __forceinline__ void pv_one(f32x16& od, int vb, bf16x8 pa0, bf16x8 pa1, bf16x8 pa2, bf16x8 pa3) {
  const s16x4 l0 = tr_read<v_rd_off(D0, 0, 0)>(vb), h0 = tr_read<v_rd_off(D0, 0, 1)>(vb), l1 = tr_read<v_rd_off(D0, 1, 0)>(vb), h1 = tr_read<v_rd_off(D0, 1, 1)>(vb);
  const s16x4 l2 = tr_read<v_rd_off(D0, 2, 0)>(vb), h2 = tr_read<v_rd_off(D0, 2, 1)>(vb), l3 = tr_read<v_rd_off(D0, 3, 0)>(vb), h3 = tr_read<v_rd_off(D0, 3, 1)>(vb);
  asm volatile("s_waitcnt lgkmcnt(0)" ::: "memory"); SBAR();
#define PK(L, H) (bf16x8){L[0], L[1], L[2], L[3], H[0], H[1], H[2], H[3]}
  od = __builtin_amdgcn_mfma_f32_32x32x16_bf16(pa0, PK(l0, h0), od, 0, 0, 0);
  od = __builtin_amdgcn_mfma_f32_32x32x16_bf16(pa1, PK(l1, h1), od, 0, 0, 0);
  od = __builtin_amdgcn_mfma_f32_32x32x16_bf16(pa2, PK(l2, h2), od, 0, 0, 0);
  od = __builtin_amdgcn_mfma_f32_32x32x16_bf16(pa3, PK(l3, h3), od, 0, 0, 0);
#undef PK
}
__device__ __forceinline__ void band_unit(const bf16_t* __restrict__ Qb, bf16_t* __restrict__ Ob, const bf16_t* __restrict__ Kh, const bf16_t* __restrict__ Vh, const float* __restrict__ relb, int h, int c0, int nw, char* lds, int tid_in) {
  int tid = tid_in; asm volatile("" : "+v"(tid));
  const int wid = __builtin_amdgcn_readfirstlane(tid >> 6), lane = tid & 63, r32 = lane & 31, hi = lane >> 5;
  char* V_lds = lds + OFF_V; char* K_lds = lds + OFF_K;
  float* wsf = (float*)(lds + OFF_WS) + wid * 64; float* li_l = wsf; float* al_l = wsf + 32; float* tb = (float*)(lds + OFF_TB);
  const bool won = wid < nw; const int cw = c0 + (wid >> 1);
  const int t_lo = c0 > 8 ? c0 - 8 : 0, t_hi = c0 + ((nw + 1) >> 1) - 1;
  if (tid < 257) tb[tid] = relb[tid * NH + h] * LOG2E;
  float m_reg = -1e30f, l_reg = 0.f; f32x16 o[4] = {}; bf16x8 qr[8];
  { const bf16_t* Qw = Qb + (size_t)((won ? wid : 0) * 32 + r32) * D + hi * 8;
#pragma unroll
    for (int d0 = 0; d0 < 8; ++d0) qr[d0] = *reinterpret_cast<const bf16x8*>(Qw + d0 * 16); }
  const int sr = tid >> 4, sc = (tid & 15) * 8, vst0 = v_st(sr, sc), vst1 = v_st(32 + sr, sc);
  const int vb0 = (int)(uintptr_t)V_lds + v_rd_base(lane);
  bf16x8 vs0, vs1, ks0, ks1;
#define SLOAD(k0) do { vs0 = *reinterpret_cast<const bf16x8*>(&Vh[(size_t)((k0) + sr) * D + sc]); vs1 = *reinterpret_cast<const bf16x8*>(&Vh[(size_t)((k0) + 32 + sr) * D + sc]); \
    ks0 = *reinterpret_cast<const bf16x8*>(&Kh[(size_t)((k0) + sr) * D + sc]); ks1 = *reinterpret_cast<const bf16x8*>(&Kh[(size_t)((k0) + 32 + sr) * D + sc]); } while (0)
#define SWRITE(b) do { *(bf16x8*)(V_lds + (b) * SHM_V + vst0) = vs0; *(bf16x8*)(V_lds + (b) * SHM_V + vst1) = vs1; const int kc = sc * 2; \
    *(bf16x8*)(K_lds + (b) * SHM_K + KSWZ(sr, kc)) = ks0; *(bf16x8*)(K_lds + (b) * SHM_K + KSWZ(32 + sr, kc)) = ks1; } while (0)
  SLOAD(t_lo * 64); asm volatile("s_waitcnt vmcnt(0)" ::: "memory"); SWRITE(0); __syncthreads();
  for (int t = t_lo; t <= t_hi; ++t) {
    const int buf = (t - t_lo) & 1;
    if (t < t_hi) SLOAD((t + 1) * 64);
    const int dch = cw - t;
    if (won && dch >= 0 && dch <= 8) {
      f32x16 p0, p1;
      qkt(p0, p1, K_lds + buf * SHM_K, qr, r32, hi);
      if (dch >= 3) { const float bc = tb[256];
#pragma unroll
        for (int r = 0; r < 16; ++r) { p0[r] = fmaf(p0[r], CS, bc); p1[r] = fmaf(p1[r], CS, bc); } }
      else { const int base = 64 * dch + 32 * (wid & 1) + r32 - 4 * hi;
#pragma unroll
        for (int r = 0; r < 16; ++r) { const int j0 = (r & 3) + 8 * (r >> 2); int i0 = base - j0, i1 = base - 32 - j0; i0 = (i0 > 128 ? 128 : i0) + 128; i1 = (i1 > 128 ? 128 : i1) + 128;
          p0[r] = fmaf(p0[r], CS, tb[i0]); p1[r] = fmaf(p1[r], CS, tb[i1]); } }
      float pmax = p0[0];
#pragma unroll
      for (int r = 1; r < 16; ++r) pmax = fmaxf(pmax, p0[r]);
#pragma unroll
      for (int r = 0; r < 16; ++r) pmax = fmaxf(pmax, p1[r]);
      { auto rr = __builtin_amdgcn_permlane32_swap(__float_as_uint(pmax), __float_as_uint(pmax), false, false); pmax = fmaxf(__uint_as_float(rr[0]), __uint_as_float(rr[1])); }
      float mn, alpha;
      if (__all(pmax - m_reg <= THR2)) { mn = m_reg; alpha = 1.f; } else { mn = fmaxf(m_reg, pmax); alpha = __builtin_amdgcn_exp2f(m_reg - mn); m_reg = mn; }
      float ps = 0.f;
#pragma unroll
      for (int r = 0; r < 16; ++r) { p0[r] = __builtin_amdgcn_exp2f(p0[r] - mn); p1[r] = __builtin_amdgcn_exp2f(p1[r] - mn); ps += p0[r] + p1[r]; }
      { auto rr = __builtin_amdgcn_permlane32_swap(__float_as_uint(ps), __float_as_uint(ps), false, false); ps = __uint_as_float(rr[0]) + __uint_as_float(rr[1]); }
      l_reg = l_reg * alpha + ps;
      if (__any(alpha < 1.f)) { if (hi == 0) al_l[r32] = alpha; asm volatile("s_waitcnt lgkmcnt(0)" ::: "memory");
#pragma unroll
        for (int d = 0; d < 4; ++d)
#pragma unroll
          for (int r = 0; r < 16; ++r) o[d][r] *= al_l[crow(r, hi)]; }
      bf16x8 pa0, pa1, pa2, pa3;
#define PK4(P, BASE, OUT) do { unsigned a0 = cvtpk(P[BASE + 0], P[BASE + 1]), a1 = cvtpk(P[BASE + 2], P[BASE + 3]); unsigned b0 = cvtpk(P[BASE + 4], P[BASE + 5]), b1 = cvtpk(P[BASE + 6], P[BASE + 7]); \
    auto r0 = __builtin_amdgcn_permlane32_swap(a0, b0, false, false); auto r1 = __builtin_amdgcn_permlane32_swap(a1, b1, false, false); u32x4 w = {r0[0], r1[0], r0[1], r1[1]}; OUT = *reinterpret_cast<bf16x8*>(&w); } while (0)
      PK4(p0, 0, pa0); PK4(p0, 8, pa1); PK4(p1, 0, pa2); PK4(p1, 8, pa3);
#undef PK4
      const int vb = vb0 + buf * SHM_V;
      pv_one<0>(o[0], vb, pa0, pa1, pa2, pa3); pv_one<1>(o[1], vb, pa0, pa1, pa2, pa3); pv_one<2>(o[2], vb, pa0, pa1, pa2, pa3); pv_one<3>(o[3], vb, pa0, pa1, pa2, pa3);
    }
    if (t < t_hi) { asm volatile("s_waitcnt vmcnt(0)" ::: "memory"); SWRITE(buf ^ 1); }
    __syncthreads();
  }
  if (hi == 0) li_l[r32] = l_reg; asm volatile("s_waitcnt lgkmcnt(0)" ::: "memory");
  if (won) {
    char* ost = lds + wid * 8192;
#pragma unroll
    for (int r = 0; r < 16; ++r) { const int orow = crow(r, hi); const float rl = __builtin_amdgcn_rcpf(li_l[orow]);
#pragma unroll
      for (int d0 = 0; d0 < 4; ++d0) *(bf16_t*)(ost + orow * 256 + (d0 * 32 + r32) * 2) = (bf16_t)f2bf(o[d0][r] * rl); }
    asm volatile("s_waitcnt lgkmcnt(0)" ::: "memory");
    bf16_t* Ow = Ob + (size_t)(wid * 32) * D;
#pragma unroll
    for (int k = 0; k < 8; ++k) { const int row = (lane >> 4) + 4 * k, c16 = lane & 15; const u32x4 v = *(const u32x4*)(ost + row * 256 + c16 * 16); *(u32x4*)(Ow + (size_t)row * D + c16 * 8) = v; }
  }
  __syncthreads();
#undef SLOAD
#undef SWRITE
}
#undef KSWZ
#undef SBAR

__device__ __forceinline__ void attn_phase(char* lds, const bf16_t* Q, bf16_t* O, const bf16_t* Kp, const bf16_t* Vp, const bf16_t* Ks, const bf16_t* Vs, const float* relb, int vcu, int G, int tid) {
  for (int bh = vcu; bh < PB * NH; bh += G) { const int b = bh >> 4, h = bh & 15;
    const bf16_t* Kh = Kp + (size_t)b * PS * D + h * HD; const bf16_t* Vh = Vp + (size_t)b * PS * D + h * HD;
    for (int qb = 0; qb < 8; ++qb) band_unit(Q + ((size_t)b * PS + qb * 256) * D + h * HD, O + ((size_t)b * PS + qb * 256) * D + h * HD, Kh, Vh, relb, h, 4 * qb, 8, lds, tid); }
  for (int u = vcu; u < SB * NH; u += G) { const int b = u >> 4, h = u & 15;
    band_unit(Q + ((size_t)TP + (size_t)b * SS) * D + h * HD, O + ((size_t)TP + (size_t)b * SS) * D + h * HD, Ks + (size_t)b * BAND * D + h * HD, Vs + (size_t)b * BAND * D + h * HD, relb, h, 8, 2, lds, tid); }
}
}

namespace rg {
constexpr int XP = 264, GP = 136;
constexpr int OFF_XB = 0, OFF_XC = 35840, OFF_GT = 69632, OFF_CW = 87040;
constexpr float LOG2E = 1.4426950408889634f;
__device__ __forceinline__ float softplus_neg(float l) {
    const float y = __expf(-fabsf(l)); const float lp = y < 0.02f ? y * (1.f - y * (0.5f - y * (0.33333334f - 0.25f * y))) : __logf(1.f + y); return (l > 0.f ? 0.f : -l) + lp; }
__device__ __forceinline__ float neg_expm1(float x) {
    const float s = -x * (1.f + x * (0.5f + x * (0.16666667f + x * (0.041666668f + x * (0.0083333338f + x * 0.0013888889f))))); const float e = 1.f - __expf(x); return x > -0.3f ? s : e; }
__device__ __forceinline__ float neg_expm1_series(float x) { return -x * (1.f + x * (0.5f + x * (0.16666667f + x * (0.041666668f + x * (0.0083333338f + x * 0.0013888889f))))); }
__device__ __forceinline__ float bperm(float v, int addr) { return __int_as_float(__builtin_amdgcn_ds_bpermute(addr, __float_as_int(v))); }
__device__ __forceinline__ bf16x8 cvt8(const float* p) { const f32x4 a = *(const f32x4*)p, b = *(const f32x4*)(p + 4); u32x4 w; w.x = pk2(a[0], a[1]); w.y = pk2(a[2], a[3]); w.z = pk2(b[0], b[1]); w.w = pk2(b[2], b[3]); return *reinterpret_cast<bf16x8*>(&w); }

__device__ __forceinline__ void rg_unit(char* lds, const bf16_t* __restrict__ xb, const bf16_t* __restrict__ gin, bf16_t* __restrict__ hgo, const bf16_t* __restrict__ wai, const float* __restrict__ cw, const float* __restrict__ cb,
                                        const float* __restrict__ b_a, const float* __restrict__ b_i, const float* __restrict__ lam, const float* __restrict__ sconv, const float* __restrict__ h0p, float* __restrict__ rnn_out,
                                        size_t m0, int nchunks, int cbase, int hf, bool pos0, int tid_in) {
    int tid = tid_in; asm volatile("" : "+v"(tid));
    const int wid = __builtin_amdgcn_readfirstlane(tid >> 6), lane = tid & 63, fr = lane & 15, fq = lane >> 4;
    bf16_t* XB = (bf16_t*)(lds + OFF_XB); bf16_t* XC = (bf16_t*)(lds + OFF_XC); bf16_t* GT = (bf16_t*)(lds + OFF_GT); float* CW = (float*)(lds + OFF_CW);
    const int chl = hf * 128 + 16 * wid + fr, ch = cbase + chl, gcol = cbase + hf * 128;
    bf16x8 Bf[2][8];
#pragma unroll
    for (int nt = 0; nt < 2; ++nt)
#pragma unroll
        for (int ks = 0; ks < 8; ++ks) Bf[nt][ks] = *reinterpret_cast<const bf16x8*>(wai + (size_t)(2 * chl + nt) * 256 + 32 * ks + 8 * fq);
    if (tid < 256) {
#pragma unroll
        for (int k = 0; k < 4; ++k) CW[k * 256 + tid] = cw[k * D + cbase + tid];
        CW[4 * 256 + tid] = cb[cbase + tid]; }
    const float ba = b_a[ch], bi = b_i[ch], sp = softplus_neg(lam[ch]), c8l = -8.f * sp * LOG2E, c2 = -16.f * sp;
    float H = h0p ? h0p[ch] : 0.f;
    const bool small_x = __all(c2 > -0.3f);
#pragma unroll
    for (int i = 0; i < 5; ++i) { const int p = tid + 512 * i; if (p < 67 * 32) { const int row = p >> 5, pc = p & 31; bf16x8 v;
        if (row >= 3) v = *reinterpret_cast<const bf16x8*>(xb + (m0 + row - 3) * D + cbase + 8 * pc);
        else if (sconv) v = cvt8(sconv + (size_t)row * D + cbase + 8 * pc); else v = (bf16x8){0, 0, 0, 0, 0, 0, 0, 0};
        *reinterpret_cast<bf16x8*>(XB + row * XP + 8 * pc) = v; } }
#pragma unroll
    for (int i = 0; i < 2; ++i) { const int p = tid + 512 * i, row = p >> 4, pc = p & 15; *reinterpret_cast<bf16x8*>(GT + row * GP + 8 * pc) = *reinterpret_cast<const bf16x8*>(gin + (m0 + row) * D + gcol + 8 * pc); }
    __syncthreads();
    const int a16 = (lane >= 16 ? lane - 16 : lane) << 2, a32 = (lane >= 32 ? lane - 32 : lane) << 2, a48 = (fr + 48) << 2;
    for (int c = 0; c < nchunks; ++c) {
        const size_t mc = m0 + (size_t)c * 64; const bool more = c + 1 < nchunks;
        { const int pc = tid & 31, r4 = (tid >> 5) * 4; f32x2 y[4][4], wk[4][4];
          { const f32x4 b0 = *(const f32x4*)(CW + 4 * 256 + 8 * pc), b1 = *(const f32x4*)(CW + 4 * 256 + 8 * pc + 4);
#pragma unroll
            for (int o = 0; o < 4; ++o) { y[o][0] = (f32x2){b0[0], b0[1]}; y[o][1] = (f32x2){b0[2], b0[3]}; y[o][2] = (f32x2){b1[0], b1[1]}; y[o][3] = (f32x2){b1[2], b1[3]}; } }
#pragma unroll
          for (int k = 0; k < 4; ++k) { const f32x4 w0 = *(const f32x4*)(CW + k * 256 + 8 * pc), w1 = *(const f32x4*)(CW + k * 256 + 8 * pc + 4);
              wk[k][0] = (f32x2){w0[0], w0[1]}; wk[k][1] = (f32x2){w0[2], w0[3]}; wk[k][2] = (f32x2){w1[0], w1[1]}; wk[k][3] = (f32x2){w1[2], w1[3]}; }
#pragma unroll
          for (int j = 0; j < 7; ++j) { const u32x4 xr = *reinterpret_cast<const u32x4*>(XB + (r4 + j) * XP + 8 * pc); f32x2 xv[4];
              xv[0] = (f32x2){__uint_as_float(xr.x << 16), __uint_as_float(xr.x & 0xffff0000u)}; xv[1] = (f32x2){__uint_as_float(xr.y << 16), __uint_as_float(xr.y & 0xffff0000u)};
              xv[2] = (f32x2){__uint_as_float(xr.z << 16), __uint_as_float(xr.z & 0xffff0000u)}; xv[3] = (f32x2){__uint_as_float(xr.w << 16), __uint_as_float(xr.w & 0xffff0000u)};
#pragma unroll
              for (int o = 0; o < 4; ++o) { const int k = j - o; if (k >= 0 && k < 4) {
#pragma unroll
                  for (int p = 0; p < 4; ++p) y[o][p] = wk[k][p] * xv[p] + y[o][p]; } } }
#pragma unroll
          for (int o = 0; o < 4; ++o) { u32x4 w; w.x = pk2(y[o][0][0], y[o][0][1]); w.y = pk2(y[o][1][0], y[o][1][1]); w.z = pk2(y[o][2][0], y[o][2][1]); w.w = pk2(y[o][3][0], y[o][3][1]); *(u32x4*)(XC + (r4 + o) * XP + 8 * pc) = w; } }
        __syncthreads();
        bf16x8 px[5], pg[2]; int t2 = tid; asm volatile("" : "+v"(t2));
        if (more) {
#pragma unroll
            for (int i = 0; i < 5; ++i) { const int p = t2 + 512 * i; if (p < 67 * 32) px[i] = *reinterpret_cast<const bf16x8*>(xb + (mc + 61 + (p >> 5)) * D + cbase + 8 * (p & 31)); }
#pragma unroll
            for (int i = 0; i < 2; ++i) { const int p = t2 + 512 * i; pg[i] = *reinterpret_cast<const bf16x8*>(gin + (mc + 64 + (p >> 4)) * D + gcol + 8 * (p & 15)); } }
        f32x4 acc[4][2];
#pragma unroll
        for (int m = 0; m < 4; ++m) { acc[m][0] = (f32x4){0.f, 0.f, 0.f, 0.f}; acc[m][1] = (f32x4){0.f, 0.f, 0.f, 0.f}; }
#pragma unroll
        for (int ks = 0; ks < 8; ++ks) { bf16x8 af[4];
#pragma unroll
            for (int m = 0; m < 4; ++m) af[m] = *reinterpret_cast<const bf16x8*>(XC + (16 * m + fr) * XP + 32 * ks + 8 * fq);
#pragma unroll
            for (int m = 0; m < 4; ++m) { acc[m][0] = __builtin_amdgcn_mfma_f32_16x16x32_bf16(af[m], Bf[0][ks], acc[m][0], 0, 0, 0); acc[m][1] = __builtin_amdgcn_mfma_f32_16x16x32_bf16(af[m], Bf[1][ks], acc[m][1], 0, 0, 0); } }
#pragma unroll
        for (int m = 0; m < 4; ++m)
#pragma unroll
            for (int rgi = 0; rgi < 4; ++rgi) { const int tok = 16 * m + 4 * fq + rgi;
                const float xcv = bf2f(XC[tok * XP + chl]);
                const float r = __builtin_amdgcn_rcpf(1.f + __expf(-(acc[m][0][rgi] + ba))), ig = __builtin_amdgcn_rcpf(1.f + __expf(-(acc[m][1][rgi] + bi)));
                const float av = __builtin_amdgcn_exp2f(r * c8l); const float x2 = r * c2;
                float mult = __builtin_amdgcn_sqrtf(small_x ? neg_expm1_series(x2) : neg_expm1(x2)); if (pos0 && c == 0 && tok == 0) mult = 1.f;
                acc[m][0][rgi] = av; acc[m][1][rgi] = mult * ig * xcv; }
#pragma unroll
        for (int m = 0; m < 4; ++m) {
            float A = 1.f, B = 0.f;
#pragma unroll
            for (int rgi = 0; rgi < 4; ++rgi) { B = acc[m][0][rgi] * B + acc[m][1][rgi]; A *= acc[m][0][rgi]; }
            { const float Ap = bperm(A, a16), Bp = bperm(B, a16); if (fq >= 1) { B = A * Bp + B; A = A * Ap; } }
            { const float Ap = bperm(A, a32), Bp = bperm(B, a32); if (fq >= 2) { B = A * Bp + B; A = A * Ap; } }
            float Ae = bperm(A, a16), Be = bperm(B, a16); if (fq == 0) { Ae = 1.f; Be = 0.f; }
            const float At = bperm(A, a48), Bt = bperm(B, a48);
            float h = Ae * H + Be; H = At * H + Bt;
#pragma unroll
            for (int rgi = 0; rgi < 4; ++rgi) { h = acc[m][0][rgi] * h + acc[m][1][rgi]; acc[m][1][rgi] = h; } }
#pragma unroll
        for (int m = 0; m < 4; ++m)
#pragma unroll
            for (int rgi = 0; rgi < 4; ++rgi) { bf16_t* gp = GT + (16 * m + 4 * fq + rgi) * GP + 16 * wid + fr; *gp = (bf16_t)f2bf(acc[m][1][rgi] * bf2f(*gp)); }
        if (!more && fq == 0) rnn_out[ch] = H;
        __syncthreads();
#pragma unroll
        for (int i = 0; i < 2; ++i) { const int p = tid + 512 * i, row = p >> 4, pc = p & 15; *(u32x4*)(hgo + (mc + row) * D + gcol + 8 * pc) = *(const u32x4*)(GT + row * GP + 8 * pc); }
        __syncthreads();
        if (more) {
#pragma unroll
            for (int i = 0; i < 5; ++i) { const int p = t2 + 512 * i; if (p < 67 * 32) *reinterpret_cast<bf16x8*>(XB + (p >> 5) * XP + 8 * (p & 31)) = px[i]; }
#pragma unroll
            for (int i = 0; i < 2; ++i) { const int p = t2 + 512 * i; *reinterpret_cast<bf16x8*>(GT + (p >> 4) * GP + 8 * (p & 15)) = pg[i]; }
            __syncthreads(); }
    }
    __syncthreads();
}

__device__ __forceinline__ void rglru_phase(char* lds, const bf16_t* xb, const bf16_t* gin, bf16_t* hgo, const bf16_t* wai, const float* cw, const float* cb, const float* b_a, const float* b_i, const float* lam,
                                            const float* sconv, const float* srnn, float* rnnp, float* rnns, int vcu, int G, int tid) {
    for (int uu = vcu; uu < (PB + SB) * 16; uu += G) { const bool samp = uu >= PB * 16; const int u = samp ? uu - PB * 16 : uu; const int b = u >> 4, n = (u >> 1) & 7, hf = u & 1;
        rg_unit(lds, xb, gin, hgo, wai + (size_t)n * 512 * 256, cw, cb, b_a, b_i, lam, samp ? sconv + (size_t)b * 3 * D : nullptr, samp ? srnn + (size_t)b * D : nullptr, (samp ? rnns : rnnp) + (size_t)b * D,
                samp ? (size_t)TP + (size_t)b * SS : (size_t)b * PS, samp ? 1 : PS / 64, n * 256, hf, !samp, tid); }
}
}

constexpr int NWAVES = 8;
constexpr int RING_BYTES = 139264;
constexpr int MISC_OFF = RING_BYTES + 320;
constexpr int LDS_BYTES = 159744;
static_assert(EPI_LDS_OFF >= MISC_OFF + 256 && EPI_LDS_OFF + 2 * EPI_LDS_HALF <= LDS_BYTES, "epilogue prefetch area inside the LDS allocation");
using pg8::bf16_t;

__device__ __forceinline__ float lane_xor_f(float v, int lane4) { return __int_as_float(__builtin_amdgcn_ds_bpermute(lane4, __float_as_int(v))); }
__device__ __forceinline__ float wave_sum(float v, int lane) {
#pragma unroll
    for (int o = 1; o < 64; o <<= 1) v += lane_xor_f(v, (lane ^ o) << 2);
    return v;
}
__device__ __forceinline__ float wave_max(float v, int lane) {
#pragma unroll
    for (int o = 1; o < 64; o <<= 1) v = fmaxf(v, lane_xor_f(v, (lane ^ o) << 2));
    return v;
}

struct Args { const float* in[32]; float* out; unsigned char* ws; };
typedef const __attribute__((address_space(4))) unsigned char* kaptr_t;
__device__ __forceinline__ kaptr_t ka_fresh() { kaptr_t ka = (kaptr_t)__builtin_amdgcn_kernarg_segment_ptr(); asm volatile("" : "+s"(ka)); return ka; }
__device__ __forceinline__ const float* arg_in(kaptr_t ka, int i) { return *(const float* const __attribute__((address_space(4)))*)(ka + 8 * i); }
__device__ __forceinline__ float* arg_out(kaptr_t ka) { return *(float* const __attribute__((address_space(4)))*)(ka + 8 * 32); }
__device__ __forceinline__ unsigned char* arg_ws(kaptr_t ka) { return *(unsigned char* const __attribute__((address_space(4)))*)(ka + 8 * 33); }
#define GAS __attribute__((address_space(1)))
struct TItem { const GAS float* W; GAS bf16_t* WT; const GAS float* kscale  ; int K, N, mode, off, item; };
__device__ __forceinline__ void t_load(const TItem& t, float (&v)[32], int lane) {
    const int nblk = t.N / 32, kb = t.item / nblk, nb = t.item % nblk; const GAS float* p = t.W + (size_t)(64 * kb + (lane >> 5)) * t.N + 32 * nb + (lane & 31);
#pragma unroll
    for (int i = 0; i < 32; ++i) v[i] = p[(size_t)(2 * i) * t.N];
    if (t.kscale) { const GAS float* ks = t.kscale + 64 * kb + (lane >> 5);
#pragma unroll
        for (int i = 0; i < 32; ++i) v[i] *= ks[2 * i]; }
}
__device__ __forceinline__ void t_finish(const TItem& t, const float (&v)[32], LAS float* scr, int lane) {
    const int nblk = t.N / 32, kb = t.item / nblk, nb = t.item % nblk, k0 = 64 * kb, n0 = 32 * nb;
#pragma unroll
    for (int i = 0; i < 32; ++i) scr[(2 * i + (lane >> 5)) * 33 + (lane & 31)] = v[i];
    LDS_WAIT(); asm volatile("" ::: "memory");
    const int c = lane & 7;
#pragma unroll
    for (int j = 0; j < 4; ++j) { const int n = (lane >> 3) + 8 * j; const LAS float* s = scr + (8 * c) * 33 + n;
        u32x4 o; o.x = pk2(s[0 * 33], s[1 * 33]); o.y = pk2(s[2 * 33], s[3 * 33]); o.z = pk2(s[4 * 33], s[5 * 33]); o.w = pk2(s[6 * 33], s[7 * 33]);
        const int nc = n0 + n; const int drow = t.mode == 0 ? t.off + nc : (t.mode == 1 ? ((nc >> 7) * 256 + (nc & 127) + t.off) : (2 * nc + t.off));
        *(GAS u32x4*)(t.WT + (size_t)drow * t.K + k0 + 8 * c) = o; }
}
constexpr int T_IB = 2048;
constexpr int T_I13 = 32 * (DFF / 32);
constexpr int T_I2 = (DFF / 64) * 64;
constexpr int T_S0 = 6 * T_IB, T_S1 = T_S0 + 4 * T_IB, T_S2 = T_S1 + 2 * T_IB, T_S3 = T_S2 + 32 * 32, T_S4 = T_S3 + 8 * T_I13, T_S5 = T_S4 + 4 * T_I2;
__device__ __forceinline__ TItem t_decode(kaptr_t ka, int it) {
    unsigned char* ws = arg_ws(ka); TItem t; t.kscale = nullptr;
    if (it < T_S0) { const int mi = it / T_IB, l = mi / 3, ty = mi % 3;
        t.W = (const GAS float*)((ty == 0 ? arg_in(ka, 13) : (ty == 1 ? arg_in(ka, 12) : arg_in(ka, 21))) + (size_t)l * D * D); t.WT = (GAS bf16_t*)(ty == 2 ? (bf16_t*)(ws + WS_WRGO) + (size_t)l * D * D : (bf16_t*)(ws + WS_WGI) + (size_t)l * 2 * D * D);
        t.K = D; t.N = D; t.mode = 0; t.off = ty == 1 ? D : 0; t.item = it % T_IB; }
    else if (it < T_S1) { const int q = it - T_S0, mi = q / T_IB, l = mi >> 1, ty = mi & 1;
        t.W = (const GAS float*)((ty == 0 ? arg_in(ka, 25) : arg_in(ka, 26)) + (size_t)l * D * D); t.WT = (GAS bf16_t*)((bf16_t*)(ws + (ty == 0 ? WS_WQ : WS_WO)) + (size_t)l * D * D); t.K = D; t.N = D; t.mode = 0; t.off = 0; t.item = q % T_IB; }
    else if (it < T_S2) { const int q = it - T_S1, ty = q / T_IB;
        t.W = (const GAS float*)(ty == 0 ? arg_in(ka, 23) : arg_in(ka, 24)); t.WT = (GAS bf16_t*)((bf16_t*)(ws + WS_WKV)); t.kscale = (const GAS float*)arg_in(ka, 22);     t.K = D; t.N = D; t.mode = 0; t.off = ty == 0 ? 0 : D; t.item = q % T_IB; }
    else if (it < T_S3) { const int q = it - T_S2, mi = q / 32, ln = mi >> 1, ty = mi & 1;
        t.W = (const GAS float*)((ty == 0 ? arg_in(ka, 16) : arg_in(ka, 18)) + (size_t)ln * 256 * 256); t.WT = (GAS bf16_t*)((bf16_t*)(ws + WS_WAI) + (size_t)ln * 512 * 256); t.K = 256; t.N = 256; t.mode = 2; t.off = ty; t.item = q % 32; }
    else if (it < T_S4) { const int q = it - T_S3, mi = q / T_I13, l = mi >> 1, ty = mi & 1;
        t.W = (const GAS float*)((ty == 0 ? arg_in(ka, 28) : arg_in(ka, 29)) + (size_t)l * D * DFF); t.WT = (GAS bf16_t*)((bf16_t*)(ws + WS_W13) + (size_t)l * 2 * DFF * D); t.K = D; t.N = DFF; t.mode = 1; t.off = ty * 128; t.item = q % T_I13; }
    else { const int q = it - T_S4, l = q / T_I2;
        t.W = (const GAS float*)(arg_in(ka, 30) + (size_t)l * DFF * D); t.WT = (GAS bf16_t*)((bf16_t*)(ws + WS_W2) + (size_t)l * D * DFF); t.K = DFF; t.N = D; t.mode = 0; t.off = 0; t.item = q % T_I2; }
    return t;
}
__device__ __forceinline__ void p0_weights(kaptr_t ka, LAS unsigned char* lds, int gw, int NGW, int wave, int lane) {
    LAS float* scr0 = (LAS float*)(lds + wave * 16896); LAS float* scr1 = scr0 + 64 * 33;
    for (int it = 2 * gw; it < T_S5; it += 2 * NGW) {
        const TItem t0 = t_decode(ka, it), t1 = t_decode(ka, it + 1);
        float v0[32], v1[32];
        t_load(t0, v0, lane); t_load(t1, v1, lane);
        t_finish(t0, v0, scr0, lane); t_finish(t1, v1, scr1, lane);
        LDS_WAIT(); asm volatile("" ::: "memory");
    }
}

__device__ __forceinline__ void p0_cache(const float* __restrict__ ck, const float* __restrict__ cv, bf16_t* __restrict__ KS, bf16_t* __restrict__ VS, int gw, int NGW, int lane) {
    constexpr int STEPS = SB * LEFT * D / 512;
    for (int it0 = 4 * gw; it0 < 2 * STEPS; it0 += 4 * NGW) {
        f32x4 x0[4], x1[4];
#pragma unroll
        for (int u = 0; u < 4; ++u) { const int it = it0 + u; const bool isv = it >= STEPS; const size_t e = (size_t)(isv ? it - STEPS : it) * 512 + lane * 8; const float* src = (isv ? cv : ck) + e; x0[u] = *(const f32x4*)src; x1[u] = *(const f32x4*)(src + 4); }
#pragma unroll
        for (int u = 0; u < 4; ++u) { const int it = it0 + u; const bool isv = it >= STEPS; const size_t e = (size_t)(isv ? it - STEPS : it) * 512 + lane * 8;
            const size_t bj = e >> 11, col = e & (D - 1), b = bj >> 9, j = bj & (LEFT - 1);
            u32x4 w; w.x = pk2(x0[u][0], x0[u][1]); w.y = pk2(x0[u][2], x0[u][3]); w.z = pk2(x1[u][0], x1[u][1]); w.w = pk2(x1[u][2], x1[u][3]);
            *(u32x4*)((isv ? VS : KS) + (b * BAND + j) * D + col) = w; }
    }
}

__device__ __forceinline__ void p0_mod(const float* __restrict__ c_p, const float* __restrict__ c_s, const float* __restrict__ ada_w, const float* __restrict__ ada_b, float* __restrict__ mod, LAS unsigned char* lds, int vcu, int G, int tid) {
    LAS float* cs = (LAS float*)lds;
    LAS float* red = (LAS float*)lds;
    const int cp = tid & 31, ks = tid >> 5, lane = tid & 63, wv = tid >> 6;
    for (int item = vcu; item < 4 * 192; item += G) {
        const int l = item / 192, j0 = (item % 192) * 64;
        f32x2 acc[NBB];
#pragma unroll
        for (int bb = 0; bb < NBB; ++bb) acc[bb] = (f32x2){0.f, 0.f};
        for (int kc = 0; kc < 8; ++kc) {
            __syncthreads();
#pragma unroll 4
            for (int i = 0; i < 24; ++i) { const int idx = tid + 512 * i, bb = idx >> 8, kk = idx & 255; const float c = bb < PB ? c_p[bb * D + kc * 256 + kk] : c_s[(bb - PB) * D + kc * 256 + kk]; cs[kk * NBB + bb] = c / (1.0f + __expf(-c)); }
            __syncthreads();
            f32x2 w2[16];
            const float* wp = ada_w + ((size_t)l * D + kc * 256 + ks * 16) * MODW + j0 + 2 * cp;
#pragma unroll
            for (int i = 0; i < 16; ++i) w2[i] = *(const f32x2*)(wp + (size_t)i * MODW);
#pragma unroll
            for (int i = 0; i < 16; ++i) { const LAS f32x4* cr = (const LAS f32x4*)(cs + (ks * 16 + i) * NBB);
#pragma unroll
                for (int q = 0; q < 12; ++q) { const f32x4 c4 = cr[q];
#pragma unroll
                    for (int e = 0; e < 4; ++e) acc[4 * q + e] += w2[i] * c4[e]; } }
        }
#pragma unroll
        for (int bb = 0; bb < NBB; ++bb) {
            { auto r = __builtin_amdgcn_permlane32_swap(__float_as_uint(acc[bb][0]), __float_as_uint(acc[bb][0]), false, false); acc[bb][0] = __uint_as_float(r[0]) + __uint_as_float(r[1]); }
            { auto r = __builtin_amdgcn_permlane32_swap(__float_as_uint(acc[bb][1]), __float_as_uint(acc[bb][1]), false, false); acc[bb][1] = __uint_as_float(r[0]) + __uint_as_float(r[1]); } }
        __syncthreads();
        if (lane < 32) {
#pragma unroll
            for (int bb = 0; bb < NBB; ++bb) { red[(wv * 96 + 2 * bb) * 32 + lane] = acc[bb][0]; red[(wv * 96 + 2 * bb + 1) * 32 + lane] = acc[bb][1]; } }
        __syncthreads();
#pragma unroll
        for (int i = 0; i < 6; ++i) { const int o = tid + 512 * i, bb = o >> 6, col = o & 63, v = 2 * bb + (col & 1), c2 = col >> 1; float s = ada_b[l * MODW + j0 + col];
#pragma unroll
            for (int w = 0; w < 8; ++w) s += red[(w * 96 + v) * 32 + c2];
            mod[((size_t)l * NBB + bb) * MODW + j0 + col] = s; }
    }
    __syncthreads();
}

__device__ __forceinline__ void gm_tables(const float* __restrict__ g_mix, const float* __restrict__ g_ffn, const float* __restrict__ mod, float* __restrict__ gm, int gtid, int nthreads) {
    for (int e = gtid; e < 8 * NBB * (D / 4); e += nthreads) { const int k4 = e % (D / 4), b = (e / (D / 4)) % NBB, i = e / ((D / 4) * NBB), l = i >> 1;
        const f32x4 g = *(const f32x4*)((i & 1 ? g_ffn : g_mix) + (size_t)l * D + 4 * k4), sc = *(const f32x4*)(mod + ((size_t)l * NBB + b) * MODW + (i & 1 ? 4 * D : D) + 4 * k4);
        *(f32x4*)(gm + ((size_t)i * NBB + b) * D + 4 * k4) = g * (sc + 1.0f); }
}
__device__ __forceinline__ void norm0_pass(const float* __restrict__ xp_, const float* __restrict__ xs_, bf16_t* __restrict__ X, bf16_t* __restrict__ xg, const float* __restrict__ g, const float* __restrict__ mod0, pg8::ssq_t* __restrict__ ssq0, int gw, int NGW, int lane) {
    for (int m0 = gw; m0 < T; m0 += 2 * NGW) {
        const int m1 = m0 + NGW; const bool two = m1 < T; const int mb = two ? m1 : m0;
        const f32x4* xr0 = (const f32x4*)(m0 < TP ? xp_ + (size_t)m0 * D : xs_ + (size_t)(m0 - TP) * D) + lane;
        const f32x4* xr1 = (const f32x4*)(mb < TP ? xp_ + (size_t)mb * D : xs_ + (size_t)(mb - TP) * D) + lane;
        f32x4 v0[8], v1[8];
#pragma unroll
        for (int j = 0; j < 8; ++j) { v0[j] = xr0[64 * j]; v1[j] = xr1[64 * j]; }
#pragma unroll
        for (int r = 0; r < 2; ++r) { if (r == 1 && !two) break; const int m = r ? m1 : m0; const f32x4* v = r ? v1 : v0; float ss = 0.f;
#pragma unroll
            for (int j = 0; j < 8; ++j) ss += (v[j][0] * v[j][0] + v[j][1] * v[j][1]) + (v[j][2] * v[j][2] + v[j][3] * v[j][3]);
            ss = wave_sum(ss, lane); if (lane == 0) ssq0[m] = pg8::ssq_fix(ss);
            const int bb = row_bb(m); const f32x4* gp = (const f32x4*)g + lane; const f32x4* sc = (const f32x4*)(mod0 + (size_t)bb * MODW + D) + lane;
            u32x2* xc = (u32x2*)(X + (size_t)m * XPITCH) + lane; u32x2* o = (u32x2*)(xg + (size_t)m * D) + lane;
#pragma unroll
            for (int j = 0; j < 8; ++j) { { u32x2 w; w.x = pk2(v[j][0], v[j][1]); w.y = pk2(v[j][2], v[j][3]); xc[64 * j] = w; } const f32x4 z = v[j] * (gp[64 * j] * (sc[64 * j] + 1.0f)); u32x2 w; w.x = pk2(z[0], z[1]); w.y = pk2(z[2], z[3]); o[64 * j] = w; } }
    }
}
__device__ __forceinline__ void shw_tile(const float* __restrict__ sh, const bf16_t* __restrict__ Wt, float* __restrict__ dst, int N, int n0, int lane) {
    const int fr = lane & 15, fq = lane >> 4;
    f32x4 acc[3][4];
#pragma unroll
    for (int m = 0; m < 3; ++m)
#pragma unroll
        for (int j = 0; j < 4; ++j) acc[m][j] = (f32x4){0.f, 0.f, 0.f, 0.f};
    const float* ap = sh + (size_t)fr * MODW + 8 * fq; const bf16_t* bp = Wt + (size_t)(n0 + fr) * D + 8 * fq;
#pragma unroll 4
    for (int k0 = 0; k0 < D; k0 += 32) { bf16x8 af[3], bfr[4];
#pragma unroll
        for (int m = 0; m < 3; ++m) { const f32x4 x0 = *(const f32x4*)(ap + (size_t)(16 * m) * MODW + k0), x1 = *(const f32x4*)(ap + (size_t)(16 * m) * MODW + k0 + 4); u32x4 w; w.x = pk2(x0[0], x0[1]); w.y = pk2(x0[2], x0[3]); w.z = pk2(x1[0], x1[1]); w.w = pk2(x1[2], x1[3]); af[m] = *reinterpret_cast<bf16x8*>(&w); }
#pragma unroll
        for (int j = 0; j < 4; ++j) bfr[j] = *reinterpret_cast<const bf16x8*>(bp + (size_t)(16 * j) * D + k0);
#pragma unroll
        for (int m = 0; m < 3; ++m)
#pragma unroll
            for (int j = 0; j < 4; ++j) acc[m][j] = __builtin_amdgcn_mfma_f32_16x16x32_bf16(af[m], bfr[j], acc[m][j], 0, 0, 0); }
#pragma unroll
    for (int m = 0; m < 3; ++m)
#pragma unroll
        for (int j = 0; j < 4; ++j)
#pragma unroll
            for (int r = 0; r < 4; ++r) dst[(size_t)(16 * m + 4 * fq + r) * N + n0 + 16 * j + fr] = acc[m][j][r];
}
__device__ __forceinline__ void shw_phase(const float* __restrict__ mod, unsigned char* ws, int vcu, int G, int wave, int lane) {
    float* shw = (float*)(ws + WS_SHW);
    for (int t = vcu + G * wave; t < 896; t += G * NWAVES) {
        if (t < 128) { const int l = t >> 6, n0 = (t & 63) * 64; shw_tile(mod + (size_t)l * NBB * MODW, (const bf16_t*)(ws + WS_WGI) + (size_t)l * 2 * D * D, shw + SHW_GI + (size_t)l * NBB * 2 * D, 2 * D, n0, lane); }
        else if (t < 192) { const int bl = (t - 128) >> 5, n0 = ((t - 128) & 31) * 64; shw_tile(mod + (size_t)(2 + bl) * NBB * MODW, (const bf16_t*)(ws + WS_WQ) + (size_t)bl * D * D, shw + SHW_Q + (size_t)bl * NBB * D, D, n0, lane); }
        else { const int q = t - 192, l = q / 176, n0 = (q % 176) * 64; shw_tile(mod + (size_t)l * NBB * MODW + 3 * D, (const bf16_t*)(ws + WS_W13) + (size_t)l * 2 * DFF * D, shw + SHW_13 + (size_t)l * NBB * 2 * DFF, 2 * DFF, n0, lane); }
    }
}
__device__ __forceinline__ void final_pass(float* Y, const float* __restrict__ g, const pg8::ssq_t* __restrict__ ssq, int gw, int NGW, int lane) {
    for (int m0 = gw; m0 < T; m0 += 2 * NGW) {
        const int m1 = m0 + NGW; const bool two = m1 < T; const int mb = two ? m1 : m0;
        const u32x2* x0 = (const u32x2*)((const bf16_t*)(Y + (size_t)m0 * D) + D) + lane; const u32x2* x1 = (const u32x2*)((const bf16_t*)(Y + (size_t)mb * D) + D) + lane; const f32x4* gp = (const f32x4*)g + lane;
        u32x2 v0[8], v1[8];
#pragma unroll
        for (int j = 0; j < 8; ++j) { v0[j] = x0[64 * j]; v1[j] = x1[64 * j]; }
        const float r0 = pg8::rstd_of(ssq[m0]), r1 = pg8::rstd_of(ssq[mb]);
        asm volatile("s_waitcnt vmcnt(0)" ::: "memory");
        f32x4* y0 = (f32x4*)(Y + (size_t)m0 * D) + lane; f32x4* y1 = (f32x4*)(Y + (size_t)mb * D) + lane;
#pragma unroll
        for (int j = 0; j < 8; ++j) { const f32x4 xv = {__uint_as_float(v0[j].x << 16), __uint_as_float(v0[j].x & 0xffff0000u), __uint_as_float(v0[j].y << 16), __uint_as_float(v0[j].y & 0xffff0000u)}; y0[64 * j] = (xv * r0) * gp[64 * j]; }
        if (two) {
#pragma unroll
            for (int j = 0; j < 8; ++j) { const f32x4 xv = {__uint_as_float(v1[j].x << 16), __uint_as_float(v1[j].x & 0xffff0000u), __uint_as_float(v1[j].y << 16), __uint_as_float(v1[j].y & 0xffff0000u)}; y1[64 * j] = (xv * r1) * gp[64 * j]; } }
    }
}

#define fresh_tid() ({ int l_; asm volatile("v_mbcnt_lo_u32_b32 %0, -1, 0\n\tv_mbcnt_hi_u32_b32 %0, -1, %0" : "=v"(l_)); (wave_s_ << 6) | l_; })
__device__ __forceinline__ int fresh_s(int v) { asm volatile("" : "+s"(v)); return v; }
#define WSP(off) ((bf16_t*)(arg_ws(ka) + (off)))

__global__ void __launch_bounds__(NWAVES * 64, 2) mega_fwd(Args a_unused) {
    extern __shared__ __attribute__((aligned(16))) unsigned char lds_raw[];
    LAS unsigned char* lds = (LAS unsigned char*)lds_raw;
    const int G_ = gridDim.x, bx_ = blockIdx.x; const int wave_s_ = __builtin_amdgcn_readfirstlane((int)threadIdx.x >> 6);
#define G (fresh_s(G_))
#define bx (fresh_s(bx_))
#define TID (fresh_tid())
#define LANE (fresh_tid() & 63)
#define WAVE (__builtin_amdgcn_readfirstlane(fresh_tid() >> 6))
#define VCU ((G % 8 == 0) ? (bx % 8) * (G / 8) + bx / 8 : bx)
#define GW (VCU * NWAVES + WAVE)
#define NGW (G * NWAVES)
    for (int u = TID; u < (LDS_BYTES - RING_BYTES) / 4; u += NWAVES * 64) ((LAS unsigned*)(lds + RING_BYTES))[u] = 0u;
    __syncthreads();
    XcdBarrier bar;
    { kaptr_t ka = ka_fresh(); bar = xcd_barrier_post((unsigned*)(arg_ws(ka) + WS_CTL) + CW_BAR, (volatile LAS unsigned*)(lds + MISC_OFF) + 8); }
#define GRID_BAR() do { XcdBarrier b2_ = bar; __attribute__((address_space(1))) unsigned* gb_ = (__attribute__((address_space(1))) unsigned*)bar.bar; asm volatile("" : "+s"(gb_), "+s"(b2_.x)); b2_.bar = (unsigned*)gb_; xcd_barrier(b2_); } while (0)

    { kaptr_t ka = ka_fresh(); pg8::ssq_t* sq = (pg8::ssq_t*)(arg_ws(ka) + WS_SSQ);
      for (int i = VCU * (NWAVES * 64) + TID; i < 9 * T; i += G * NWAVES * 64) sq[i] = 0ull; }
    { kaptr_t ka = ka_fresh(); p0_weights(ka, lds, GW, NGW, WAVE, LANE); }
    { kaptr_t ka = ka_fresh(); p0_cache(arg_in(ka, 6), arg_in(ka, 7), WSP(WS_KS), WSP(WS_VS), GW, NGW, LANE); }
    __syncthreads();
    { kaptr_t ka = ka_fresh(); p0_mod(arg_in(ka, 2), arg_in(ka, 3), arg_in(ka, 8), arg_in(ka, 9), (float*)(arg_ws(ka) + WS_MOD), lds, VCU, G, TID); }
    GRID_BAR();

    { kaptr_t ka = ka_fresh(); const float* mod = (const float*)(arg_ws(ka) + WS_MOD);
      gm_tables(arg_in(ka, 10), arg_in(ka, 11), mod, (float*)(arg_ws(ka) + WS_GM), VCU * (NWAVES * 64) + TID, G * NWAVES * 64); }
    { kaptr_t ka = ka_fresh(); shw_phase((const float*)(arg_ws(ka) + WS_MOD), arg_ws(ka), VCU, G, WAVE, LANE); }
    { kaptr_t ka = ka_fresh();
      norm0_pass(arg_in(ka, 0), arg_in(ka, 1), (bf16_t*)(arg_out(ka) + O_Y) + D, WSP(WS_HN), arg_in(ka, 10), (const float*)(arg_ws(ka) + WS_MOD), (pg8::ssq_t*)(arg_ws(ka) + WS_SSQ), GW, NGW, LANE); }
    GRID_BAR();

#define SSQP(i) ((pg8::ssq_t*)(arg_ws(ka) + WS_SSQ) + (size_t)(i) * T)
#define GMP(i) ((const float*)(arg_ws(ka) + WS_GM) + (size_t)(i) * NBB * D)
#define MODL(l) ((const float*)(arg_ws(ka) + WS_MOD) + (size_t)(l) * NBB * MODW)
#define SHWP(off) ((const float*)(arg_ws(ka) + WS_SHW) + (off))
#pragma unroll 1
    for (int l = 0; l < 4; ++l) {
        if (l < 2) {
            { kaptr_t ka = ka_fresh(); float* out = arg_out(ka);
              pg8::Gemm g{WSP(WS_HN), WSP(WS_WGI) + (size_t)l * 2 * D * D, T, 2 * D, D}; pg8::ORD_GI S; S.init(T, 2 * D, G, bx);
              pg8::EpiGateInP E{WSP(WS_BA), WSP(WS_BB), out + O_CONVP + (size_t)l * PB * 3 * D, out + O_CONVS + (size_t)l * SB * 3 * D, SSQP(2 * l), SHWP(SHW_GI + (size_t)l * NBB * 2 * D)};
              pg8::gemm_phase<pg8::EpiGateInP, pg8::ORD_GI, true, true>(lds, g, S, E, TID); }
            GRID_BAR();
            { kaptr_t ka = ka_fresh(); float* out = arg_out(ka);
              rg::rglru_phase((char*)lds_raw, WSP(WS_BB), WSP(WS_BA), WSP(WS_HN), WSP(WS_WAI) + (size_t)l * 8 * 512 * 256, arg_in(ka, 14) + (size_t)l * 4 * D, arg_in(ka, 15) + (size_t)l * D, arg_in(ka, 17) + (size_t)l * D, arg_in(ka, 19) + (size_t)l * D,
                              arg_in(ka, 20) + (size_t)l * D, arg_in(ka, 4) + (size_t)l * SB * 3 * D, arg_in(ka, 5) + (size_t)l * SB * D, out + O_RNNP + (size_t)l * PB * D, out + O_RNNS + (size_t)l * SB * D, VCU, G, TID); }
            GRID_BAR();
            { kaptr_t ka = ka_fresh();
              pg8::Gemm g{WSP(WS_HN), WSP(WS_WRGO) + (size_t)l * D * D, T, D, D}; pg8::ORD_R S; S.init(T, D, G, bx);
              pg8::EpiResidP E{(bf16_t*)(arg_out(ka) + O_Y) + D, MODL(l) + 2 * D, WSP(WS_BA), GMP(2 * l + 1), SSQP(2 * l + 1)};
              pg8::gemm_phase<pg8::EpiResidP, pg8::ORD_R, true, true>(lds, g, S, E, TID); }
        } else {
            if (l == 2) { kaptr_t ka = ka_fresh();
              pg8::Gemm g{(bf16_t*)(arg_out(ka) + O_Y) + D, WSP(WS_WKV), T, 2 * D, D, XPITCH}; pg8::ORD_KV S; S.init(T, 2 * D, G, bx);
              pg8::EpiKVP E{WSP(WS_BB), WSP(WS_BC), WSP(WS_KS), WSP(WS_VS), arg_out(ka), SSQP(4)};
              pg8::gemm_phase<pg8::EpiKVP, pg8::ORD_KV, true, true>(lds, g, S, E, TID); }
            { kaptr_t ka = ka_fresh();
              pg8::Gemm g{WSP(WS_HN), WSP(WS_WQ) + (size_t)(l - 2) * D * D, T, D, D}; pg8::ORD_Q S; S.init(T, D, G, bx);
              pg8::EpiQP E{WSP(WS_HID), SSQP(2 * l), SHWP(SHW_Q + (size_t)(l - 2) * NBB * D)};
              pg8::gemm_phase<pg8::EpiQP, pg8::ORD_Q, true, true>(lds, g, S, E, TID); }
            GRID_BAR();
            { kaptr_t ka = ka_fresh();
              att::attn_phase((char*)lds_raw, WSP(WS_HID), WSP(WS_HN), WSP(WS_BB), WSP(WS_BC), WSP(WS_KS), WSP(WS_VS), arg_in(ka, 27) + (size_t)(l - 2) * (2 * RELC + 1) * NH, VCU, G, TID); }
            GRID_BAR();
            { kaptr_t ka = ka_fresh();
              pg8::Gemm g{WSP(WS_HN), WSP(WS_WO) + (size_t)(l - 2) * D * D, T, D, D}; pg8::ORD_R S; S.init(T, D, G, bx);
              pg8::EpiResidP E{(bf16_t*)(arg_out(ka) + O_Y) + D, MODL(l) + 2 * D, WSP(WS_BA), GMP(2 * l + 1), SSQP(2 * l + 1)};
              pg8::gemm_phase<pg8::EpiResidP, pg8::ORD_R, true, true>(lds, g, S, E, TID); }
        }
        GRID_BAR();
        { kaptr_t ka = ka_fresh();
          pg8::Gemm g{WSP(WS_BA), WSP(WS_W13) + (size_t)l * 2 * DFF * D, T, 2 * DFF, D}; pg8::ORD_F13 S; S.init(T, 2 * DFF, G, bx);
          pg8::EpiFfn13P E{WSP(WS_HID), SSQP(2 * l + 1), SHWP(SHW_13 + (size_t)l * NBB * 2 * DFF)};
          pg8::gemm_phase<pg8::EpiFfn13P, pg8::ORD_F13, true, true>(lds, g, S, E, TID);
          }
        GRID_BAR();
        { kaptr_t ka = ka_fresh();
          pg8::Gemm g{WSP(WS_HID), WSP(WS_W2) + (size_t)l * D * DFF, T, D, DFF}; pg8::ORD_F2 S; S.init(T, D, G, bx);
          pg8::EpiResidP E{(bf16_t*)(arg_out(ka) + O_Y) + D, MODL(l) + 5 * D, WSP(WS_HN), GMP(l < 3 ? 2 * l + 2 : 0), SSQP(2 * l + 2)};
          pg8::gemm_phase<pg8::EpiResidP, pg8::ORD_F2, true, true>(lds, g, S, E, TID); }
        GRID_BAR();
    }
    { kaptr_t ka = ka_fresh(); final_pass(arg_out(ka) + O_Y, arg_in(ka, 31), SSQP(8), GW, NGW, LANE); }
}

extern "C" void kernel_launch(void* const* d_in, const int* in_sizes, int n_in, void* d_out, int out_size, void* d_ws, size_t ws_size, hipStream_t stream) {
    (void)in_sizes; (void)out_size;
    static int grid = 0;
    if (grid == 0) {
        if (n_in != 32 || ws_size < WS_END) { fprintf(stderr, "kernel_launch: unexpected n_in %d / ws %zu\n", n_in, ws_size); grid = -1; return; }
        int dev = 0, cus = 0, per_cu = 0;
        if (hipGetDevice(&dev) != hipSuccess || hipDeviceGetAttribute(&cus, hipDeviceAttributeMultiprocessorCount, dev) != hipSuccess) { grid = -1; return; }
        if (hipFuncSetAttribute((const void*)mega_fwd, hipFuncAttributeMaxDynamicSharedMemorySize, LDS_BYTES) != hipSuccess) { fprintf(stderr, "kernel_launch: hipFuncSetAttribute failed\n"); grid = -1; return; }
        if (hipOccupancyMaxActiveBlocksPerMultiprocessor(&per_cu, (const void*)mega_fwd, NWAVES * 64, LDS_BYTES) != hipSuccess || per_cu < 1) fprintf(stderr, "kernel_launch: occupancy query says %d\n", per_cu);
        (void)hipGetLastError();
        grid = cus;
    }
    if (grid < 0) return;
    if (hipMemsetAsync((char*)d_ws + WS_CTL, 0, CTL_ZERO_BYTES, stream) != hipSuccess) return;
    Args a{};
    for (int i = 0; i < 32; ++i) a.in[i] = (const float*)d_in[i];
    a.out = (float*)d_out; a.ws = (unsigned char*)d_ws;
    hipLaunchKernelGGL(mega_fwd, dim3(grid), dim3(NWAVES * 64), LDS_BYTES, stream, a);
}
```

```cpp
#include <hip/hip_runtime.h>
#include <cstdio>
#include <cstdint>

typedef unsigned short bf16_t;
typedef short bf16x8 __attribute__((ext_vector_type(8)));
typedef float f32x4 __attribute__((ext_vector_type(4)));
typedef float f32x2 __attribute__((ext_vector_type(2)));
typedef unsigned u32x2 __attribute__((ext_vector_type(2)));
typedef unsigned u32x4 __attribute__((ext_vector_type(4)));
#define LAS __attribute__((address_space(3)))

constexpr int D = 2048, DFF = 5632, NH = 16, HD = 128;
constexpr int PB = 16, PS = 2048, SB = 32, SS = 64;
constexpr int TP = PB * PS;
constexpr int TS = SB * SS;
constexpr int T = TP + TS;
constexpr int NBB = PB + SB;
constexpr int MODW = 6 * D;
constexpr int LEFT = 512, BAND = 576, RELC = 128;
constexpr float EPS = 1e-6f;

constexpr size_t O_Y = 0;
constexpr int XPITCH = 2 * 2048;
constexpr size_t O_CONVP = (size_t)T * D;
constexpr size_t O_RNNP = O_CONVP + 2 * PB * 3 * D;
constexpr size_t O_KP = O_RNNP + 2 * PB * D;
constexpr size_t O_VP = O_KP + (size_t)PB * LEFT * D;
constexpr size_t O_CONVS = O_VP + (size_t)PB * LEFT * D;
constexpr size_t O_RNNS = O_CONVS + 2 * SB * 3 * D;
constexpr size_t O_KS = O_RNNS + 2 * SB * D;
constexpr size_t O_VS = O_KS + (size_t)SB * SS * D;
constexpr size_t O_END = O_VS + (size_t)SB * SS * D;
static_assert(O_END == 114032640, "output size");

constexpr size_t MiB = 1u << 20;
constexpr size_t WS_CTL = 0, CTL_ZERO_BYTES = 1 * MiB;
constexpr size_t WS_MOD = 1 * MiB;
constexpr size_t WS_WGI = 10 * MiB;
constexpr size_t WS_WRGO = 42 * MiB;
constexpr size_t WS_WAI = 58 * MiB;
constexpr size_t WS_WKV = 62 * MiB;
constexpr size_t WS_WQ = 78 * MiB;
constexpr size_t WS_WO = 94 * MiB;
constexpr size_t WS_W13 = 110 * MiB;
constexpr size_t WS_W2 = 286 * MiB;
constexpr size_t WS_HN = 374 * MiB;
constexpr size_t WS_BA = 510 * MiB;
constexpr size_t WS_BB = 646 * MiB;
constexpr size_t WS_BC = 782 * MiB;
constexpr size_t WS_HID = 918 * MiB;
constexpr size_t WS_KS = 1292 * MiB;
constexpr size_t WS_VS = 1364 * MiB;
constexpr size_t WS_SSQ = 1454 * MiB;
constexpr size_t SSQ_BYTES = 9 * (size_t)34816 * 8;
constexpr size_t WS_GM = 1438 * MiB;
constexpr size_t WS_SHW = 1442 * MiB;
constexpr size_t SHW_GI = 0, SHW_Q = 2 * 48 * 4096, SHW_13 = SHW_Q + 2 * 48 * 2048;
constexpr size_t WS_END = 1458 * MiB;
constexpr int EPI_LDS_OFF = 139264 + 2048, EPI_LDS_HALF = 8192;
constexpr int CW_BAR = 4096;

__device__ __forceinline__ float bf2f(bf16_t b) { return __uint_as_float(((unsigned)b) << 16); }
__device__ __forceinline__ unsigned f2bf(float f) { unsigned u = __float_as_uint(f); return (u + 0x7fffu + ((u >> 16) & 1u)) >> 16; }
__device__ __forceinline__ unsigned pk2(float lo, float hi) { return f2bf(lo) | (f2bf(hi) << 16); }
__device__ __forceinline__ int row_bb(int m) { return m < TP ? (m >> 11) : PB + ((m - TP) >> 6); }
__device__ __forceinline__ float fast_sigmoid(float x) { return __builtin_amdgcn_rcpf(1.0f + __expf(-x)); }
__device__ __forceinline__ f32x4 sigmoid4(const f32x4& x) { const f32x4 t = x * (-1.4426950408889634f); f32x4 e; e[0] = __builtin_amdgcn_exp2f(t[0]); e[1] = __builtin_amdgcn_exp2f(t[1]); e[2] = __builtin_amdgcn_exp2f(t[2]); e[3] = __builtin_amdgcn_exp2f(t[3]);
    const f32x4 d = e + 1.0f; f32x4 s; s[0] = __builtin_amdgcn_rcpf(d[0]); s[1] = __builtin_amdgcn_rcpf(d[1]); s[2] = __builtin_amdgcn_rcpf(d[2]); s[3] = __builtin_amdgcn_rcpf(d[3]); return s; }
__device__ __forceinline__ f32x4 gelu_tanh4(const f32x4& x) { const f32x4 u = (x * x * 0.044715f + 1.0f) * x * 1.5957691216057308f; return x * sigmoid4(u); }
__device__ __forceinline__ float gelu_tanh_fast(float x) { const float u = 1.5957691216057308f * (x + 0.044715f * x * x * x); return x * __builtin_amdgcn_rcpf(1.0f + __expf(-u)); }
#define LDS_WAIT() asm volatile("s_waitcnt lgkmcnt(0)" ::: "memory")
#define VM_WAIT() asm volatile("s_waitcnt vmcnt(0)" ::: "memory")

namespace pg8 {
#define PG8_LAS __attribute__((address_space(3)))
typedef unsigned short bf16_t;
typedef short bf16x8 __attribute__((ext_vector_type(8)));
typedef float f32x4 __attribute__((ext_vector_type(4)));
typedef unsigned u32x4 __attribute__((ext_vector_type(4)));
constexpr int BM = 256, BK = 64, HALF = 128, HTB = HALF * BK * 2  , STAGE_BYTES = 8 * HTB, NXCD = 8, WGM = 8;

__host__ __device__ __forceinline__ int lds_byte(int r, int c) { const int st = (r >> 4) * 2 + (c >> 5), rr = r & 15, cc = c & 31, ob = rr * 64 + cc * 2; return st * 1024 + (ob ^ (((ob >> 9) & 1) << 5)); }
__host__ __device__ __forceinline__ void stage_rc(int b, int& R, int& C) { const int st = b / 1024, sb = b % 1024, swz = sb ^ (((sb >> 9) & 1) << 5); R = (st >> 1) * 16 + swz / 64; C = (st & 1) * 32 + (swz % 64) / 2; }
__host__ __device__ __forceinline__ int perm32(int rho) { const int n = rho >> 4, i = rho & 15; return 8 * (i >> 2) + 4 * n + (i & 3); }

struct Unit { int pm, pn; };
struct Gemm { const bf16_t* A; const bf16_t* Bt; int M, N, K; int lda; };

template <int WG  > struct StaticOrderT {
    int nM, nN, nwg, G, c;
    __host__ __device__ void init(int M, int N, int G_, int c_) { nM = M / BM; nN = N / BM; nwg = nM * nN; G = G_; c = c_; }
    __host__ __device__ bool next(int i, Unit& u) const {
        const long L = (long)i * G + c; if (L >= nwg) return false;
        int wgid = (int)L; { const int q = nwg / NXCD, r = nwg % NXCD, xcd = wgid % NXCD, off = wgid / NXCD; wgid = (xcd < r ? xcd * (q + 1) : r * (q + 1) + (xcd - r) * q) + off; }
        const int nig = WG * nN, gid = wgid / nig, fm = gid * WG, gsz = (nM - fm) < WG ? (nM - fm) : WG;
        u.pm = fm + ((wgid % nig) % gsz); u.pn = (wgid % nig) / gsz; return true;
    }
    __device__ __forceinline__ void a_ready(const Unit&) const {}
    __device__ __forceinline__ void done(const Unit&) const {}
};
typedef StaticOrderT<WGM> StaticOrder;
#ifndef WG_GI
#define WG_GI 4
#endif
#ifndef WG_KV
#define WG_KV 4
#endif
#ifndef WG_Q
#define WG_Q 4
#endif
#ifndef WG_F13
#define WG_F13 4
#endif
#ifndef WG_R
#define WG_R 4
#endif
#ifndef WG_F2
#define WG_F2 4
#endif
typedef StaticOrderT<WG_GI> ORD_GI; typedef StaticOrderT<WG_KV> ORD_KV; typedef StaticOrderT<WG_Q> ORD_Q; typedef StaticOrderT<WG_F13> ORD_F13; typedef StaticOrderT<WG_R> ORD_R; typedef StaticOrderT<WG_F2> ORD_F2;
__device__ __forceinline__ unsigned cvt_pk_bf16(float lo, float hi) { unsigned r; asm volatile("v_cvt_pk_bf16_f32 %0, %1, %2" : "=v"(r) : "v"(lo), "v"(hi)); return r; }
typedef unsigned long long ssq_t;
constexpr float SSQ_SCALE = 65536.0f;
__device__ __forceinline__ ssq_t ssq_fix(float s) { return (ssq_t)(s * SSQ_SCALE + 0.5f); }
__device__ __forceinline__ float rstd_of(ssq_t ssq) { return __builtin_amdgcn_rsqf((float)ssq * (1.0f / (SSQ_SCALE * D)) + EPS); }
__device__ __forceinline__ void dma1k(const void* gsrc_lane, PG8_LAS unsigned char* dst_wave) { __builtin_amdgcn_global_load_lds((const unsigned*)gsrc_lane, (PG8_LAS unsigned*)dst_wave, 16, 0, 0); }
__device__ __forceinline__ void prefetch_norm(PG8_LAS unsigned char* area, const ssq_t* ssq, const float* shw, int shw_pitch, int pm, int pn, int wid, int lane) {
    if (wid < 2) dma1k(ssq + (size_t)pm * BM + wid * 128 + 2 * lane, area + wid * 1024);
    else if (wid < 6 && shw) { const int k = wid - 2, bb = row_bb(pm * BM + (k >> 1) * HALF + (k & 1) * 64); dma1k(shw + (size_t)bb * shw_pitch + pn * BM + 4 * lane, area + 2048 + k * 1024); }
}
__device__ __forceinline__ ssq_t lds_ssq(PG8_LAS unsigned char* area, int lrow) { return *(const PG8_LAS ssq_t*)(area + lrow * 8); }
__device__ __forceinline__ f32x4 lds_shw(PG8_LAS unsigned char* area, int k, int lcol) { return *(const PG8_LAS f32x4*)(area + 2048 + k * 1024 + lcol * 4); }
__device__ __forceinline__ u32x4 pack8(const f32x4& v0, const f32x4& v1) { u32x4 w; w.x = cvt_pk_bf16(v0[0], v0[1]); w.y = cvt_pk_bf16(v0[2], v0[3]); w.z = cvt_pk_bf16(v1[0], v1[1]); w.w = cvt_pk_bf16(v1[2], v1[3]); return w; }
__device__ __forceinline__ float sq4(const f32x4& o) { return (o[0] * o[0] + o[1] * o[1]) + (o[2] * o[2] + o[3] * o[3]); }

__device__ __forceinline__ void unpack8(const u32x4& w, f32x4& lo, f32x4& hi) {
    lo[0] = __uint_as_float(w.x << 16); lo[1] = __uint_as_float(w.x & 0xffff0000u); lo[2] = __uint_as_float(w.y << 16); lo[3] = __uint_as_float(w.y & 0xffff0000u);
    hi[0] = __uint_as_float(w.z << 16); hi[1] = __uint_as_float(w.z & 0xffff0000u); hi[2] = __uint_as_float(w.w << 16); hi[3] = __uint_as_float(w.w & 0xffff0000u); }
__device__ __forceinline__ void resid_body(const f32x4 (&acc)[2][2][4][2], int row0  , int col0  , int fq,
                                           bf16_t* __restrict__ x, bf16_t* __restrict__ xg, ssq_t* __restrict__ ssq,
                                           PG8_LAS unsigned char* area  , int lcol0  , int wr) {
    u32x4 xw[2][4][2];
#pragma unroll
    for (int ai = 0; ai < 2; ++ai)
#pragma unroll
        for (int m = 0; m < 4; ++m)
#pragma unroll
            for (int bj = 0; bj < 2; ++bj) xw[ai][m][bj] = *(const u32x4*)((const char*)x + ((unsigned)(row0 + ai * HALF + m * 16) * (unsigned)(XPITCH * 2) + (unsigned)((col0 + bj * HALF) * 2)));
    asm volatile("s_waitcnt vmcnt(0)" ::: "memory");
#pragma unroll
    for (int ai = 0; ai < 2; ++ai) {
        f32x4 g[2][2], q[2][2];
#pragma unroll
        for (int bj = 0; bj < 2; ++bj)
#pragma unroll
            for (int n = 0; n < 2; ++n) { g[bj][n] = *(const PG8_LAS f32x4*)(area + (ai * 2 + wr) * 1024 + (lcol0 + bj * HALF + 4 * n) * 4); q[bj][n] = *(const PG8_LAS f32x4*)(area + 4096 + (ai * 2 + wr) * 1024 + (lcol0 + bj * HALF + 4 * n) * 4); }
#pragma unroll
        for (int m = 0; m < 4; ++m) { const int row = row0 + ai * HALF + m * 16; float s = 0.f;
#pragma unroll
            for (int bj = 0; bj < 2; ++bj) { f32x4 o0, o1; unpack8(xw[ai][m][bj], o0, o1); o0 = o0 + g[bj][0] * acc[ai][bj][m][0]; o1 = o1 + g[bj][1] * acc[ai][bj][m][1];
                const u32x4 pw = pack8(o0, o1); *(u32x4*)((char*)x + ((unsigned)row * (unsigned)(XPITCH * 2) + (unsigned)((col0 + bj * HALF) * 2))) = pw;
                unpack8(pw, o0, o1);
                s += sq4(o0) + sq4(o1);
                *(u32x4*)((char*)xg + ((unsigned)row * (unsigned)(D * 2) + (unsigned)((col0 + bj * HALF) * 2))) = pack8(o0 * q[bj][0], o1 * q[bj][1]); }
            s += __int_as_float(__builtin_amdgcn_ds_swizzle(__float_as_int(s), 0x401f));
            { auto r2 = __builtin_amdgcn_permlane32_swap(__float_as_uint(s), __float_as_uint(s), false, false); s = __uint_as_float(r2[0]) + __uint_as_float(r2[1]); }
            if (fq == 0) __hip_atomic_fetch_add((ssq_t*)((char*)ssq + (unsigned)row * 8u), ssq_fix(s), __ATOMIC_RELAXED, __HIP_MEMORY_SCOPE_AGENT); }
    }
}
struct EpiResidP {
    static constexpr bool PERM = true, AFTER_DRAIN = false;
    bf16_t* x; const float* gvec;
    bf16_t* xg; const float* gm;
    ssq_t* ssq;
    __device__ __forceinline__ void prefetch(PG8_LAS unsigned char* area, const Unit& u, int wid, int lane) const {
        const int k = wid & 3, bb = row_bb(u.pm * BM + (k >> 1) * HALF + (k & 1) * 64);
        if (wid < 4) dma1k(gvec + (size_t)bb * MODW + u.pn * BM + 4 * lane, area + k * 1024);
        else dma1k(gm + (size_t)bb * D + u.pn * BM + 4 * lane, area + 4096 + k * 1024);
    }
    __device__ __forceinline__ void operator()(const f32x4 (&acc)[2][2][4][2], const Unit& u, int wr, int wc, int fr, int fq, PG8_LAS unsigned char* area) const {
        resid_body(acc, u.pm * BM + wr * 64 + fr, u.pn * BM + wc * 32 + 8 * fq, fq, x, xg, ssq, area, wc * 32 + 8 * fq, wr);
    }
};
__device__ __forceinline__ void gatein_body(const f32x4 (&acc)[2][2][4][2], int row0, int n0  , bool isx, bf16_t* __restrict__ gate, bf16_t* __restrict__ xb, float* __restrict__ convp, float* __restrict__ convs,
                                            PG8_LAS unsigned char* area, int lrow0  , int lcol0  , int wr) {
    const int col0 = n0 - (isx ? D : 0);
    ssq_t rs[2][4]; f32x4 sh[2][2][2];
#pragma unroll
    for (int ai = 0; ai < 2; ++ai) {
#pragma unroll
        for (int m = 0; m < 4; ++m) rs[ai][m] = lds_ssq(area, lrow0 + ai * HALF + m * 16);
#pragma unroll
        for (int bj = 0; bj < 2; ++bj)
#pragma unroll
            for (int n = 0; n < 2; ++n) sh[ai][bj][n] = lds_shw(area, ai * 2 + wr, lcol0 + bj * HALF + 4 * n); }
#pragma unroll
    for (int ai = 0; ai < 2; ++ai)
#pragma unroll
        for (int m = 0; m < 4; ++m) { const int row = row0 + ai * HALF + m * 16; const float r = rstd_of(rs[ai][m]);
            float* cdst = nullptr;
            if (isx) { if (row < TP) { const int b = row >> 11, t = row & (PS - 1); if (t >= PS - 3) cdst = convp + ((size_t)b * 3 + (t - (PS - 3))) * D; }
                       else { const int mm = row - TP, b = mm >> 6, t = mm & (SS - 1); if (t >= SS - 3) cdst = convs + ((size_t)b * 3 + (t - (SS - 3))) * D; } }
#pragma unroll
            for (int bj = 0; bj < 2; ++bj) { f32x4 v0 = acc[ai][bj][m][0] * r + sh[ai][bj][0], v1 = acc[ai][bj][m][1] * r + sh[ai][bj][1]; const int c = col0 + bj * HALF;
                if (!isx) {
                    v0 = gelu_tanh4(v0); v1 = gelu_tanh4(v1);
                    *(u32x4*)(gate + (size_t)row * D + c) = pack8(v0, v1);
                } else {
                    *(u32x4*)(xb + (size_t)row * D + c) = pack8(v0, v1);
                    if (cdst) { *(f32x4*)(cdst + c) = v0; *(f32x4*)(cdst + c + 4) = v1; }
                } } }
}
struct EpiGateInP {
    static constexpr bool PERM = true, AFTER_DRAIN = false;
    bf16_t* gate; bf16_t* xb; float* convp; float* convs; const ssq_t* ssq; const float* shw;
    __device__ __forceinline__ void prefetch(PG8_LAS unsigned char* area, const Unit& u, int wid, int lane) const { prefetch_norm(area, ssq, shw, 2 * D, u.pm, u.pn, wid, lane); }
    __device__ __forceinline__ void operator()(const f32x4 (&acc)[2][2][4][2], const Unit& u, int wr, int wc, int fr, int fq, PG8_LAS unsigned char* area) const {
        gatein_body(acc, u.pm * BM + wr * 64 + fr, u.pn * BM + wc * 32 + 8 * fq, u.pn >= 8, gate, xb, convp, convs, area, wr * 64 + fr, wc * 32 + 8 * fq, wr);
    }
};
__device__ __forceinline__ void ffn13_body(const f32x4 (&acc)[2][2][4][2], int row0, int hcol0, bf16_t* __restrict__ hid, PG8_LAS unsigned char* area, int lrow0, int lcol0, int wr) {
    ssq_t rs[2][4]; f32x4 sh[2][2][2];
#pragma unroll
    for (int ai = 0; ai < 2; ++ai) {
#pragma unroll
        for (int m = 0; m < 4; ++m) rs[ai][m] = lds_ssq(area, lrow0 + ai * HALF + m * 16);
#pragma unroll
        for (int bj = 0; bj < 2; ++bj)
#pragma unroll
            for (int n = 0; n < 2; ++n) sh[ai][bj][n] = lds_shw(area, ai * 2 + wr, lcol0 + bj * HALF + 4 * n); }
#pragma unroll
    for (int ai = 0; ai < 2; ++ai)
#pragma unroll
        for (int m = 0; m < 4; ++m) { const int row = row0 + ai * HALF + m * 16; const float r = rstd_of(rs[ai][m]);
            const f32x4 a0 = acc[ai][0][m][0] * r + sh[ai][0][0], a1 = acc[ai][0][m][1] * r + sh[ai][0][1], b0 = acc[ai][1][m][0] * r + sh[ai][1][0], b1 = acc[ai][1][m][1] * r + sh[ai][1][1];
            const f32x4 h0 = a0 * sigmoid4(a0) * b0, h1 = a1 * sigmoid4(a1) * b1;
            *(u32x4*)(hid + (size_t)row * DFF + hcol0) = pack8(h0, h1); }
}
struct EpiFfn13P {
    static constexpr bool PERM = true, AFTER_DRAIN = false;
    bf16_t* hid; const ssq_t* ssq; const float* shw;
    __device__ __forceinline__ void prefetch(PG8_LAS unsigned char* area, const Unit& u, int wid, int lane) const { prefetch_norm(area, ssq, shw, 2 * DFF, u.pm, u.pn, wid, lane); }
    __device__ __forceinline__ void operator()(const f32x4 (&acc)[2][2][4][2], const Unit& u, int wr, int wc, int fr, int fq, PG8_LAS unsigned char* area) const {
        ffn13_body(acc, u.pm * BM + wr * 64 + fr, u.pn * HALF + wc * 32 + 8 * fq, hid, area, wr * 64 + fr, wc * 32 + 8 * fq, wr);
    }
};
__device__ __forceinline__ void kv_body(const f32x4 (&acc)[2][2][4][2], int row0, int col0, bool isv, bf16_t* __restrict__ kvp  , bf16_t* __restrict__ kvs  , float* __restrict__ out, PG8_LAS unsigned char* area, int lrow0) {
    ssq_t rs[2][4];
#pragma unroll
    for (int ai = 0; ai < 2; ++ai)
#pragma unroll
        for (int m = 0; m < 4; ++m) rs[ai][m] = lds_ssq(area, lrow0 + ai * HALF + m * 16);
#pragma unroll
    for (int ai = 0; ai < 2; ++ai)
#pragma unroll
        for (int m = 0; m < 4; ++m) { const int row = row0 + ai * HALF + m * 16; const float r = rstd_of(rs[ai][m]);
            float* fdst = nullptr; bf16_t* dst;
            if (row < TP) { const int b = row >> 11, t = row & (PS - 1); dst = kvp + (size_t)row * D; if (t >= PS - LEFT) fdst = out + (isv ? O_VP : O_KP) + ((size_t)b * LEFT + (t - (PS - LEFT))) * D; }
            else { const int mm = row - TP, b = mm >> 6, t = mm & (SS - 1); dst = kvs + ((size_t)b * BAND + LEFT + t) * D; fdst = out + (isv ? O_VS : O_KS) + (size_t)mm * D; }
#pragma unroll
            for (int bj = 0; bj < 2; ++bj) { const f32x4 v0 = acc[ai][bj][m][0] * r, v1 = acc[ai][bj][m][1] * r; const int c = col0 + bj * HALF;
                *(u32x4*)(dst + c) = pack8(v0, v1);
                if (fdst) { *(f32x4*)(fdst + c) = v0; *(f32x4*)(fdst + c + 4) = v1; } } }
}
struct EpiKVP {
    static constexpr bool PERM = true, AFTER_DRAIN = false;
    bf16_t* kb; bf16_t* vb; bf16_t* ks; bf16_t* vs; float* out; const ssq_t* ssq;
    __device__ __forceinline__ void prefetch(PG8_LAS unsigned char* area, const Unit& u, int wid, int lane) const { prefetch_norm(area, ssq, nullptr, 0, u.pm, u.pn, wid, lane); }
    __device__ __forceinline__ void operator()(const f32x4 (&acc)[2][2][4][2], const Unit& u, int wr, int wc, int fr, int fq, PG8_LAS unsigned char* area) const {
        const bool isv = u.pn >= 8;
        kv_body(acc, u.pm * BM + wr * 64 + fr, (isv ? u.pn - 8 : u.pn) * BM + wc * 32 + 8 * fq, isv, isv ? vb : kb, isv ? vs : ks, out, area, wr * 64 + fr);
    }
};
__device__ __forceinline__ void q_body(const f32x4 (&acc)[2][2][4][2], int row0, int col0, bf16_t* __restrict__ q, PG8_LAS unsigned char* area, int lrow0, int lcol0, int wr) {
    ssq_t rs[2][4]; f32x4 sh[2][2][2];
#pragma unroll
    for (int ai = 0; ai < 2; ++ai) {
#pragma unroll
        for (int m = 0; m < 4; ++m) rs[ai][m] = lds_ssq(area, lrow0 + ai * HALF + m * 16);
#pragma unroll
        for (int bj = 0; bj < 2; ++bj)
#pragma unroll
            for (int n = 0; n < 2; ++n) sh[ai][bj][n] = lds_shw(area, ai * 2 + wr, lcol0 + bj * HALF + 4 * n); }
#pragma unroll
    for (int ai = 0; ai < 2; ++ai)
#pragma unroll
        for (int m = 0; m < 4; ++m) { const int row = row0 + ai * HALF + m * 16; const float r = rstd_of(rs[ai][m]);
#pragma unroll
            for (int bj = 0; bj < 2; ++bj) *(u32x4*)(q + (size_t)row * D + col0 + bj * HALF) = pack8(acc[ai][bj][m][0] * r + sh[ai][bj][0], acc[ai][bj][m][1] * r + sh[ai][bj][1]); }
}
struct EpiQP {
    static constexpr bool PERM = true, AFTER_DRAIN = false;
    bf16_t* q; const ssq_t* ssq; const float* shw;
    __device__ __forceinline__ void prefetch(PG8_LAS unsigned char* area, const Unit& u, int wid, int lane) const { prefetch_norm(area, ssq, shw, D, u.pm, u.pn, wid, lane); }
    __device__ __forceinline__ void operator()(const f32x4 (&acc)[2][2][4][2], const Unit& u, int wr, int wc, int fr, int fq, PG8_LAS unsigned char* area) const {
        q_body(acc, u.pm * BM + wr * 64 + fr, u.pn * BM + wc * 32 + 8 * fq, q, area, wr * 64 + fr, wc * 32 + 8 * fq, wr);
    }
};

template <class Epi, class Sched, bool ALIGN_EPI = false, bool SP2 = false, int AUXA = 0, int AUXB = 0  >
__device__ __forceinline__ void gemm_phase(PG8_LAS unsigned char* lds, const Gemm g, const Sched& S, const Epi& E, int tid_in) {
    int tid_ = tid_in; asm volatile("" : "+v"(tid_));
    const int tid = tid_, wid = __builtin_amdgcn_readfirstlane(tid >> 6), lane = tid & 63, wr = wid >> 2, wc = wid & 3, fr = lane & 15, fq = lane >> 4;
    const int K = g.K, nt = K / BK, LDA = g.lda ? g.lda : g.K;
    unsigned voffA[2], voffB[2];
#pragma unroll
    for (int i = 0; i < 2; ++i) { int R, C; stage_rc(tid * 16 + i * 8192, R, C); const int Rb = Epi::PERM ? ((R & ~31) + perm32(R & 31)) : R;
        voffA[i] = (unsigned)(R * LDA + C) * 2u; voffB[i] = (unsigned)(Rb * K + C) * 2u; }
    const size_t kstep = (size_t)(BK * 2);
    const size_t hstepA = (size_t)HALF * LDA * 2, hstepB = (size_t)HALF * K * 2;
    const size_t tstepA = 2 * hstepA, tstepB = 2 * hstepB;
    const unsigned ldsw = (unsigned)wid * 1024u;
    const int aoff = lds_byte(wr * 64 + fr, fq * 8), boff = lds_byte(wc * 32 + fr, fq * 8);
#define PG8_SA(b, h) (((b) * 2 + (h)) * HTB)
#define PG8_SB(b, h) ((4 + (b) * 2 + (h)) * HTB)
    constexpr int AUX_voffA = AUXA, AUX_voffB = AUXB;
#define PG8_STAGE(bufoff, gbase, voff) do { _Pragma("unroll") for (int _i = 0; _i < 2; ++_i) \
        __builtin_amdgcn_global_load_lds((const unsigned*)((const char*)(gbase) + (voff)[_i]), (PG8_LAS unsigned*)(lds + (bufoff) + ldsw + _i * 8192), 16, 0, AUX_##voff); } while (0)
#define PG8_LDA(dst, b, h) do { _Pragma("unroll") for (int m = 0; m < 4; ++m) _Pragma("unroll") for (int k = 0; k < 2; ++k) dst[m][k] = *(const PG8_LAS bf16x8*)(lds + PG8_SA(b, h) + aoff + m * 2048 + k * 1024); } while (0)
#define PG8_LDB(dst, b, h) do { _Pragma("unroll") for (int n = 0; n < 2; ++n) _Pragma("unroll") for (int k = 0; k < 2; ++k) dst[n][k] = *(const PG8_LAS bf16x8*)(lds + PG8_SB(b, h) + boff + n * 2048 + k * 1024); } while (0)
#define PG8_MMA(ai, bj, At, Bt) do { __builtin_amdgcn_s_setprio(1); _Pragma("unroll") for (int m = 0; m < 4; ++m) _Pragma("unroll") for (int n = 0; n < 2; ++n) _Pragma("unroll") for (int k = 0; k < 2; ++k) \
        acc[ai][bj][m][n] = __builtin_amdgcn_mfma_f32_16x16x32_bf16(Bt[n][k], At[m][k], acc[ai][bj][m][n], 0, 0, 0); __builtin_amdgcn_s_setprio(0); } while (0)
#define PG8_WAIT_V(n) asm volatile("s_waitcnt vmcnt(" #n ")" ::: "memory")
#define PG8_WAIT_L(n) asm volatile("s_waitcnt lgkmcnt(" #n ")" ::: "memory")
#define PG8_BAR __builtin_amdgcn_s_barrier()
#define PG8_SCHED __builtin_amdgcn_sched_barrier(0)
    Unit cur, nxt; int ui = 0;
    if (!S.next(0, cur)) return;
    f32x4 acc[2][2][4][2];
#pragma unroll
    for (int a = 0; a < 2; ++a)
#pragma unroll
        for (int b = 0; b < 2; ++b)
#pragma unroll
            for (int m = 0; m < 4; ++m)
#pragma unroll
                for (int n = 0; n < 2; ++n) acc[a][b][m][n] = (f32x4){0.f, 0.f, 0.f, 0.f};
    bf16x8 At[4][2], B0[2][2], B1[2][2];
    const char* cA = (const char*)g.A + (size_t)cur.pm * tstepA; const char* cB = (const char*)g.Bt + (size_t)cur.pn * tstepB;
    S.a_ready(cur);
    if constexpr (SP2) {
        PG8_STAGE(PG8_SB(0, 0), cB, voffB); PG8_STAGE(PG8_SB(0, 1), cB + hstepB, voffB); PG8_STAGE(PG8_SA(0, 0), cA, voffA); PG8_STAGE(PG8_SA(0, 1), cA + hstepA, voffA);
        if (wr == 1) PG8_BAR;
        PG8_WAIT_V(2); PG8_BAR;
        PG8_STAGE(PG8_SB(1, 0), cB + kstep, voffB); PG8_STAGE(PG8_SA(1, 0), cA + kstep, voffA); PG8_STAGE(PG8_SB(1, 1), cB + hstepB + kstep, voffB);
        PG8_WAIT_V(6); PG8_BAR;
    } else {
        PG8_STAGE(PG8_SB(0, 0), cB, voffB); PG8_STAGE(PG8_SA(0, 0), cA, voffA); PG8_STAGE(PG8_SB(0, 1), cB + hstepB, voffB); PG8_STAGE(PG8_SA(0, 1), cA + hstepA, voffA);
        if (wr == 1) PG8_BAR;
        PG8_WAIT_V(4); PG8_BAR;
        PG8_STAGE(PG8_SB(1, 0), cB + kstep, voffB); PG8_STAGE(PG8_SA(1, 0), cA + kstep, voffA); PG8_STAGE(PG8_SB(1, 1), cB + hstepB + kstep, voffB);
        PG8_WAIT_V(6); PG8_BAR;
    }
    for (;;) {
        const bool has_next = S.next(ui + 1, nxt);
        const char* nA = has_next ? (const char*)g.A + (size_t)nxt.pm * tstepA : cA; const char* nB = has_next ? (const char*)g.Bt + (size_t)nxt.pn * tstepB : cB;
        PG8_LAS unsigned char* epi_lds = lds + EPI_LDS_OFF + (ui & 1) * EPI_LDS_HALF;
        E.prefetch(epi_lds, cur, wid, lane);
        for (int t = 0; t < nt; t += 2) {
            const bool last = (t == nt - 2);
            const char* a1 = cA + (size_t)(t + 1) * kstep;
            const char* a2 = last ? nA : cA + (size_t)(t + 2) * kstep; const char* b2 = last ? nB : cB + (size_t)(t + 2) * kstep;
            const char* a3 = a2 + kstep; const char* b3 = b2 + kstep;
            if (last && has_next) S.a_ready(nxt);
            if constexpr (SP2) {
            PG8_LDB(B0, 0, 0); PG8_LDB(B1, 0, 1); PG8_SCHED; PG8_LDA(At, 0, 0); PG8_STAGE(PG8_SA(1, 1), a1 + hstepA, voffA);
            PG8_WAIT_V(8); PG8_WAIT_L(0); PG8_BAR; PG8_MMA(0, 0, At, B0); PG8_MMA(0, 1, At, B1); PG8_BAR; PG8_SCHED;
            PG8_LDA(At, 0, 1); PG8_STAGE(PG8_SB(0, 0), b2, voffB); PG8_STAGE(PG8_SB(0, 1), b2 + hstepB, voffB); PG8_STAGE(PG8_SA(0, 0), a2, voffA);
            PG8_WAIT_V(8); PG8_WAIT_L(0); PG8_BAR; PG8_MMA(1, 0, At, B0); PG8_MMA(1, 1, At, B1); PG8_BAR; PG8_SCHED;
            PG8_LDB(B0, 1, 0); PG8_LDB(B1, 1, 1); PG8_SCHED; PG8_LDA(At, 1, 0); PG8_STAGE(PG8_SA(0, 1), a2 + hstepA, voffA);
            PG8_WAIT_V(8); PG8_WAIT_L(0); PG8_BAR; PG8_MMA(0, 0, At, B0); PG8_MMA(0, 1, At, B1); PG8_BAR; PG8_SCHED;
            PG8_LDA(At, 1, 1); PG8_STAGE(PG8_SB(1, 0), b3, voffB); PG8_STAGE(PG8_SB(1, 1), b3 + hstepB, voffB); PG8_STAGE(PG8_SA(1, 0), a3, voffA);
            PG8_WAIT_V(8); PG8_WAIT_L(0); PG8_BAR; PG8_MMA(1, 0, At, B0); PG8_MMA(1, 1, At, B1); PG8_BAR; PG8_SCHED;
            } else {
            PG8_LDB(B0, 0, 0); PG8_SCHED; PG8_LDA(At, 0, 0); PG8_STAGE(PG8_SA(1, 1), a1 + hstepA, voffA);
            PG8_WAIT_L(8); PG8_BAR; PG8_WAIT_L(0); PG8_MMA(0, 0, At, B0); PG8_BAR; PG8_SCHED;
            PG8_LDB(B1, 0, 1); PG8_STAGE(PG8_SB(0, 0), b2, voffB);
            PG8_BAR; PG8_WAIT_L(0); PG8_MMA(0, 1, At, B1); PG8_BAR;
            PG8_LDA(At, 0, 1); PG8_STAGE(PG8_SA(0, 0), a2, voffA);
            PG8_BAR; PG8_WAIT_L(0); PG8_MMA(1, 0, At, B0); PG8_BAR; PG8_SCHED;
            PG8_STAGE(PG8_SB(0, 1), b2 + hstepB, voffB);
            PG8_WAIT_V(6); PG8_BAR; PG8_MMA(1, 1, At, B1); PG8_BAR;
            PG8_LDB(B0, 1, 0); PG8_SCHED; PG8_LDA(At, 1, 0); PG8_STAGE(PG8_SA(0, 1), a2 + hstepA, voffA);
            PG8_WAIT_L(8); PG8_BAR; PG8_WAIT_L(0); PG8_MMA(0, 0, At, B0); PG8_BAR; PG8_SCHED;
            PG8_LDB(B1, 1, 1); PG8_STAGE(PG8_SB(1, 0), b3, voffB);
            PG8_BAR; PG8_WAIT_L(0); PG8_MMA(0, 1, At, B1); PG8_BAR;
            PG8_LDA(At, 1, 1); PG8_STAGE(PG8_SA(1, 0), a3, voffA);
            PG8_BAR; PG8_WAIT_L(0); PG8_MMA(1, 0, At, B0); PG8_BAR; PG8_SCHED;
            PG8_STAGE(PG8_SB(1, 1), b3 + hstepB, voffB);
            PG8_WAIT_V(6); PG8_BAR; PG8_MMA(1, 1, At, B1); PG8_BAR;
            }
        }
        if constexpr (ALIGN_EPI) { if (wr == 0) PG8_BAR; }
        if constexpr (!Epi::AFTER_DRAIN) { int ln_; asm volatile("v_mbcnt_lo_u32_b32 %0, -1, 0\n\tv_mbcnt_hi_u32_b32 %0, -1, %0" : "=v"(ln_));
            E(acc, cur, wr, wc, ln_ & 15, ln_ >> 4, epi_lds); S.done(cur); }
        if (!has_next) break;
#pragma unroll
        for (int a = 0; a < 2; ++a)
#pragma unroll
            for (int b = 0; b < 2; ++b)
#pragma unroll
                for (int m = 0; m < 4; ++m)
#pragma unroll
                    for (int n = 0; n < 2; ++n) acc[a][b][m][n] = (f32x4){0.f, 0.f, 0.f, 0.f};
        cur = nxt; cA = nA; cB = nB; ++ui;
        if constexpr (ALIGN_EPI) { if (wr == 1) PG8_BAR; }
    }
    PG8_WAIT_V(0);
    if constexpr (!ALIGN_EPI) { if (wr == 0) PG8_BAR; }
    PG8_BAR;
    if constexpr (Epi::AFTER_DRAIN) { E.fused(acc, cur, wr, wc, fr, fq, lds, wid, lane); S.done(cur); }
#undef PG8_SA
#undef PG8_SB
#undef PG8_STAGE
#undef PG8_LDA
#undef PG8_LDB
#undef PG8_MMA
#undef PG8_WAIT_V
#undef PG8_WAIT_L
#undef PG8_BAR
#undef PG8_SCHED
}
}
#undef LAS
#define LAS __attribute__((address_space(3)))
#define XB_TMO      128
#define XB_XCNT(j)  (256  + 64 * (j))
#define XB_XSUB(j)  (1280 + 64 * (j))
#define XB_XGEN(j)  (2304 + 64 * (j))
#define XB_TOP      3328
#define XB_TOPGEN   3392
#define XCD_BAR_WORDS 3456
#define XB_SPIN_CAP (1u << 22)

__device__ __forceinline__ unsigned xb_ld(unsigned* p)              { return __hip_atomic_load(p, __ATOMIC_RELAXED, __HIP_MEMORY_SCOPE_AGENT); }
__device__ __forceinline__ unsigned xb_add(unsigned* p, unsigned v) { return __hip_atomic_fetch_add(p, v, __ATOMIC_RELAXED, __HIP_MEMORY_SCOPE_AGENT); }
__device__ __forceinline__ unsigned xb_xcc_id() { return (unsigned)__builtin_amdgcn_s_getreg((3 << 11) | 20) & 0xFu; }
#define XB_SPIN(cond, bar) do { unsigned _sp = 0; while (cond) { __builtin_amdgcn_s_sleep(1); \
    if ((++_sp & 255u) == 0u) { if (xb_ld(&(bar)[XB_TMO])) break; if (_sp > XB_SPIN_CAP) { atomicAdd(&(bar)[XB_TMO], 1u); break; } } } } while (0)

struct XcdBarrier {
    unsigned* bar; unsigned x;
    volatile LAS unsigned* st;
};

__device__ __forceinline__ XcdBarrier xcd_barrier_post(unsigned* bar, volatile LAS unsigned* st) {
    XcdBarrier b; b.bar = bar; b.x = xb_xcc_id(); b.st = st;
    if (threadIdx.x == 0) (void)xb_add(&bar[XB_XCNT(b.x)], 1u);
    return b;
}
__device__ __forceinline__ void xcd_barrier_complete(unsigned* bar, unsigned x, unsigned& nloc, unsigned& nx) {
    const unsigned G = gridDim.x * gridDim.y * gridDim.z;
    unsigned sum, cnt, mine, sp = 0u;
    for (;;) {
        sum = 0u; cnt = 0u; mine = 0u;
#pragma unroll
        for (unsigned j = 0; j < 16; ++j) { const unsigned c = xb_ld(&bar[XB_XCNT(j)]); sum += c; cnt += (c > 0u) ? 1u : 0u; mine = (j == x) ? c : mine; }
        if (sum == G) break;
        __builtin_amdgcn_s_sleep(1);
        if ((++sp & 255u) == 0u) { if (xb_ld(&bar[XB_TMO])) break; if (sp > XB_SPIN_CAP) { atomicAdd(&bar[XB_TMO], 1u); break; } }
    }
    nloc = mine > 0u ? mine : 1u; nx = cnt > 0u ? cnt : 1u;
}

__device__ __forceinline__ void xcd_barrier(const XcdBarrier& b) {
    asm volatile("s_waitcnt vmcnt(0)" ::: "memory");
    __syncthreads();
    if (threadIdx.x == 0) {
        unsigned* bar = b.bar;
        __builtin_amdgcn_s_waitcnt(0);
        unsigned nloc = b.st[0], nx = b.st[1];
        if (nloc == 0u) { xcd_barrier_complete(bar, b.x, nloc, nx); b.st[0] = nloc; b.st[1] = nx; }
        const unsigned old = xb_add(&bar[XB_XSUB(b.x)], 1u);
        const unsigned gen = old / nloc;
        if (old + 1u == (gen + 1u) * nloc) {
            __builtin_amdgcn_fence(__ATOMIC_RELEASE, "agent");
            asm volatile("s_waitcnt vmcnt(0)" ::: "memory");
            const unsigned og = xb_add(&bar[XB_TOP], 1u);
            const unsigned tg = og / nx;
            if (og + 1u == (tg + 1u) * nx) xb_add(&bar[XB_TOPGEN], 1u);
            else XB_SPIN(xb_ld(&bar[XB_TOPGEN]) == tg, bar);
            __builtin_amdgcn_fence(__ATOMIC_ACQUIRE, "agent");
            xb_add(&bar[XB_XGEN(b.x)], 1u);
            asm volatile("s_waitcnt vmcnt(0)" ::: "memory");
        } else {
            XB_SPIN(xb_ld(&bar[XB_XGEN(b.x)]) == gen, bar);
            __builtin_amdgcn_fence(__ATOMIC_ACQUIRE, "agent");
            asm volatile("s_waitcnt vmcnt(0)" ::: "memory");
        }
    }
    __syncthreads();
}
namespace att {
typedef short s16x4 __attribute__((ext_vector_type(4)));
typedef float f32x16 __attribute__((ext_vector_type(16)));
constexpr int SHM_V = 16384, SHM_K = 16384;
constexpr int OFF_V = 0, OFF_K = 2 * SHM_V, OFF_WS = OFF_K + 2 * SHM_K, OFF_TB = OFF_WS + 8 * 64 * 4;
constexpr float SCALE = 0.088388347648318440f, LOG2E = 1.4426950408889634f, CS = SCALE * LOG2E;
constexpr float THR2 = 8.0f * LOG2E;
#define KSWZ(row, colB) ((row) * 256 + ((colB) ^ (((row) & 7) << 4)))
#define SBAR() __builtin_amdgcn_sched_barrier(0)
__device__ __forceinline__ int crow(int r, int hi) { return (r & 3) + 8 * (r >> 2) + 4 * hi; }
__device__ __forceinline__ unsigned cvtpk(float lo, float hi) { unsigned r; asm volatile("v_cvt_pk_bf16_f32 %0, %1, %2" : "=v"(r) : "v"(lo), "v"(hi)); return r; }
__device__ __forceinline__ void qkt(f32x16& p0, f32x16& p1, const char* Ks, const bf16x8* qr, int r32, int hi) {
  p0 = f32x16{}; p1 = f32x16{};
#pragma unroll
  for (int d0 = 0; d0 < 8; ++d0) { const int cb = (d0 * 16 + hi * 8) * 2;
    const bf16x8 b0 = *reinterpret_cast<const bf16x8*>(Ks + KSWZ(r32, cb));
    const bf16x8 b1 = *reinterpret_cast<const bf16x8*>(Ks + KSWZ(32 + r32, cb));
    p0 = __builtin_amdgcn_mfma_f32_32x32x16_bf16(b0, qr[d0], p0, 0, 0, 0);
    p1 = __builtin_amdgcn_mfma_f32_32x32x16_bf16(b1, qr[d0], p1, 0, 0, 0); }
}
__device__ __forceinline__ int v_st(int k, int c) { const int kk = (k & ~0xC) | ((k & 4) << 1) | ((k & 8) >> 1); return ((kk >> 3) * 4 + (c >> 5)) * 512 + ((kk & 7) * 32 + (c & 31)) * 2; }
__device__ __forceinline__ int v_rd_base(int lane) { return ((lane & 3) << 3) | (((lane >> 2) & 3) << 6) | (((lane >> 4) & 1) << 5) | (((lane >> 5) & 1) << 8); }
constexpr int v_rd_off(int d0, int ks, int half) { return d0 * 512 + ks * 4096 + half * 2048; }
template <int OFF> __device__ __forceinline__ s16x4 tr_read(int vb) { s16x4 r; asm volatile("ds_read_b64_tr_b16 %0, %1 offset:%2" : "=&v"(r) : "v"(vb), "i"(OFF) : "memory"); return r; }
template <int D0> __device__ __forceinline__ void pv_one(f32x16& od, int vb, bf16x8 pa0, bf16x8 pa1, bf16x8 pa2, bf16x8 pa3) {
  const s16x4 l0 = tr_read<v_rd_off(D0, 0, 0)>(vb), h0 = tr_read<v_rd_off(D0, 0, 1)>(vb), l1 = tr_read<v_rd_off(D0, 1, 0)>(vb), h1 = tr_read<v_rd_off(D0, 1, 1)>(vb);
  const s16x4 l2 = tr_read<v_rd_off(D0, 2, 0)>(vb), h2 = tr_read<v_rd_off(D0, 2, 1)>(vb), l3 = tr_read<v_rd_off(D0, 3, 0)>(vb), h3 = tr_read<v_rd_off(D0, 3, 1)>(vb);
  asm volatile("s_waitcnt lgkmcnt(0)" ::: "memory"); SBAR();
#define PK(L, H) (bf16x8){L[0], L[1], L[2], L[3], H[0], H[1], H[2], H[3]}
  od = __builtin_amdgcn_mfma_f32_32x32x16_bf16(pa0, PK(l0, h0), od, 0, 0, 0);
  od = __builtin_amdgcn_mfma_f32_32x32x16_bf16(pa1, PK(l1, h1), od, 0, 0, 0);
  od = __builtin_amdgcn_mfma_f32_32x32x16_bf16(pa2, PK(l2, h2), od, 0, 0, 0);
  od = __builtin_amdgcn_mfma_f32_32x32x16_bf16(pa3, PK(l3, h3), od, 0, 0, 0);
#undef PK
}
__device__ __forceinline__ void band_unit(const bf16_t* __restrict__ Qb, bf16_t* __restrict__ Ob, const bf16_t* __restrict__ Kh, const bf16_t* __restrict__ Vh, const float* __restrict__ relb, int h, int c0, int nw, char* lds, int tid_in) {
  int tid = tid_in; asm volatile("" : "+v"(tid));
  const int wid = __builtin_amdgcn_readfirstlane(tid >> 6), lane = tid & 63, r32 = lane & 31, hi = lane >> 5;
  char* V_lds = lds + OFF_V; char* K_lds = lds + OFF_K;
  float* wsf = (float*)(lds + OFF_WS) + wid * 64; float* li_l = wsf; float* al_l = wsf + 32; float* tb = (float*)(lds + OFF_TB);
  const bool won = wid < nw; const int cw = c0 + (wid >> 1);
  const int t_lo = c0 > 8 ? c0 - 8 : 0, t_hi = c0 + ((nw + 1) >> 1) - 1;
  if (tid < 257) tb[tid] = relb[tid * NH + h] * LOG2E;
  float m_reg = -1e30f, l_reg = 0.f; f32x16 o[4] = {}; bf16x8 qr[8];
  { const bf16_t* Qw = Qb + (size_t)((won ? wid : 0) * 32 + r32) * D + hi * 8;
#pragma unroll
    for (int d0 = 0; d0 < 8; ++d0) qr[d0] = *reinterpret_cast<const bf16x8*>(Qw + d0 * 16); }
  const int sr = tid >> 4, sc = (tid & 15) * 8, vst0 = v_st(sr, sc), vst1 = v_st(32 + sr, sc);
  const int vb0 = (int)(uintptr_t)V_lds + v_rd_base(lane);
  bf16x8 vs0, vs1, ks0, ks1;
#define SLOAD(k0) do { vs0 = *reinterpret_cast<const bf16x8*>(&Vh[(size_t)((k0) + sr) * D + sc]); vs1 = *reinterpret_cast<const bf16x8*>(&Vh[(size_t)((k0) + 32 + sr) * D + sc]); \
    ks0 = *reinterpret_cast<const bf16x8*>(&Kh[(size_t)((k0) + sr) * D + sc]); ks1 = *reinterpret_cast<const bf16x8*>(&Kh[(size_t)((k0) + 32 + sr) * D + sc]); } while (0)
#define SWRITE(b) do { *(bf16x8*)(V_lds + (b) * SHM_V + vst0) = vs0; *(bf16x8*)(V_lds + (b) * SHM_V + vst1) = vs1; const int kc = sc * 2; \
    *(bf16x8*)(K_lds + (b) * SHM_K + KSWZ(sr, kc)) = ks0; *(bf16x8*)(K_lds + (b) * SHM_K + KSWZ(32 + sr, kc)) = ks1; } while (0)
  SLOAD(t_lo * 64); asm volatile("s_waitcnt vmcnt(0)" ::: "memory"); SWRITE(0); __syncthreads();
  for (int t = t_lo; t <= t_hi; ++t) {
    const int buf = (t - t_lo) & 1;
    if (t < t_hi) SLOAD((t + 1) * 64);
    const int dch = cw - t;
    if (won && dch >= 0 && dch <= 8) {
      f32x16 p0, p1;
      qkt(p0, p1, K_lds + buf * SHM_K, qr, r32, hi);
      if (dch >= 3) { const float bc = tb[256];
#pragma unroll
        for (int r = 0; r < 16; ++r) { p0[r] = fmaf(p0[r], CS, bc); p1[r] = fmaf(p1[r], CS, bc); } }
      else { const int base = 64 * dch + 32 * (wid & 1) + r32 - 4 * hi;
#pragma unroll
        for (int r = 0; r < 16; ++r) { const int j0 = (r & 3) + 8 * (r >> 2); int i0 = base - j0, i1 = base - 32 - j0; i0 = (i0 > 128 ? 128 : i0) + 128; i1 = (i1 > 128 ? 128 : i1) + 128;
          p0[r] = fmaf(p0[r], CS, tb[i0]); p1[r] = fmaf(p1[r], CS, tb[i1]); } }
      float pmax = p0[0];
#pragma unroll
      for (int r = 1; r < 16; ++r) pmax = fmaxf(pmax, p0[r]);
#pragma unroll
      for (int r = 0; r < 16; ++r) pmax = fmaxf(pmax, p1[r]);
      { auto rr = __builtin_amdgcn_permlane32_swap(__float_as_uint(pmax), __float_as_uint(pmax), false, false); pmax = fmaxf(__uint_as_float(rr[0]), __uint_as_float(rr[1])); }
      float mn, alpha;
      if (__all(pmax - m_reg <= THR2)) { mn = m_reg; alpha = 1.f; } else { mn = fmaxf(m_reg, pmax); alpha = __builtin_amdgcn_exp2f(m_reg - mn); m_reg = mn; }
      float ps = 0.f;
#pragma unroll
      for (int r = 0; r < 16; ++r) { p0[r] = __builtin_amdgcn_exp2f(p0[r] - mn); p1[r] = __builtin_amdgcn_exp2f(p1[r] - mn); ps += p0[r] + p1[r]; }
      { auto rr = __builtin_amdgcn_permlane32_swap(__float_as_uint(ps), __float_as_uint(ps), false, false); ps = __uint_as_float(rr[0]) + __uint_as_float(rr[1]); }
      l_reg = l_reg * alpha + ps;
      if (__any(alpha < 1.f)) { if (hi == 0) al_l[r32] = alpha; asm volatile("s_waitcnt lgkmcnt(0)" ::: "memory");
#pragma unroll
        for (int d = 0; d < 4; ++d)
#pragma unroll
          for (int r = 0; r < 16; ++r) o[d][r] *= al_l[crow(r, hi)]; }
      bf16x8 pa0, pa1, pa2, pa3;
#define PK4(P, BASE, OUT) do { unsigned a0 = cvtpk(P[BASE + 0], P[BASE + 1]), a1 = cvtpk(P[BASE + 2], P[BASE + 3]); unsigned b0 = cvtpk(P[BASE + 4], P[BASE + 5]), b1 = cvtpk(P[BASE + 6], P[BASE + 7]); \
    auto r0 = __builtin_amdgcn_permlane32_swap(a0, b0, false, false); auto r1 = __builtin_amdgcn_permlane32_swap(a1, b1, false, false); u32x4 w = {r0[0], r1[0], r0[1], r1[1]}; OUT = *reinterpret_cast<bf16x8*>(&w); } while (0)
      PK4(p0, 0, pa0); PK4(p0, 8, pa1); PK4(p1, 0, pa2); PK4(p1, 8, pa3);
#undef PK4
      const int vb = vb0 + buf * SHM_V;
      pv_one<0>(o[0], vb, pa0, pa1, pa2, pa3); pv_one<1>(o[1], vb, pa0, pa1, pa2, pa3); pv_one<2>(o[2], vb, pa0, pa1, pa2, pa3); pv_one<3>(o[3], vb, pa0, pa1, pa2, pa3);
    }
    if (t < t_hi) { asm volatile("s_waitcnt vmcnt(0)" ::: "memory"); SWRITE(buf ^ 1); }
    __syncthreads();
  }
  if (hi == 0) li_l[r32] = l_reg; asm volatile("s_waitcnt lgkmcnt(0)" ::: "memory");
  if (won) {
    char* ost = lds + wid * 8192;
#pragma unroll
    for (int r = 0; r < 16; ++r) { const int orow = crow(r, hi); const float rl = __builtin_amdgcn_rcpf(li_l[orow]);
#pragma unroll
      for (int d0 = 0; d0 < 4; ++d0) *(bf16_t*)(ost + orow * 256 + (d0 * 32 + r32) * 2) = (bf16_t)f2bf(o[d0][r] * rl); }
    asm volatile("s_waitcnt lgkmcnt(0)" ::: "memory");
    bf16_t* Ow = Ob + (size_t)(wid * 32) * D;
#pragma unroll
    for (int k = 0; k < 8; ++k) { const int row = (lane >> 4) + 4 * k, c16 = lane & 15; const u32x4 v = *(const u32x4*)(ost + row * 256 + c16 * 16); *(u32x4*)(Ow + (size_t)row * D + c16 * 8) = v; }
  }
  __syncthreads();
#undef SLOAD
#undef SWRITE
}
#undef KSWZ
#undef SBAR

__device__ __forceinline__ void attn_phase(char* lds, const bf16_t* Q, bf16_t* O, const bf16_t* Kp, const bf16_t* Vp, const bf16_t* Ks, const bf16_t* Vs, const float* relb, int vcu, int G, int tid) {
  for (int bh = vcu; bh < PB * NH; bh += G) { const int b = bh >> 4, h = bh & 15;
    const bf16_t* Kh = Kp + (size_t)b * PS * D + h * HD; const bf16_t* Vh = Vp + (size_t)b * PS * D + h * HD;
    for (int qb = 0; qb < 8; ++qb) band_unit(Q + ((size_t)b * PS + qb * 256) * D + h * HD, O + ((size_t)b * PS + qb * 256) * D + h * HD, Kh, Vh, relb, h, 4 * qb, 8, lds, tid); }
  for (int u = vcu; u < SB * NH; u += G) { const int b = u >> 4, h = u & 15;
    band_unit(Q + ((size_t)TP + (size_t)b * SS) * D + h * HD, O + ((size_t)TP + (size_t)b * SS) * D + h * HD, Ks + (size_t)b * BAND * D + h * HD, Vs + (size_t)b * BAND * D + h * HD, relb, h, 8, 2, lds, tid); }
}
}

namespace rg {
constexpr int XP = 264, GP = 136;
constexpr int OFF_XB = 0, OFF_XC = 35840, OFF_GT = 69632, OFF_CW = 87040;
constexpr float LOG2E = 1.4426950408889634f;
__device__ __forceinline__ float softplus_neg(float l) {
    const float y = __expf(-fabsf(l)); const float lp = y < 0.02f ? y * (1.f - y * (0.5f - y * (0.33333334f - 0.25f * y))) : __logf(1.f + y); return (l > 0.f ? 0.f : -l) + lp; }
__device__ __forceinline__ float neg_expm1(float x) {
    const float s = -x * (1.f + x * (0.5f + x * (0.16666667f + x * (0.041666668f + x * (0.0083333338f + x * 0.0013888889f))))); const float e = 1.f - __expf(x); return x > -0.3f ? s : e; }
__device__ __forceinline__ float neg_expm1_series(float x) { return -x * (1.f + x * (0.5f + x * (0.16666667f + x * (0.041666668f + x * (0.0083333338f + x * 0.0013888889f))))); }
__device__ __forceinline__ float bperm(float v, int addr) { return __int_as_float(__builtin_amdgcn_ds_bpermute(addr, __float_as_int(v))); }
__device__ __forceinline__ bf16x8 cvt8(const float* p) { const f32x4 a = *(const f32x4*)p, b = *(const f32x4*)(p + 4); u32x4 w; w.x = pk2(a[0], a[1]); w.y = pk2(a[2], a[3]); w.z = pk2(b[0], b[1]); w.w = pk2(b[2], b[3]); return *reinterpret_cast<bf16x8*>(&w); }

__device__ __forceinline__ void rg_unit(char* lds, const bf16_t* __restrict__ xb, const bf16_t* __restrict__ gin, bf16_t* __restrict__ hgo, const bf16_t* __restrict__ wai, const float* __restrict__ cw, const float* __restrict__ cb,
                                        const float* __restrict__ b_a, const float* __restrict__ b_i, const float* __restrict__ lam, const float* __restrict__ sconv, const float* __restrict__ h0p, float* __restrict__ rnn_out,
                                        size_t m0, int nchunks, int cbase, int hf, bool pos0, int tid_in) {
    int tid = tid_in; asm volatile("" : "+v"(tid));
    const int wid = __builtin_amdgcn_readfirstlane(tid >> 6), lane = tid & 63, fr = lane & 15, fq = lane >> 4;
    bf16_t* XB = (bf16_t*)(lds + OFF_XB); bf16_t* XC = (bf16_t*)(lds + OFF_XC); bf16_t* GT = (bf16_t*)(lds + OFF_GT); float* CW = (float*)(lds + OFF_CW);
    const int chl = hf * 128 + 16 * wid + fr, ch = cbase + chl, gcol = cbase + hf * 128;
    bf16x8 Bf[2][8];
#pragma unroll
    for (int nt = 0; nt < 2; ++nt)
#pragma unroll
        for (int ks = 0; ks < 8; ++ks) Bf[nt][ks] = *reinterpret_cast<const bf16x8*>(wai + (size_t)(2 * chl + nt) * 256 + 32 * ks + 8 * fq);
    if (tid < 256) {
#pragma unroll
        for (int k = 0; k < 4; ++k) CW[k * 256 + tid] = cw[k * D + cbase + tid];
        CW[4 * 256 + tid] = cb[cbase + tid]; }
    const float ba = b_a[ch], bi = b_i[ch], sp = softplus_neg(lam[ch]), c8l = -8.f * sp * LOG2E, c2 = -16.f * sp;
    float H = h0p ? h0p[ch] : 0.f;
    const bool small_x = __all(c2 > -0.3f);
#pragma unroll
    for (int i = 0; i < 5; ++i) { const int p = tid + 512 * i; if (p < 67 * 32) { const int row = p >> 5, pc = p & 31; bf16x8 v;
        if (row >= 3) v = *reinterpret_cast<const bf16x8*>(xb + (m0 + row - 3) * D + cbase + 8 * pc);
        else if (sconv) v = cvt8(sconv + (size_t)row * D + cbase + 8 * pc); else v = (bf16x8){0, 0, 0, 0, 0, 0, 0, 0};
        *reinterpret_cast<bf16x8*>(XB + row * XP + 8 * pc) = v; } }
#pragma unroll
    for (int i = 0; i < 2; ++i) { const int p = tid + 512 * i, row = p >> 4, pc = p & 15; *reinterpret_cast<bf16x8*>(GT + row * GP + 8 * pc) = *reinterpret_cast<const bf16x8*>(gin + (m0 + row) * D + gcol + 8 * pc); }
    __syncthreads();
    const int a16 = (lane >= 16 ? lane - 16 : lane) << 2, a32 = (lane >= 32 ? lane - 32 : lane) << 2, a48 = (fr + 48) << 2;
    for (int c = 0; c < nchunks; ++c) {
        const size_t mc = m0 + (size_t)c * 64; const bool more = c + 1 < nchunks;
        { const int pc = tid & 31, r4 = (tid >> 5) * 4; f32x2 y[4][4], wk[4][4];
          { const f32x4 b0 = *(const f32x4*)(CW + 4 * 256 + 8 * pc), b1 = *(const f32x4*)(CW + 4 * 256 + 8 * pc + 4);
#pragma unroll
            for (int o = 0; o < 4; ++o) { y[o][0] = (f32x2){b0[0], b0[1]}; y[o][1] = (f32x2){b0[2], b0[3]}; y[o][2] = (f32x2){b1[0], b1[1]}; y[o][3] = (f32x2){b1[2], b1[3]}; } }
#pragma unroll
          for (int k = 0; k < 4; ++k) { const f32x4 w0 = *(const f32x4*)(CW + k * 256 + 8 * pc), w1 = *(const f32x4*)(CW + k * 256 + 8 * pc + 4);
              wk[k][0] = (f32x2){w0[0], w0[1]}; wk[k][1] = (f32x2){w0[2], w0[3]}; wk[k][2] = (f32x2){w1[0], w1[1]}; wk[k][3] = (f32x2){w1[2], w1[3]}; }
#pragma unroll
          for (int j = 0; j < 7; ++j) { const u32x4 xr = *reinterpret_cast<const u32x4*>(XB + (r4 + j) * XP + 8 * pc); f32x2 xv[4];
              xv[0] = (f32x2){__uint_as_float(xr.x << 16), __uint_as_float(xr.x & 0xffff0000u)}; xv[1] = (f32x2){__uint_as_float(xr.y << 16), __uint_as_float(xr.y & 0xffff0000u)};
              xv[2] = (f32x2){__uint_as_float(xr.z << 16), __uint_as_float(xr.z & 0xffff0000u)}; xv[3] = (f32x2){__uint_as_float(xr.w << 16), __uint_as_float(xr.w & 0xffff0000u)};
#pragma unroll
              for (int o = 0; o < 4; ++o) { const int k = j - o; if (k >= 0 && k < 4) {
#pragma unroll
                  for (int p = 0; p < 4; ++p) y[o][p] = wk[k][p] * xv[p] + y[o][p]; } } }
#pragma unroll
          for (int o = 0; o < 4; ++o) { u32x4 w; w.x = pk2(y[o][0][0], y[o][0][1]); w.y = pk2(y[o][1][0], y[o][1][1]); w.z = pk2(y[o][2][0], y[o][2][1]); w.w = pk2(y[o][3][0], y[o][3][1]); *(u32x4*)(XC + (r4 + o) * XP + 8 * pc) = w; } }
        __syncthreads();
        bf16x8 px[5], pg[2]; int t2 = tid; asm volatile("" : "+v"(t2));
        if (more) {
#pragma unroll
            for (int i = 0; i < 5; ++i) { const int p = t2 + 512 * i; if (p < 67 * 32) px[i] = *reinterpret_cast<const bf16x8*>(xb + (mc + 61 + (p >> 5)) * D + cbase + 8 * (p & 31)); }
#pragma unroll
            for (int i = 0; i < 2; ++i) { const int p = t2 + 512 * i; pg[i] = *reinterpret_cast<const bf16x8*>(gin + (mc + 64 + (p >> 4)) * D + gcol + 8 * (p & 15)); } }
        f32x4 acc[4][2];
#pragma unroll
        for (int m = 0; m < 4; ++m) { acc[m][0] = (f32x4){0.f, 0.f, 0.f, 0.f}; acc[m][1] = (f32x4){0.f, 0.f, 0.f, 0.f}; }
#pragma unroll
        for (int ks = 0; ks < 8; ++ks) { bf16x8 af[4];
#pragma unroll
            for (int m = 0; m < 4; ++m) af[m] = *reinterpret_cast<const bf16x8*>(XC + (16 * m + fr) * XP + 32 * ks + 8 * fq);
#pragma unroll
            for (int m = 0; m < 4; ++m) { acc[m][0] = __builtin_amdgcn_mfma_f32_16x16x32_bf16(af[m], Bf[0][ks], acc[m][0], 0, 0, 0); acc[m][1] = __builtin_amdgcn_mfma_f32_16x16x32_bf16(af[m], Bf[1][ks], acc[m][1], 0, 0, 0); } }
#pragma unroll
        for (int m = 0; m < 4; ++m)
#pragma unroll
            for (int rgi = 0; rgi < 4; ++rgi) { const int tok = 16 * m + 4 * fq + rgi;
                const float xcv = bf2f(XC[tok * XP + chl]);
                const float r = __builtin_amdgcn_rcpf(1.f + __expf(-(acc[m][0][rgi] + ba))), ig = __builtin_amdgcn_rcpf(1.f + __expf(-(acc[m][1][rgi] + bi)));
                const float av = __builtin_amdgcn_exp2f(r * c8l); const float x2 = r * c2;
                float mult = __builtin_amdgcn_sqrtf(small_x ? neg_expm1_series(x2) : neg_expm1(x2)); if (pos0 && c == 0 && tok == 0) mult = 1.f;
                acc[m][0][rgi] = av; acc[m][1][rgi] = mult * ig * xcv; }
#pragma unroll
        for (int m = 0; m < 4; ++m) {
            float A = 1.f, B = 0.f;
#pragma unroll
            for (int rgi = 0; rgi < 4; ++rgi) { B = acc[m][0][rgi] * B + acc[m][1][rgi]; A *= acc[m][0][rgi]; }
            { const float Ap = bperm(A, a16), Bp = bperm(B, a16); if (fq >= 1) { B = A * Bp + B; A = A * Ap; } }
            { const float Ap = bperm(A, a32), Bp = bperm(B, a32); if (fq >= 2) { B = A * Bp + B; A = A * Ap; } }
            float Ae = bperm(A, a16), Be = bperm(B, a16); if (fq == 0) { Ae = 1.f; Be = 0.f; }
            const float At = bperm(A, a48), Bt = bperm(B, a48);
            float h = Ae * H + Be; H = At * H + Bt;
#pragma unroll
            for (int rgi = 0; rgi < 4; ++rgi) { h = acc[m][0][rgi] * h + acc[m][1][rgi]; acc[m][1][rgi] = h; } }
#pragma unroll
        for (int m = 0; m < 4; ++m)
#pragma unroll
            for (int rgi = 0; rgi < 4; ++rgi) { bf16_t* gp = GT + (16 * m + 4 * fq + rgi) * GP + 16 * wid + fr; *gp = (bf16_t)f2bf(acc[m][1][rgi] * bf2f(*gp)); }
        if (!more && fq == 0) rnn_out[ch] = H;
        __syncthreads();
#pragma unroll
        for (int i = 0; i < 2; ++i) { const int p = tid + 512 * i, row = p >> 4, pc = p & 15; *(u32x4*)(hgo + (mc + row) * D + gcol + 8 * pc) = *(const u32x4*)(GT + row * GP + 8 * pc); }
        __syncthreads();
        if (more) {
#pragma unroll
            for (int i = 0; i < 5; ++i) { const int p = t2 + 512 * i; if (p < 67 * 32) *reinterpret_cast<bf16x8*>(XB + (p >> 5) * XP + 8 * (p & 31)) = px[i]; }
#pragma unroll
            for (int i = 0; i < 2; ++i) { const int p = t2 + 512 * i; *reinterpret_cast<bf16x8*>(GT + (p >> 4) * GP + 8 * (p & 15)) = pg[i]; }
            __syncthreads(); }
    }
    __syncthreads();
}

__device__ __forceinline__ void rglru_phase(char* lds, const bf16_t* xb, const bf16_t* gin, bf16_t* hgo, const bf16_t* wai, const float* cw, const float* cb, const float* b_a, const float* b_i, const float* lam,
                                            const float* sconv, const float* srnn, float* rnnp, float* rnns, int vcu, int G, int tid) {
    for (int uu = vcu; uu < (PB + SB) * 16; uu += G) { const bool samp = uu >= PB * 16; const int u = samp ? uu - PB * 16 : uu; const int b = u >> 4, n = (u >> 1) & 7, hf = u & 1;
        rg_unit(lds, xb, gin, hgo, wai + (size_t)n * 512 * 256, cw, cb, b_a, b_i, lam, samp ? sconv + (size_t)b * 3 * D : nullptr, samp ? srnn + (size_t)b * D : nullptr, (samp ? rnns : rnnp) + (size_t)b * D,
                samp ? (size_t)TP + (size_t)b * SS : (size_t)b * PS, samp ? 1 : PS / 64, n * 256, hf, !samp, tid); }
}
}

constexpr int NWAVES = 8;
constexpr int RING_BYTES = 139264;
constexpr int MISC_OFF = RING_BYTES + 320;
constexpr int LDS_BYTES = 159744;
static_assert(EPI_LDS_OFF >= MISC_OFF + 256 && EPI_LDS_OFF + 2 * EPI_LDS_HALF <= LDS_BYTES, "epilogue prefetch area inside the LDS allocation");
using pg8::bf16_t;

__device__ __forceinline__ float lane_xor_f(float v, int lane4) { return __int_as_float(__builtin_amdgcn_ds_bpermute(lane4, __float_as_int(v))); }
__device__ __forceinline__ float wave_sum(float v, int lane) {
#pragma unroll
    for (int o = 1; o < 64; o <<= 1) v += lane_xor_f(v, (lane ^ o) << 2);
    return v;
}
__device__ __forceinline__ float wave_max(float v, int lane) {
#pragma unroll
    for (int o = 1; o < 64; o <<= 1) v = fmaxf(v, lane_xor_f(v, (lane ^ o) << 2));
    return v;
}

struct Args { const float* in[32]; float* out; unsigned char* ws; };
typedef const __attribute__((address_space(4))) unsigned char* kaptr_t;
__device__ __forceinline__ kaptr_t ka_fresh() { kaptr_t ka = (kaptr_t)__builtin_amdgcn_kernarg_segment_ptr(); asm volatile("" : "+s"(ka)); return ka; }
__device__ __forceinline__ const float* arg_in(kaptr_t ka, int i) { return *(const float* const __attribute__((address_space(4)))*)(ka + 8 * i); }
__device__ __forceinline__ float* arg_out(kaptr_t ka) { return *(float* const __attribute__((address_space(4)))*)(ka + 8 * 32); }
__device__ __forceinline__ unsigned char* arg_ws(kaptr_t ka) { return *(unsigned char* const __attribute__((address_space(4)))*)(ka + 8 * 33); }
#define GAS __attribute__((address_space(1)))
struct TItem { const GAS float* W; GAS bf16_t* WT; const GAS float* kscale  ; int K, N, mode, off, item; };
__device__ __forceinline__ void t_load(const TItem& t, float (&v)[32], int lane) {
    const int nblk = t.N / 32, kb = t.item / nblk, nb = t.item % nblk; const GAS float* p = t.W + (size_t)(64 * kb + (lane >> 5)) * t.N + 32 * nb + (lane & 31);
#pragma unroll
    for (int i = 0; i < 32; ++i) v[i] = p[(size_t)(2 * i) * t.N];
    if (t.kscale) { const GAS float* ks = t.kscale + 64 * kb + (lane >> 5);
#pragma unroll
        for (int i = 0; i < 32; ++i) v[i] *= ks[2 * i]; }
}
__device__ __forceinline__ void t_finish(const TItem& t, const float (&v)[32], LAS float* scr, int lane) {
    const int nblk = t.N / 32, kb = t.item / nblk, nb = t.item % nblk, k0 = 64 * kb, n0 = 32 * nb;
#pragma unroll
    for (int i = 0; i < 32; ++i) scr[(2 * i + (lane >> 5)) * 33 + (lane & 31)] = v[i];
    LDS_WAIT(); asm volatile("" ::: "memory");
    const int c = lane & 7;
#pragma unroll
    for (int j = 0; j < 4; ++j) { const int n = (lane >> 3) + 8 * j; const LAS float* s = scr + (8 * c) * 33 + n;
        u32x4 o; o.x = pk2(s[0 * 33], s[1 * 33]); o.y = pk2(s[2 * 33], s[3 * 33]); o.z = pk2(s[4 * 33], s[5 * 33]); o.w = pk2(s[6 * 33], s[7 * 33]);
        const int nc = n0 + n; const int drow = t.mode == 0 ? t.off + nc : (t.mode == 1 ? ((nc >> 7) * 256 + (nc & 127) + t.off) : (2 * nc + t.off));
        *(GAS u32x4*)(t.WT + (size_t)drow * t.K + k0 + 8 * c) = o; }
}
constexpr int T_IB = 2048;
constexpr int T_I13 = 32 * (DFF / 32);
constexpr int T_I2 = (DFF / 64) * 64;
constexpr int T_S0 = 6 * T_IB, T_S1 = T_S0 + 4 * T_IB, T_S2 = T_S1 + 2 * T_IB, T_S3 = T_S2 + 32 * 32, T_S4 = T_S3 + 8 * T_I13, T_S5 = T_S4 + 4 * T_I2;
__device__ __forceinline__ TItem t_decode(kaptr_t ka, int it) {
    unsigned char* ws = arg_ws(ka); TItem t; t.kscale = nullptr;
    if (it < T_S0) { const int mi = it / T_IB, l = mi / 3, ty = mi % 3;
        t.W = (const GAS float*)((ty == 0 ? arg_in(ka, 13) : (ty == 1 ? arg_in(ka, 12) : arg_in(ka, 21))) + (size_t)l * D * D); t.WT = (GAS bf16_t*)(ty == 2 ? (bf16_t*)(ws + WS_WRGO) + (size_t)l * D * D : (bf16_t*)(ws + WS_WGI) + (size_t)l * 2 * D * D);
        t.K = D; t.N = D; t.mode = 0; t.off = ty == 1 ? D : 0; t.item = it % T_IB; }
    else if (it < T_S1) { const int q = it - T_S0, mi = q / T_IB, l = mi >> 1, ty = mi & 1;
        t.W = (const GAS float*)((ty == 0 ? arg_in(ka, 25) : arg_in(ka, 26)) + (size_t)l * D * D); t.WT = (GAS bf16_t*)((bf16_t*)(ws + (ty == 0 ? WS_WQ : WS_WO)) + (size_t)l * D * D); t.K = D; t.N = D; t.mode = 0; t.off = 0; t.item = q % T_IB; }
    else if (it < T_S2) { const int q = it - T_S1, ty = q / T_IB;
        t.W = (const GAS float*)(ty == 0 ? arg_in(ka, 23) : arg_in(ka, 24)); t.WT = (GAS bf16_t*)((bf16_t*)(ws + WS_WKV)); t.kscale = (const GAS float*)arg_in(ka, 22);     t.K = D; t.N = D; t.mode = 0; t.off = ty == 0 ? 0 : D; t.item = q % T_IB; }
    else if (it < T_S3) { const int q = it - T_S2, mi = q / 32, ln = mi >> 1, ty = mi & 1;
        t.W = (const GAS float*)((ty == 0 ? arg_in(ka, 16) : arg_in(ka, 18)) + (size_t)ln * 256 * 256); t.WT = (GAS bf16_t*)((bf16_t*)(ws + WS_WAI) + (size_t)ln * 512 * 256); t.K = 256; t.N = 256; t.mode = 2; t.off = ty; t.item = q % 32; }
    else if (it < T_S4) { const int q = it - T_S3, mi = q / T_I13, l = mi >> 1, ty = mi & 1;
        t.W = (const GAS float*)((ty == 0 ? arg_in(ka, 28) : arg_in(ka, 29)) + (size_t)l * D * DFF); t.WT = (GAS bf16_t*)((bf16_t*)(ws + WS_W13) + (size_t)l * 2 * DFF * D); t.K = D; t.N = DFF; t.mode = 1; t.off = ty * 128; t.item = q % T_I13; }
    else { const int q = it - T_S4, l = q / T_I2;
        t.W = (const GAS float*)(arg_in(ka, 30) + (size_t)l * DFF * D); t.WT = (GAS bf16_t*)((bf16_t*)(ws + WS_W2) + (size_t)l * D * DFF); t.K = DFF; t.N = D; t.mode = 0; t.off = 0; t.item = q % T_I2; }
    return t;
}
__device__ __forceinline__ void p0_weights(kaptr_t ka, LAS unsigned char* lds, int gw, int NGW, int wave, int lane) {
    LAS float* scr0 = (LAS float*)(lds + wave * 16896); LAS float* scr1 = scr0 + 64 * 33;
    for (int it = 2 * gw; it < T_S5; it += 2 * NGW) {
        const TItem t0 = t_decode(ka, it), t1 = t_decode(ka, it + 1);
        float v0[32], v1[32];
        t_load(t0, v0, lane); t_load(t1, v1, lane);
        t_finish(t0, v0, scr0, lane); t_finish(t1, v1, scr1, lane);
        LDS_WAIT(); asm volatile("" ::: "memory");
    }
}

__device__ __forceinline__ void p0_cache(const float* __restrict__ ck, const float* __restrict__ cv, bf16_t* __restrict__ KS, bf16_t* __restrict__ VS, int gw, int NGW, int lane) {
    constexpr int STEPS = SB * LEFT * D / 512;
    for (int it0 = 4 * gw; it0 < 2 * STEPS; it0 += 4 * NGW) {
        f32x4 x0[4], x1[4];
#pragma unroll
        for (int u = 0; u < 4; ++u) { const int it = it0 + u; const bool isv = it >= STEPS; const size_t e = (size_t)(isv ? it - STEPS : it) * 512 + lane * 8; const float* src = (isv ? cv : ck) + e; x0[u] = *(const f32x4*)src; x1[u] = *(const f32x4*)(src + 4); }
#pragma unroll
        for (int u = 0; u < 4; ++u) { const int it = it0 + u; const bool isv = it >= STEPS; const size_t e = (size_t)(isv ? it - STEPS : it) * 512 + lane * 8;
            const size_t bj = e >> 11, col = e & (D - 1), b = bj >> 9, j = bj & (LEFT - 1);
            u32x4 w; w.x = pk2(x0[u][0], x0[u][1]); w.y = pk2(x0[u][2], x0[u][3]); w.z = pk2(x1[u][0], x1[u][1]); w.w = pk2(x1[u][2], x1[u][3]);
            *(u32x4*)((isv ? VS : KS) + (b * BAND + j) * D + col) = w; }
    }
}

#define WG_BAR() do { asm volatile("s_waitcnt lgkmcnt(0)" ::: "memory"); __builtin_amdgcn_s_barrier(); asm volatile("" ::: "memory"); } while (0)
__device__ __forceinline__ void p0_mod(const float* __restrict__ c_p, const float* __restrict__ c_s, const float* __restrict__ ada_w, const float* __restrict__ ada_b, float* __restrict__ mod, LAS unsigned char* lds, int vcu, int G, int tid) {
    constexpr int AP = 264;
    LAS unsigned short* Ahi = (LAS unsigned short*)lds; LAS unsigned short* Alo = Ahi + 64 * AP;
    LAS float* red = (LAS float*)lds;
    const int lane = tid & 63, wv = tid >> 6, n32 = lane & 31, kg = lane >> 5, sb = tid >> 5, sk = (tid & 31) * 8;
    for (int item = vcu; item < 4 * 192; item += G) {
        const int l = item / 192, j0 = (item % 192) * 64;
        att::f32x16 acc[2][2];
#pragma unroll
        for (int nb = 0; nb < 2; ++nb)
#pragma unroll
            for (int mb = 0; mb < 2; ++mb) acc[nb][mb] = att::f32x16{};
        const float* wbase = ada_w + ((size_t)l * D + 32 * wv + 8 * kg) * MODW + j0 + n32;
        const float* cb0 = c_p + sb * D + sk; const float* cb1 = c_s + sb * D + sk; const float* cb2 = c_s + (16 + sb) * D + sk;
        f32x4 cr[3][2]; float wa[32], wb[32];
#define MOD_LOADC(kc) do { cr[0][0] = *(const f32x4*)(cb0 + (kc) * 256); cr[0][1] = *(const f32x4*)(cb0 + (kc) * 256 + 4); cr[1][0] = *(const f32x4*)(cb1 + (kc) * 256); cr[1][1] = *(const f32x4*)(cb1 + (kc) * 256 + 4); \
                           cr[2][0] = *(const f32x4*)(cb2 + (kc) * 256); cr[2][1] = *(const f32x4*)(cb2 + (kc) * 256 + 4); } while (0)
#define MOD_LOADW(dst, kc) do { _Pragma("unroll") for (int q = 0; q < 4; ++q) { _Pragma("unroll") for (int i = 0; i < 8; ++i) dst[q * 8 + i] = wbase[(size_t)((kc) * 256 + 16 * (q >> 1) + i) * MODW + 32 * (q & 1)]; } } while (0)
#define MOD_STAGE() do { WG_BAR(); \
            _Pragma("unroll") for (int g = 0; g < 3; ++g) { u32x4 h4, l4; \
                _Pragma("unroll") for (int p = 0; p < 4; ++p) { const float x0 = cr[g][p >> 1][2 * (p & 1)], x1 = cr[g][p >> 1][2 * (p & 1) + 1]; \
                    const float s0 = x0 * __builtin_amdgcn_rcpf(1.0f + __expf(-x0)), s1 = x1 * __builtin_amdgcn_rcpf(1.0f + __expf(-x1)); \
                    const unsigned u0 = __float_as_uint(s0) & 0xffff0000u, u1 = __float_as_uint(s1) & 0xffff0000u; \
                    h4[p] = (u0 >> 16) | u1; l4[p] = pk2(s0 - __uint_as_float(u0), s1 - __uint_as_float(u1)); } \
                *(LAS u32x4*)(Ahi + (sb + 16 * g) * AP + sk) = h4; *(LAS u32x4*)(Alo + (sb + 16 * g) * AP + sk) = l4; } \
            *(LAS u32x4*)(Ahi + (sb + 48) * AP + sk) = (u32x4){0u, 0u, 0u, 0u}; *(LAS u32x4*)(Alo + (sb + 48) * AP + sk) = (u32x4){0u, 0u, 0u, 0u}; \
            WG_BAR(); } while (0)
#define MOD_COMPUTE(w) do { _Pragma("unroll") for (int ks2 = 0; ks2 < 2; ++ks2) { bf16x8 ah[2], al[2]; \
                _Pragma("unroll") for (int mb = 0; mb < 2; ++mb) { const int off = (32 * mb + n32) * AP + 32 * wv + 16 * ks2 + 8 * kg; ah[mb] = *(const LAS bf16x8*)(Ahi + off); al[mb] = *(const LAS bf16x8*)(Alo + off); } \
                _Pragma("unroll") for (int nb = 0; nb < 2; ++nb) { u32x4 bh4, bl4; \
                    _Pragma("unroll") for (int p = 0; p < 4; ++p) { const float w0 = w[(ks2 * 2 + nb) * 8 + 2 * p], w1 = w[(ks2 * 2 + nb) * 8 + 2 * p + 1]; \
                        const unsigned u0 = __float_as_uint(w0) & 0xffff0000u, u1 = __float_as_uint(w1) & 0xffff0000u; bh4[p] = (u0 >> 16) | u1; bl4[p] = pk2(w0 - __uint_as_float(u0), w1 - __uint_as_float(u1)); } \
                    const bf16x8 bh = *reinterpret_cast<const bf16x8*>(&bh4), bl = *reinterpret_cast<const bf16x8*>(&bl4); \
                    _Pragma("unroll") for (int mb = 0; mb < 2; ++mb) { acc[nb][mb] = __builtin_amdgcn_mfma_f32_32x32x16_bf16(ah[mb], bh, acc[nb][mb], 0, 0, 0); \
                        acc[nb][mb] = __builtin_amdgcn_mfma_f32_32x32x16_bf16(ah[mb], bl, acc[nb][mb], 0, 0, 0); acc[nb][mb] = __builtin_amdgcn_mfma_f32_32x32x16_bf16(al[mb], bh, acc[nb][mb], 0, 0, 0); } } } } while (0)
        MOD_LOADC(0); MOD_LOADW(wa, 0);
#pragma unroll
        for (int kc2 = 0; kc2 < 4; ++kc2) {
            MOD_STAGE(); MOD_LOADC(2 * kc2 + 1); MOD_LOADW(wb, 2 * kc2 + 1); MOD_COMPUTE(wa);
            MOD_STAGE(); if (kc2 < 3) { MOD_LOADC(2 * kc2 + 2); MOD_LOADW(wa, 2 * kc2 + 2); } MOD_COMPUTE(wb);
        }
#undef MOD_LOADC
#undef MOD_LOADW
#undef MOD_STAGE
#undef MOD_COMPUTE
        WG_BAR();
#pragma unroll
        for (int nb = 0; nb < 2; ++nb)
#pragma unroll
            for (int mb = 0; mb < 2; ++mb)
#pragma unroll
                for (int r = 0; r < (mb ? 8 : 16); ++r) { const int m = 32 * mb + (r & 3) + 8 * (r >> 2) + 4 * kg; red[(wv * NBB + m) * 64 + 32 * nb + n32] = acc[nb][mb][r]; }
        WG_BAR();
#pragma unroll
        for (int i = 0; i < 6; ++i) { const int o = tid + 512 * i, bb = o >> 6, col = o & 63; float s = ada_b[l * MODW + j0 + col];
#pragma unroll
            for (int w = 0; w < 8; ++w) s += red[(w * NBB + bb) * 64 + col];
            mod[((size_t)l * NBB + bb) * MODW + j0 + col] = s; }
    }
    __syncthreads();
}

__device__ __forceinline__ void gm_tables(const float* __restrict__ g_mix, const float* __restrict__ g_ffn, const float* __restrict__ mod, float* __restrict__ gm, int gtid, int nthreads) {
    for (int e = gtid; e < 8 * NBB * (D / 4); e += nthreads) { const int k4 = e % (D / 4), b = (e / (D / 4)) % NBB, i = e / ((D / 4) * NBB), l = i >> 1;
        const f32x4 g = *(const f32x4*)((i & 1 ? g_ffn : g_mix) + (size_t)l * D + 4 * k4), sc = *(const f32x4*)(mod + ((size_t)l * NBB + b) * MODW + (i & 1 ? 4 * D : D) + 4 * k4);
        *(f32x4*)(gm + ((size_t)i * NBB + b) * D + 4 * k4) = g * (sc + 1.0f); }
}
__device__ __forceinline__ void norm0_pass(const float* __restrict__ xp_, const float* __restrict__ xs_, bf16_t* __restrict__ X, bf16_t* __restrict__ xg, const float* __restrict__ g, const float* __restrict__ mod0, pg8::ssq_t* __restrict__ ssq0, int gw, int NGW, int lane) {
    for (int m0 = gw; m0 < T; m0 += 2 * NGW) {
        const int m1 = m0 + NGW; const bool two = m1 < T; const int mb = two ? m1 : m0;
        const f32x4* xr0 = (const f32x4*)(m0 < TP ? xp_ + (size_t)m0 * D : xs_ + (size_t)(m0 - TP) * D) + lane;
        const f32x4* xr1 = (const f32x4*)(mb < TP ? xp_ + (size_t)mb * D : xs_ + (size_t)(mb - TP) * D) + lane;
        f32x4 v0[8], v1[8];
#pragma unroll
        for (int j = 0; j < 8; ++j) { v0[j] = xr0[64 * j]; v1[j] = xr1[64 * j]; }
#pragma unroll
        for (int r = 0; r < 2; ++r) { if (r == 1 && !two) break; const int m = r ? m1 : m0; const f32x4* v = r ? v1 : v0; float ss = 0.f;
#pragma unroll
            for (int j = 0; j < 8; ++j) ss += (v[j][0] * v[j][0] + v[j][1] * v[j][1]) + (v[j][2] * v[j][2] + v[j][3] * v[j][3]);
            ss = wave_sum(ss, lane); if (lane == 0) ssq0[m] = pg8::ssq_fix(ss);
            const int bb = row_bb(m); const f32x4* gp = (const f32x4*)g + lane; const f32x4* sc = (const f32x4*)(mod0 + (size_t)bb * MODW + D) + lane;
            u32x2* xc = (u32x2*)(X + (size_t)m * XPITCH) + lane; u32x2* o = (u32x2*)(xg + (size_t)m * D) + lane;
#pragma unroll
            for (int j = 0; j < 8; ++j) { { u32x2 w; w.x = pk2(v[j][0], v[j][1]); w.y = pk2(v[j][2], v[j][3]); xc[64 * j] = w; } const f32x4 z = v[j] * (gp[64 * j] * (sc[64 * j] + 1.0f)); u32x2 w; w.x = pk2(z[0], z[1]); w.y = pk2(z[2], z[3]); o[64 * j] = w; } }
    }
}
__device__ __forceinline__ void shw_tile(const float* __restrict__ sh, const bf16_t* __restrict__ Wt, float* __restrict__ dst, int N, int n0, int lane) {
    const int fr = lane & 15, fq = lane >> 4;
    f32x4 acc[3][4];
#pragma unroll
    for (int m = 0; m < 3; ++m)
#pragma unroll
        for (int j = 0; j < 4; ++j) acc[m][j] = (f32x4){0.f, 0.f, 0.f, 0.f};
    const float* ap = sh + (size_t)fr * MODW + 8 * fq; const bf16_t* bp = Wt + (size_t)(n0 + fr) * D + 8 * fq;
#pragma unroll 4
    for (int k0 = 0; k0 < D; k0 += 32) { bf16x8 af[3], bfr[4];
#pragma unroll
        for (int m = 0; m < 3; ++m) { const f32x4 x0 = *(const f32x4*)(ap + (size_t)(16 * m) * MODW + k0), x1 = *(const f32x4*)(ap + (size_t)(16 * m) * MODW + k0 + 4); u32x4 w; w.x = pk2(x0[0], x0[1]); w.y = pk2(x0[2], x0[3]); w.z = pk2(x1[0], x1[1]); w.w = pk2(x1[2], x1[3]); af[m] = *reinterpret_cast<bf16x8*>(&w); }
#pragma unroll
        for (int j = 0; j < 4; ++j) bfr[j] = *reinterpret_cast<const bf16x8*>(bp + (size_t)(16 * j) * D + k0);
#pragma unroll
        for (int m = 0; m < 3; ++m)
#pragma unroll
            for (int j = 0; j < 4; ++j) acc[m][j] = __builtin_amdgcn_mfma_f32_16x16x32_bf16(af[m], bfr[j], acc[m][j], 0, 0, 0); }
#pragma unroll
    for (int m = 0; m < 3; ++m)
#pragma unroll
        for (int j = 0; j < 4; ++j)
#pragma unroll
            for (int r = 0; r < 4; ++r) dst[(size_t)(16 * m + 4 * fq + r) * N + n0 + 16 * j + fr] = acc[m][j][r];
}
__device__ __forceinline__ void shw_phase(const float* __restrict__ mod, unsigned char* ws, int vcu, int G, int wave, int lane) {
    float* shw = (float*)(ws + WS_SHW);
    for (int t = vcu + G * wave; t < 896; t += G * NWAVES) {
        if (t < 128) { const int l = t >> 6, n0 = (t & 63) * 64; shw_tile(mod + (size_t)l * NBB * MODW, (const bf16_t*)(ws + WS_WGI) + (size_t)l * 2 * D * D, shw + SHW_GI + (size_t)l * NBB * 2 * D, 2 * D, n0, lane); }
        else if (t < 192) { const int bl = (t - 128) >> 5, n0 = ((t - 128) & 31) * 64; shw_tile(mod + (size_t)(2 + bl) * NBB * MODW, (const bf16_t*)(ws + WS_WQ) + (size_t)bl * D * D, shw + SHW_Q + (size_t)bl * NBB * D, D, n0, lane); }
        else { const int q = t - 192, l = q / 176, n0 = (q % 176) * 64; shw_tile(mod + (size_t)l * NBB * MODW + 3 * D, (const bf16_t*)(ws + WS_W13) + (size_t)l * 2 * DFF * D, shw + SHW_13 + (size_t)l * NBB * 2 * DFF, 2 * DFF, n0, lane); }
    }
}
__device__ __forceinline__ void final_pass(float* Y, const float* __restrict__ g, const pg8::ssq_t* __restrict__ ssq, int gw, int NGW, int lane) {
    for (int m0 = gw; m0 < T; m0 += 2 * NGW) {
        const int m1 = m0 + NGW; const bool two = m1 < T; const int mb = two ? m1 : m0;
        const u32x2* x0 = (const u32x2*)((const bf16_t*)(Y + (size_t)m0 * D) + D) + lane; const u32x2* x1 = (const u32x2*)((const bf16_t*)(Y + (size_t)mb * D) + D) + lane; const f32x4* gp = (const f32x4*)g + lane;
        u32x2 v0[8], v1[8];
#pragma unroll
        for (int j = 0; j < 8; ++j) { v0[j] = x0[64 * j]; v1[j] = x1[64 * j]; }
        const float r0 = pg8::rstd_of(ssq[m0]), r1 = pg8::rstd_of(ssq[mb]);
        asm volatile("s_waitcnt vmcnt(0)" ::: "memory");
        f32x4* y0 = (f32x4*)(Y + (size_t)m0 * D) + lane; f32x4* y1 = (f32x4*)(Y + (size_t)mb * D) + lane;
#pragma unroll
        for (int j = 0; j < 8; ++j) { const f32x4 xv = {__uint_as_float(v0[j].x << 16), __uint_as_float(v0[j].x & 0xffff0000u), __uint_as_float(v0[j].y << 16), __uint_as_float(v0[j].y & 0xffff0000u)}; y0[64 * j] = (xv * r0) * gp[64 * j]; }
        if (two) {
#pragma unroll
            for (int j = 0; j < 8; ++j) { const f32x4 xv = {__uint_as_float(v1[j].x << 16), __uint_as_float(v1[j].x & 0xffff0000u), __uint_as_float(v1[j].y << 16), __uint_as_float(v1[j].y & 0xffff0000u)}; y1[64 * j] = (xv * r1) * gp[64 * j]; } }
    }
}

#define fresh_tid() ({ int l_; asm volatile("v_mbcnt_lo_u32_b32 %0, -1, 0\n\tv_mbcnt_hi_u32_b32 %0, -1, %0" : "=v"(l_)); (wave_s_ << 6) | l_; })
__device__ __forceinline__ int fresh_s(int v) { asm volatile("" : "+s"(v)); return v; }
#define WSP(off) ((bf16_t*)(arg_ws(ka) + (off)))

__global__ void __launch_bounds__(NWAVES * 64, 2) mega_fwd(Args a_unused) {
    extern __shared__ __attribute__((aligned(16))) unsigned char lds_raw[];
    LAS unsigned char* lds = (LAS unsigned char*)lds_raw;
    const int G_ = gridDim.x, bx_ = blockIdx.x; const int wave_s_ = __builtin_amdgcn_readfirstlane((int)threadIdx.x >> 6);
#define G (fresh_s(G_))
#define bx (fresh_s(bx_))
#define TID (fresh_tid())
#define LANE (fresh_tid() & 63)
#define WAVE (__builtin_amdgcn_readfirstlane(fresh_tid() >> 6))
#define VCU ((G % 8 == 0) ? (bx % 8) * (G / 8) + bx / 8 : bx)
#define GW (VCU * NWAVES + WAVE)
#define NGW (G * NWAVES)
    for (int u = TID; u < (LDS_BYTES - RING_BYTES) / 4; u += NWAVES * 64) ((LAS unsigned*)(lds + RING_BYTES))[u] = 0u;
    __syncthreads();
    XcdBarrier bar;
    { kaptr_t ka = ka_fresh(); bar = xcd_barrier_post((unsigned*)(arg_ws(ka) + WS_CTL) + CW_BAR, (volatile LAS unsigned*)(lds + MISC_OFF) + 8); }
#define GRID_BAR() do { XcdBarrier b2_ = bar; __attribute__((address_space(1))) unsigned* gb_ = (__attribute__((address_space(1))) unsigned*)bar.bar; asm volatile("" : "+s"(gb_), "+s"(b2_.x)); b2_.bar = (unsigned*)gb_; xcd_barrier(b2_); } while (0)

    { kaptr_t ka = ka_fresh(); pg8::ssq_t* sq = (pg8::ssq_t*)(arg_ws(ka) + WS_SSQ);
      for (int i = VCU * (NWAVES * 64) + TID; i < 9 * T; i += G * NWAVES * 64) sq[i] = 0ull; }
    { kaptr_t ka = ka_fresh(); p0_weights(ka, lds, GW, NGW, WAVE, LANE); }
    { kaptr_t ka = ka_fresh(); p0_cache(arg_in(ka, 6), arg_in(ka, 7), WSP(WS_KS), WSP(WS_VS), GW, NGW, LANE); }
    __syncthreads();
    { kaptr_t ka = ka_fresh(); p0_mod(arg_in(ka, 2), arg_in(ka, 3), arg_in(ka, 8), arg_in(ka, 9), (float*)(arg_ws(ka) + WS_MOD), lds, VCU, G, TID); }
    GRID_BAR();

    { kaptr_t ka = ka_fresh(); const float* mod = (const float*)(arg_ws(ka) + WS_MOD);
      gm_tables(arg_in(ka, 10), arg_in(ka, 11), mod, (float*)(arg_ws(ka) + WS_GM), VCU * (NWAVES * 64) + TID, G * NWAVES * 64); }
    { kaptr_t ka = ka_fresh(); shw_phase((const float*)(arg_ws(ka) + WS_MOD), arg_ws(ka), VCU, G, WAVE, LANE); }
    { kaptr_t ka = ka_fresh();
      norm0_pass(arg_in(ka, 0), arg_in(ka, 1), (bf16_t*)(arg_out(ka) + O_Y) + D, WSP(WS_HN), arg_in(ka, 10), (const float*)(arg_ws(ka) + WS_MOD), (pg8::ssq_t*)(arg_ws(ka) + WS_SSQ), GW, NGW, LANE); }
    GRID_BAR();

#define SSQP(i) ((pg8::ssq_t*)(arg_ws(ka) + WS_SSQ) + (size_t)(i) * T)
#define GMP(i) ((const float*)(arg_ws(ka) + WS_GM) + (size_t)(i) * NBB * D)
#define MODL(l) ((const float*)(arg_ws(ka) + WS_MOD) + (size_t)(l) * NBB * MODW)
#define SHWP(off) ((const float*)(arg_ws(ka) + WS_SHW) + (off))
#pragma unroll 1
    for (int l = 0; l < 4; ++l) {
        if (l < 2) {
            { kaptr_t ka = ka_fresh(); float* out = arg_out(ka);
              pg8::Gemm g{WSP(WS_HN), WSP(WS_WGI) + (size_t)l * 2 * D * D, T, 2 * D, D}; pg8::ORD_GI S; S.init(T, 2 * D, G, bx);
              pg8::EpiGateInP E{WSP(WS_BA), WSP(WS_BB), out + O_CONVP + (size_t)l * PB * 3 * D, out + O_CONVS + (size_t)l * SB * 3 * D, SSQP(2 * l), SHWP(SHW_GI + (size_t)l * NBB * 2 * D)};
              pg8::gemm_phase<pg8::EpiGateInP, pg8::ORD_GI, true, true>(lds, g, S, E, TID); }
            GRID_BAR();
            { kaptr_t ka = ka_fresh(); float* out = arg_out(ka);
              rg::rglru_phase((char*)lds_raw, WSP(WS_BB), WSP(WS_BA), WSP(WS_HN), WSP(WS_WAI) + (size_t)l * 8 * 512 * 256, arg_in(ka, 14) + (size_t)l * 4 * D, arg_in(ka, 15) + (size_t)l * D, arg_in(ka, 17) + (size_t)l * D, arg_in(ka, 19) + (size_t)l * D,
                              arg_in(ka, 20) + (size_t)l * D, arg_in(ka, 4) + (size_t)l * SB * 3 * D, arg_in(ka, 5) + (size_t)l * SB * D, out + O_RNNP + (size_t)l * PB * D, out + O_RNNS + (size_t)l * SB * D, VCU, G, TID); }
            GRID_BAR();
            { kaptr_t ka = ka_fresh();
              pg8::Gemm g{WSP(WS_HN), WSP(WS_WRGO) + (size_t)l * D * D, T, D, D}; pg8::ORD_R S; S.init(T, D, G, bx);
              pg8::EpiResidP E{(bf16_t*)(arg_out(ka) + O_Y) + D, MODL(l) + 2 * D, WSP(WS_BA), GMP(2 * l + 1), SSQP(2 * l + 1)};
              pg8::gemm_phase<pg8::EpiResidP, pg8::ORD_R, true, true>(lds, g, S, E, TID); }
        } else {
            if (l == 2) { kaptr_t ka = ka_fresh();
              pg8::Gemm g{(bf16_t*)(arg_out(ka) + O_Y) + D, WSP(WS_WKV), T, 2 * D, D, XPITCH}; pg8::ORD_KV S; S.init(T, 2 * D, G, bx);
              pg8::EpiKVP E{WSP(WS_BB), WSP(WS_BC), WSP(WS_KS), WSP(WS_VS), arg_out(ka), SSQP(4)};
              pg8::gemm_phase<pg8::EpiKVP, pg8::ORD_KV, true, true>(lds, g, S, E, TID); }
            { kaptr_t ka = ka_fresh();
              pg8::Gemm g{WSP(WS_HN), WSP(WS_WQ) + (size_t)(l - 2) * D * D, T, D, D}; pg8::ORD_Q S; S.init(T, D, G, bx);
              pg8::EpiQP E{WSP(WS_HID), SSQP(2 * l), SHWP(SHW_Q + (size_t)(l - 2) * NBB * D)};
              pg8::gemm_phase<pg8::EpiQP, pg8::ORD_Q, true, true>(lds, g, S, E, TID); }
            GRID_BAR();
            { kaptr_t ka = ka_fresh();
              att::attn_phase((char*)lds_raw, WSP(WS_HID), WSP(WS_HN), WSP(WS_BB), WSP(WS_BC), WSP(WS_KS), WSP(WS_VS), arg_in(ka, 27) + (size_t)(l - 2) * (2 * RELC + 1) * NH, VCU, G, TID); }
            GRID_BAR();
            { kaptr_t ka = ka_fresh();
              pg8::Gemm g{WSP(WS_HN), WSP(WS_WO) + (size_t)(l - 2) * D * D, T, D, D}; pg8::ORD_R S; S.init(T, D, G, bx);
              pg8::EpiResidP E{(bf16_t*)(arg_out(ka) + O_Y) + D, MODL(l) + 2 * D, WSP(WS_BA), GMP(2 * l + 1), SSQP(2 * l + 1)};
              pg8::gemm_phase<pg8::EpiResidP, pg8::ORD_R, true, true>(lds, g, S, E, TID); }
        }
        GRID_BAR();
        { kaptr_t ka = ka_fresh();
          pg8::Gemm g{WSP(WS_BA), WSP(WS_W13) + (size_t)l * 2 * DFF * D, T, 2 * DFF, D}; pg8::ORD_F13 S; S.init(T, 2 * DFF, G, bx);
          pg8::EpiFfn13P E{WSP(WS_HID), SSQP(2 * l + 1), SHWP(SHW_13 + (size_t)l * NBB * 2 * DFF)};
          pg8::gemm_phase<pg8::EpiFfn13P, pg8::ORD_F13, true, true>(lds, g, S, E, TID);
          }
        GRID_BAR();
        { kaptr_t ka = ka_fresh();
          pg8::Gemm g{WSP(WS_HID), WSP(WS_W2) + (size_t)l * D * DFF, T, D, DFF}; pg8::ORD_F2 S; S.init(T, D, G, bx);
          pg8::EpiResidP E{(bf16_t*)(arg_out(ka) + O_Y) + D, MODL(l) + 5 * D, WSP(WS_HN), GMP(l < 3 ? 2 * l + 2 : 0), SSQP(2 * l + 2)};
          pg8::gemm_phase<pg8::EpiResidP, pg8::ORD_F2, true, true>(lds, g, S, E, TID); }
        GRID_BAR();
    }
    { kaptr_t ka = ka_fresh(); final_pass(arg_out(ka) + O_Y, arg_in(ka, 31), SSQP(8), GW, NGW, LANE); }
}

extern "C" void kernel_launch(void* const* d_in, const int* in_sizes, int n_in, void* d_out, int out_size, void* d_ws, size_t ws_size, hipStream_t stream) {
    (void)in_sizes; (void)out_size;
    static int grid = 0;
    if (grid == 0) {
        if (n_in != 32 || ws_size < WS_END) { fprintf(stderr, "kernel_launch: unexpected n_in %d / ws %zu\n", n_in, ws_size); grid = -1; return; }
        int dev = 0, cus = 0, per_cu = 0;
        if (hipGetDevice(&dev) != hipSuccess || hipDeviceGetAttribute(&cus, hipDeviceAttributeMultiprocessorCount, dev) != hipSuccess) { grid = -1; return; }
        if (hipFuncSetAttribute((const void*)mega_fwd, hipFuncAttributeMaxDynamicSharedMemorySize, LDS_BYTES) != hipSuccess) { fprintf(stderr, "kernel_launch: hipFuncSetAttribute failed\n"); grid = -1; return; }
        if (hipOccupancyMaxActiveBlocksPerMultiprocessor(&per_cu, (const void*)mega_fwd, NWAVES * 64, LDS_BYTES) != hipSuccess || per_cu < 1) fprintf(stderr, "kernel_launch: occupancy query says %d\n", per_cu);
        (void)hipGetLastError();
        grid = cus;
    }
    if (grid < 0) return;
    if (hipMemsetAsync((char*)d_ws + WS_CTL, 0, CTL_ZERO_BYTES, stream) != hipSuccess) return;
    Args a{};
    for (int i = 0; i < 32; ++i) a.in[i] = (const float*)d_in[i];
    a.out = (float*)d_out; a.ws = (unsigned char*)d_ws;
    hipLaunchKernelGGL(mega_fwd, dim3(grid), dim3(NWAVES * 64), LDS_BYTES, stream, a);
}
```

```cpp
#include <hip/hip_runtime.h>
#include <cstdio>
#include <cstdint>

typedef unsigned short bf16_t;
typedef short bf16x8 __attribute__((ext_vector_type(8)));
typedef float f32x4 __attribute__((ext_vector_type(4)));
typedef float f32x2 __attribute__((ext_vector_type(2)));
typedef unsigned u32x2 __attribute__((ext_vector_type(2)));
typedef unsigned u32x4 __attribute__((ext_vector_type(4)));
#define LAS __attribute__((address_space(3)))

constexpr int D = 2048, DFF = 5632, NH = 16, HD = 128;
constexpr int PB = 16, PS = 2048, SB = 32, SS = 64;
constexpr int TP = PB * PS;
constexpr int TS = SB * SS;
constexpr int T = TP + TS;
constexpr int NBB = PB + SB;
constexpr int MODW = 6 * D;
constexpr int LEFT = 512, BAND = 576, RELC = 128;
constexpr float EPS = 1e-6f;

constexpr size_t O_Y = 0;
constexpr int XPITCH = 2 * 2048;
constexpr size_t O_CONVP = (size_t)T * D;
constexpr size_t O_RNNP = O_CONVP + 2 * PB * 3 * D;
constexpr size_t O_KP = O_RNNP + 2 * PB * D;
constexpr size_t O_VP = O_KP + (size_t)PB * LEFT * D;
constexpr size_t O_CONVS = O_VP + (size_t)PB * LEFT * D;
constexpr size_t O_RNNS = O_CONVS + 2 * SB * 3 * D;
constexpr size_t O_KS = O_RNNS + 2 * SB * D;
constexpr size_t O_VS = O_KS + (size_t)SB * SS * D;
constexpr size_t O_END = O_VS + (size_t)SB * SS * D;
static_assert(O_END == 114032640, "output size");

constexpr size_t MiB = 1u << 20;
constexpr size_t WS_CTL = 0, CTL_ZERO_BYTES = 1 * MiB;
constexpr size_t WS_MOD = 1 * MiB;
constexpr size_t WS_WGI = 10 * MiB;
constexpr size_t WS_WRGO = 42 * MiB;
constexpr size_t WS_WAI = 58 * MiB;
constexpr size_t WS_WKV = 62 * MiB;
constexpr size_t WS_WQ = 78 * MiB;
constexpr size_t WS_WO = 94 * MiB;
constexpr size_t WS_W13 = 110 * MiB;
constexpr size_t WS_W2 = 286 * MiB;
constexpr size_t WS_HN = 374 * MiB;
constexpr size_t WS_BA = 510 * MiB;
constexpr size_t WS_BB = 646 * MiB;
constexpr size_t WS_BC = 782 * MiB;
constexpr size_t WS_HID = 918 * MiB;
constexpr size_t WS_KS = 1292 * MiB;
constexpr size_t WS_VS = 1364 * MiB;
constexpr size_t WS_SSQ = 1454 * MiB;
constexpr size_t SSQ_BYTES = 9 * (size_t)34816 * 8;
constexpr size_t WS_GM = 1438 * MiB;
constexpr size_t WS_SHW = 1442 * MiB;
constexpr size_t SHW_GI = 0, SHW_Q = 2 * 48 * 4096, SHW_13 = SHW_Q + 2 * 48 * 2048;
constexpr size_t WS_END = 1458 * MiB;
constexpr int EPI_LDS_OFF = 139264 + 2048, EPI_LDS_HALF = 8192;
constexpr int CW_BAR = 4096;

__device__ __forceinline__ float bf2f(bf16_t b) { return __uint_as_float(((unsigned)b) << 16); }
__device__ __forceinline__ unsigned f2bf(float f) { unsigned u = __float_as_uint(f); return (u + 0x7fffu + ((u >> 16) & 1u)) >> 16; }
__device__ __forceinline__ unsigned pk2(float lo, float hi) { return f2bf(lo) | (f2bf(hi) << 16); }
__device__ __forceinline__ int row_bb(int m) { return m < TP ? (m >> 11) : PB + ((m - TP) >> 6); }
__device__ __forceinline__ float fast_sigmoid(float x) { return __builtin_amdgcn_rcpf(1.0f + __expf(-x)); }
__device__ __forceinline__ f32x4 sigmoid4(const f32x4& x) { const f32x4 t = x * (-1.4426950408889634f); f32x4 e; e[0] = __builtin_amdgcn_exp2f(t[0]); e[1] = __builtin_amdgcn_exp2f(t[1]); e[2] = __builtin_amdgcn_exp2f(t[2]); e[3] = __builtin_amdgcn_exp2f(t[3]);
    const f32x4 d = e + 1.0f; f32x4 s; s[0] = __builtin_amdgcn_rcpf(d[0]); s[1] = __builtin_amdgcn_rcpf(d[1]); s[2] = __builtin_amdgcn_rcpf(d[2]); s[3] = __builtin_amdgcn_rcpf(d[3]); return s; }
__device__ __forceinline__ f32x4 gelu_tanh4(const f32x4& x) { const f32x4 u = (x * x * 0.044715f + 1.0f) * x * 1.5957691216057308f; return x * sigmoid4(u); }
__device__ __forceinline__ float gelu_tanh_fast(float x) { const float u = 1.5957691216057308f * (x + 0.044715f * x * x * x); return x * __builtin_amdgcn_rcpf(1.0f + __expf(-u)); }
#define LDS_WAIT() asm volatile("s_waitcnt lgkmcnt(0)" ::: "memory")
#define VM_WAIT() asm volatile("s_waitcnt vmcnt(0)" ::: "memory")

namespace pg8 {
#define PG8_LAS __attribute__((address_space(3)))
typedef unsigned short bf16_t;
typedef short bf16x8 __attribute__((ext_vector_type(8)));
typedef float f32x4 __attribute__((ext_vector_type(4)));
typedef unsigned u32x4 __attribute__((ext_vector_type(4)));
constexpr int BM = 256, BK = 64, HALF = 128, HTB = HALF * BK * 2  , STAGE_BYTES = 8 * HTB, NXCD = 8, WGM = 8;

__host__ __device__ __forceinline__ int lds_byte(int r, int c) { const int st = (r >> 4) * 2 + (c >> 5), rr = r & 15, cc = c & 31, ob = rr * 64 + cc * 2; return st * 1024 + (ob ^ (((ob >> 9) & 1) << 5)); }
__host__ __device__ __forceinline__ void stage_rc(int b, int& R, int& C) { const int st = b / 1024, sb = b % 1024, swz = sb ^ (((sb >> 9) & 1) << 5); R = (st >> 1) * 16 + swz / 64; C = (st & 1) * 32 + (swz % 64) / 2; }
__host__ __device__ __forceinline__ int perm32(int rho) { const int n = rho >> 4, i = rho & 15; return 8 * (i >> 2) + 4 * n + (i & 3); }

struct Unit { int pm, pn; };
struct Gemm { const bf16_t* A; const bf16_t* Bt; int M, N, K; int lda; };

template <int WG  > struct StaticOrderT {
    int nM, nN, nwg, G, c;
    __host__ __device__ void init(int M, int N, int G_, int c_) { nM = M / BM; nN = N / BM; nwg = nM * nN; G = G_; c = c_; }
    __host__ __device__ bool next(int i, Unit& u) const {
        const long L = (long)i * G + c; if (L >= nwg) return false;
        int wgid = (int)L; { const int q = nwg / NXCD, r = nwg % NXCD, xcd = wgid % NXCD, off = wgid / NXCD; wgid = (xcd < r ? xcd * (q + 1) : r * (q + 1) + (xcd - r) * q) + off; }
        const int nig = WG * nN, gid = wgid / nig, fm = gid * WG, gsz = (nM - fm) < WG ? (nM - fm) : WG;
        u.pm = fm + ((wgid % nig) % gsz); u.pn = (wgid % nig) / gsz; return true;
    }
    __device__ __forceinline__ void a_ready(const Unit&) const {}
    __device__ __forceinline__ void done(const Unit&) const {}
};
typedef StaticOrderT<WGM> StaticOrder;
#ifndef WG_GI
#define WG_GI 4
#endif
#ifndef WG_KV
#define WG_KV 4
#endif
#ifndef WG_Q
#define WG_Q 4
#endif
#ifndef WG_F13
#define WG_F13 4
#endif
#ifndef WG_R
#define WG_R 4
#endif
#ifndef WG_F2
#define WG_F2 4
#endif
typedef StaticOrderT<WG_GI> ORD_GI; typedef StaticOrderT<WG_KV> ORD_KV; typedef StaticOrderT<WG_Q> ORD_Q; typedef StaticOrderT<WG_F13> ORD_F13; typedef StaticOrderT<WG_R> ORD_R; typedef StaticOrderT<WG_F2> ORD_F2;
__device__ __forceinline__ unsigned cvt_pk_bf16(float lo, float hi) { unsigned r; asm volatile("v_cvt_pk_bf16_f32 %0, %1, %2" : "=v"(r) : "v"(lo), "v"(hi)); return r; }
typedef unsigned long long ssq_t;
constexpr float SSQ_SCALE = 65536.0f;
__device__ __forceinline__ ssq_t ssq_fix(float s) { return (ssq_t)(s * SSQ_SCALE + 0.5f); }
__device__ __forceinline__ float rstd_of(ssq_t ssq) { return __builtin_amdgcn_rsqf((float)ssq * (1.0f / (SSQ_SCALE * D)) + EPS); }
__device__ __forceinline__ void dma1k(const void* gsrc_lane, PG8_LAS unsigned char* dst_wave) { __builtin_amdgcn_global_load_lds((const unsigned*)gsrc_lane, (PG8_LAS unsigned*)dst_wave, 16, 0, 0); }
__device__ __forceinline__ void prefetch_norm(PG8_LAS unsigned char* area, const ssq_t* ssq, const float* shw, int shw_pitch, int pm, int pn, int wid, int lane) {
    if (wid < 2) dma1k(ssq + (size_t)pm * BM + wid * 128 + 2 * lane, area + wid * 1024);
    else if (wid < 6 && shw) { const int k = wid - 2, bb = row_bb(pm * BM + (k >> 1) * HALF + (k & 1) * 64); dma1k(shw + (size_t)bb * shw_pitch + pn * BM + 4 * lane, area + 2048 + k * 1024); }
}
__device__ __forceinline__ ssq_t lds_ssq(PG8_LAS unsigned char* area, int lrow) { return *(const PG8_LAS ssq_t*)(area + lrow * 8); }
__device__ __forceinline__ f32x4 lds_shw(PG8_LAS unsigned char* area, int k, int lcol) { return *(const PG8_LAS f32x4*)(area + 2048 + k * 1024 + lcol * 4); }
__device__ __forceinline__ u32x4 pack8(const f32x4& v0, const f32x4& v1) { u32x4 w; w.x = cvt_pk_bf16(v0[0], v0[1]); w.y = cvt_pk_bf16(v0[2], v0[3]); w.z = cvt_pk_bf16(v1[0], v1[1]); w.w = cvt_pk_bf16(v1[2], v1[3]); return w; }
__device__ __forceinline__ float sq4(const f32x4& o) { return (o[0] * o[0] + o[1] * o[1]) + (o[2] * o[2] + o[3] * o[3]); }

__device__ __forceinline__ void unpack8(const u32x4& w, f32x4& lo, f32x4& hi) {
    lo[0] = __uint_as_float(w.x << 16); lo[1] = __uint_as_float(w.x & 0xffff0000u); lo[2] = __uint_as_float(w.y << 16); lo[3] = __uint_as_float(w.y & 0xffff0000u);
    hi[0] = __uint_as_float(w.z << 16); hi[1] = __uint_as_float(w.z & 0xffff0000u); hi[2] = __uint_as_float(w.w << 16); hi[3] = __uint_as_float(w.w & 0xffff0000u); }
__device__ __forceinline__ void resid_body(const f32x4 (&acc)[2][2][4][2], int row0  , int col0  , int fq,
                                           bf16_t* __restrict__ x, bf16_t* __restrict__ xg, ssq_t* __restrict__ ssq,
                                           PG8_LAS unsigned char* area  , int lcol0  , int wr) {
    u32x4 xw[2][4][2];
#pragma unroll
    for (int ai = 0; ai < 2; ++ai)
#pragma unroll
        for (int m = 0; m < 4; ++m)
#pragma unroll
            for (int bj = 0; bj < 2; ++bj) xw[ai][m][bj] = *(const u32x4*)((const char*)x + ((unsigned)(row0 + ai * HALF + m * 16) * (unsigned)(XPITCH * 2) + (unsigned)((col0 + bj * HALF) * 2)));
    asm volatile("s_waitcnt vmcnt(0)" ::: "memory");
#pragma unroll
    for (int ai = 0; ai < 2; ++ai) {
        f32x4 g[2][2], q[2][2];
#pragma unroll
        for (int bj = 0; bj < 2; ++bj)
#pragma unroll
            for (int n = 0; n < 2; ++n) { g[bj][n] = *(const PG8_LAS f32x4*)(area + (ai * 2 + wr) * 1024 + (lcol0 + bj * HALF + 4 * n) * 4); q[bj][n] = *(const PG8_LAS f32x4*)(area + 4096 + (ai * 2 + wr) * 1024 + (lcol0 + bj * HALF + 4 * n) * 4); }
#pragma unroll
        for (int m = 0; m < 4; ++m) { const int row = row0 + ai * HALF + m * 16; float s = 0.f;
#pragma unroll
            for (int bj = 0; bj < 2; ++bj) { f32x4 o0, o1; unpack8(xw[ai][m][bj], o0, o1); o0 = o0 + g[bj][0] * acc[ai][bj][m][0]; o1 = o1 + g[bj][1] * acc[ai][bj][m][1];
                const u32x4 pw = pack8(o0, o1); *(u32x4*)((char*)x + ((unsigned)row * (unsigned)(XPITCH * 2) + (unsigned)((col0 + bj * HALF) * 2))) = pw;
                unpack8(pw, o0, o1);
                s += sq4(o0) + sq4(o1);
                *(u32x4*)((char*)xg + ((unsigned)row * (unsigned)(D * 2) + (unsigned)((col0 + bj * HALF) * 2))) = pack8(o0 * q[bj][0], o1 * q[bj][1]); }
            s += __int_as_float(__builtin_amdgcn_ds_swizzle(__float_as_int(s), 0x401f));
            { auto r2 = __builtin_amdgcn_permlane32_swap(__float_as_uint(s), __float_as_uint(s), false, false); s = __uint_as_float(r2[0]) + __uint_as_float(r2[1]); }
            if (fq == 0) __hip_atomic_fetch_add((ssq_t*)((char*)ssq + (unsigned)row * 8u), ssq_fix(s), __ATOMIC_RELAXED, __HIP_MEMORY_SCOPE_AGENT); }
    }
}
struct EpiResidP {
    static constexpr bool PERM = true, AFTER_DRAIN = false;
    bf16_t* x; const float* gvec;
    bf16_t* xg; const float* gm;
    ssq_t* ssq;
    __device__ __forceinline__ void prefetch(PG8_LAS unsigned char* area, const Unit& u, int wid, int lane) const {
        const int k = wid & 3, bb = row_bb(u.pm * BM + (k >> 1) * HALF + (k & 1) * 64);
        if (wid < 4) dma1k(gvec + (size_t)bb * MODW + u.pn * BM + 4 * lane, area + k * 1024);
        else dma1k(gm + (size_t)bb * D + u.pn * BM + 4 * lane, area + 4096 + k * 1024);
    }
    __device__ __forceinline__ void operator()(const f32x4 (&acc)[2][2][4][2], const Unit& u, int wr, int wc, int fr, int fq, PG8_LAS unsigned char* area) const {
        resid_body(acc, u.pm * BM + wr * 64 + fr, u.pn * BM + wc * 32 + 8 * fq, fq, x, xg, ssq, area, wc * 32 + 8 * fq, wr);
    }
};
__device__ __forceinline__ void gatein_body(const f32x4 (&acc)[2][2][4][2], int row0, int n0  , bool isx, bf16_t* __restrict__ gate, bf16_t* __restrict__ xb, float* __restrict__ convp, float* __restrict__ convs,
                                            PG8_LAS unsigned char* area, int lrow0  , int lcol0  , int wr) {
    const int col0 = n0 - (isx ? D : 0);
    ssq_t rs[2][4]; f32x4 sh[2][2][2];
#pragma unroll
    for (int ai = 0; ai < 2; ++ai) {
#pragma unroll
        for (int m = 0; m < 4; ++m) rs[ai][m] = lds_ssq(area, lrow0 + ai * HALF + m * 16);
#pragma unroll
        for (int bj = 0; bj < 2; ++bj)
#pragma unroll
            for (int n = 0; n < 2; ++n) sh[ai][bj][n] = lds_shw(area, ai * 2 + wr, lcol0 + bj * HALF + 4 * n); }
#pragma unroll
    for (int ai = 0; ai < 2; ++ai)
#pragma unroll
        for (int m = 0; m < 4; ++m) { const int row = row0 + ai * HALF + m * 16; const float r = rstd_of(rs[ai][m]);
            float* cdst = nullptr;
            if (isx) { if (row < TP) { const int b = row >> 11, t = row & (PS - 1); if (t >= PS - 3) cdst = convp + ((size_t)b * 3 + (t - (PS - 3))) * D; }
                       else { const int mm = row - TP, b = mm >> 6, t = mm & (SS - 1); if (t >= SS - 3) cdst = convs + ((size_t)b * 3 + (t - (SS - 3))) * D; } }
#pragma unroll
            for (int bj = 0; bj < 2; ++bj) { f32x4 v0 = acc[ai][bj][m][0] * r + sh[ai][bj][0], v1 = acc[ai][bj][m][1] * r + sh[ai][bj][1]; const int c = col0 + bj * HALF;
                if (!isx) {
                    v0 = gelu_tanh4(v0); v1 = gelu_tanh4(v1);
                    *(u32x4*)(gate + (size_t)row * D + c) = pack8(v0, v1);
                } else {
                    *(u32x4*)(xb + (size_t)row * D + c) = pack8(v0, v1);
                    if (cdst) { *(f32x4*)(cdst + c) = v0; *(f32x4*)(cdst + c + 4) = v1; }
                } } }
}
struct EpiGateInP {
    static constexpr bool PERM = true, AFTER_DRAIN = false;
    bf16_t* gate; bf16_t* xb; float* convp; float* convs; const ssq_t* ssq; const float* shw;
    __device__ __forceinline__ void prefetch(PG8_LAS unsigned char* area, const Unit& u, int wid, int lane) const { prefetch_norm(area, ssq, shw, 2 * D, u.pm, u.pn, wid, lane); }
    __device__ __forceinline__ void operator()(const f32x4 (&acc)[2][2][4][2], const Unit& u, int wr, int wc, int fr, int fq, PG8_LAS unsigned char* area) const {
        gatein_body(acc, u.pm * BM + wr * 64 + fr, u.pn * BM + wc * 32 + 8 * fq, u.pn >= 8, gate, xb, convp, convs, area, wr * 64 + fr, wc * 32 + 8 * fq, wr);
    }
};
__device__ __forceinline__ void ffn13_body(const f32x4 (&acc)[2][2][4][2], int row0, int hcol0, bf16_t* __restrict__ hid, PG8_LAS unsigned char* area, int lrow0, int lcol0, int wr) {
    ssq_t rs[2][4]; f32x4 sh[2][2][2];
#pragma unroll
    for (int ai = 0; ai < 2; ++ai) {
#pragma unroll
        for (int m = 0; m < 4; ++m) rs[ai][m] = lds_ssq(area, lrow0 + ai * HALF + m * 16);
#pragma unroll
        for (int bj = 0; bj < 2; ++bj)
#pragma unroll
            for (int n = 0; n < 2; ++n) sh[ai][bj][n] = lds_shw(area, ai * 2 + wr, lcol0 + bj * HALF + 4 * n); }
#pragma unroll
    for (int ai = 0; ai < 2; ++ai)
#pragma unroll
        for (int m = 0; m < 4; ++m) { const int row = row0 + ai * HALF + m * 16; const float r = rstd_of(rs[ai][m]);
            const f32x4 a0 = acc[ai][0][m][0] * r + sh[ai][0][0], a1 = acc[ai][0][m][1] * r + sh[ai][0][1], b0 = acc[ai][1][m][0] * r + sh[ai][1][0], b1 = acc[ai][1][m][1] * r + sh[ai][1][1];
            const f32x4 h0 = a0 * sigmoid4(a0) * b0, h1 = a1 * sigmoid4(a1) * b1;
            *(u32x4*)(hid + (size_t)row * DFF + hcol0) = pack8(h0, h1); }
}
struct EpiFfn13P {
    static constexpr bool PERM = true, AFTER_DRAIN = false;
    bf16_t* hid; const ssq_t* ssq; const float* shw;
    __device__ __forceinline__ void prefetch(PG8_LAS unsigned char* area, const Unit& u, int wid, int lane) const { prefetch_norm(area, ssq, shw, 2 * DFF, u.pm, u.pn, wid, lane); }
    __device__ __forceinline__ void operator()(const f32x4 (&acc)[2][2][4][2], const Unit& u, int wr, int wc, int fr, int fq, PG8_LAS unsigned char* area) const {
        ffn13_body(acc, u.pm * BM + wr * 64 + fr, u.pn * HALF + wc * 32 + 8 * fq, hid, area, wr * 64 + fr, wc * 32 + 8 * fq, wr);
    }
};
__device__ __forceinline__ void kv_body(const f32x4 (&acc)[2][2][4][2], int row0, int col0, bool isv, bf16_t* __restrict__ kvp  , bf16_t* __restrict__ kvs  , float* __restrict__ out, PG8_LAS unsigned char* area, int lrow0) {
    ssq_t rs[2][4];
#pragma unroll
    for (int ai = 0; ai < 2; ++ai)
#pragma unroll
        for (int m = 0; m < 4; ++m) rs[ai][m] = lds_ssq(area, lrow0 + ai * HALF + m * 16);
#pragma unroll
    for (int ai = 0; ai < 2; ++ai)
#pragma unroll
        for (int m = 0; m < 4; ++m) { const int row = row0 + ai * HALF + m * 16; const float r = rstd_of(rs[ai][m]);
            float* fdst = nullptr; bf16_t* dst;
            if (row < TP) { const int b = row >> 11, t = row & (PS - 1); dst = kvp + (size_t)row * D; if (t >= PS - LEFT) fdst = out + (isv ? O_VP : O_KP) + ((size_t)b * LEFT + (t - (PS - LEFT))) * D; }
            else { const int mm = row - TP, b = mm >> 6, t = mm & (SS - 1); dst = kvs + ((size_t)b * BAND + LEFT + t) * D; fdst = out + (isv ? O_VS : O_KS) + (size_t)mm * D; }
#pragma unroll
            for (int bj = 0; bj < 2; ++bj) { const f32x4 v0 = acc[ai][bj][m][0] * r, v1 = acc[ai][bj][m][1] * r; const int c = col0 + bj * HALF;
                *(u32x4*)(dst + c) = pack8(v0, v1);
                if (fdst) { *(f32x4*)(fdst + c) = v0; *(f32x4*)(fdst + c + 4) = v1; } } }
}
struct EpiKVP {
    static constexpr bool PERM = true, AFTER_DRAIN = false;
    bf16_t* kb; bf16_t* vb; bf16_t* ks; bf16_t* vs; float* out; const ssq_t* ssq;
    __device__ __forceinline__ void prefetch(PG8_LAS unsigned char* area, const Unit& u, int wid, int lane) const { prefetch_norm(area, ssq, nullptr, 0, u.pm, u.pn, wid, lane); }
    __device__ __forceinline__ void operator()(const f32x4 (&acc)[2][2][4][2], const Unit& u, int wr, int wc, int fr, int fq, PG8_LAS unsigned char* area) const {
        const bool isv = u.pn >= 8;
        kv_body(acc, u.pm * BM + wr * 64 + fr, (isv ? u.pn - 8 : u.pn) * BM + wc * 32 + 8 * fq, isv, isv ? vb : kb, isv ? vs : ks, out, area, wr * 64 + fr);
    }
};
__device__ __forceinline__ void q_body(const f32x4 (&acc)[2][2][4][2], int row0, int col0, bf16_t* __restrict__ q, PG8_LAS unsigned char* area, int lrow0, int lcol0, int wr) {
    ssq_t rs[2][4]; f32x4 sh[2][2][2];
#pragma unroll
    for (int ai = 0; ai < 2; ++ai) {
#pragma unroll
        for (int m = 0; m < 4; ++m) rs[ai][m] = lds_ssq(area, lrow0 + ai * HALF + m * 16);
#pragma unroll
        for (int bj = 0; bj < 2; ++bj)
#pragma unroll
            for (int n = 0; n < 2; ++n) sh[ai][bj][n] = lds_shw(area, ai * 2 + wr, lcol0 + bj * HALF + 4 * n); }
#pragma unroll
    for (int ai = 0; ai < 2; ++ai)
#pragma unroll
        for (int m = 0; m < 4; ++m) { const int row = row0 + ai * HALF + m * 16; const float r = rstd_of(rs[ai][m]);
#pragma unroll
            for (int bj = 0; bj < 2; ++bj) *(u32x4*)(q + (size_t)row * D + col0 + bj * HALF) = pack8(acc[ai][bj][m][0] * r + sh[ai][bj][0], acc[ai][bj][m][1] * r + sh[ai][bj][1]); }
}
struct EpiQP {
    static constexpr bool PERM = true, AFTER_DRAIN = false;
    bf16_t* q; const ssq_t* ssq; const float* shw;
    __device__ __forceinline__ void prefetch(PG8_LAS unsigned char* area, const Unit& u, int wid, int lane) const { prefetch_norm(area, ssq, shw, D, u.pm, u.pn, wid, lane); }
    __device__ __forceinline__ void operator()(const f32x4 (&acc)[2][2][4][2], const Unit& u, int wr, int wc, int fr, int fq, PG8_LAS unsigned char* area) const {
        q_body(acc, u.pm * BM + wr * 64 + fr, u.pn * BM + wc * 32 + 8 * fq, q, area, wr * 64 + fr, wc * 32 + 8 * fq, wr);
    }
};

template <class Epi, class Sched, bool ALIGN_EPI = false, bool SP2 = false, int AUXA = 0, int AUXB = 0  >
__device__ __forceinline__ void gemm_phase(PG8_LAS unsigned char* lds, const Gemm g, const Sched& S, const Epi& E, int tid_in) {
    int tid_ = tid_in; asm volatile("" : "+v"(tid_));
    const int tid = tid_, wid = __builtin_amdgcn_readfirstlane(tid >> 6), lane = tid & 63, wr = wid >> 2, wc = wid & 3, fr = lane & 15, fq = lane >> 4;
    const int K = g.K, nt = K / BK, LDA = g.lda ? g.lda : g.K;
    unsigned voffA[2], voffB[2];
#pragma unroll
    for (int i = 0; i < 2; ++i) { int R, C; stage_rc(tid * 16 + i * 8192, R, C); const int Rb = Epi::PERM ? ((R & ~31) + perm32(R & 31)) : R;
        voffA[i] = (unsigned)(R * LDA + C) * 2u; voffB[i] = (unsigned)(Rb * K + C) * 2u; }
    const size_t kstep = (size_t)(BK * 2);
    const size_t hstepA = (size_t)HALF * LDA * 2, hstepB = (size_t)HALF * K * 2;
    const size_t tstepA = 2 * hstepA, tstepB = 2 * hstepB;
    const unsigned ldsw = (unsigned)wid * 1024u;
    const int aoff = lds_byte(wr * 64 + fr, fq * 8), boff = lds_byte(wc * 32 + fr, fq * 8);
#define PG8_SA(b, h) (((b) * 2 + (h)) * HTB)
#define PG8_SB(b, h) ((4 + (b) * 2 + (h)) * HTB)
    constexpr int AUX_voffA = AUXA, AUX_voffB = AUXB;
#define PG8_STAGE(bufoff, gbase, voff) do { _Pragma("unroll") for (int _i = 0; _i < 2; ++_i) \
        __builtin_amdgcn_global_load_lds((const unsigned*)((const char*)(gbase) + (voff)[_i]), (PG8_LAS unsigned*)(lds + (bufoff) + ldsw + _i * 8192), 16, 0, AUX_##voff); } while (0)
#define PG8_LDA(dst, b, h) do { _Pragma("unroll") for (int m = 0; m < 4; ++m) _Pragma("unroll") for (int k = 0; k < 2; ++k) dst[m][k] = *(const PG8_LAS bf16x8*)(lds + PG8_SA(b, h) + aoff + m * 2048 + k * 1024); } while (0)
#define PG8_LDB(dst, b, h) do { _Pragma("unroll") for (int n = 0; n < 2; ++n) _Pragma("unroll") for (int k = 0; k < 2; ++k) dst[n][k] = *(const PG8_LAS bf16x8*)(lds + PG8_SB(b, h) + boff + n * 2048 + k * 1024); } while (0)
#define PG8_MMA(ai, bj, At, Bt) do { __builtin_amdgcn_s_setprio(1); _Pragma("unroll") for (int m = 0; m < 4; ++m) _Pragma("unroll") for (int n = 0; n < 2; ++n) _Pragma("unroll") for (int k = 0; k < 2; ++k) \
        acc[ai][bj][m][n] = __builtin_amdgcn_mfma_f32_16x16x32_bf16(Bt[n][k], At[m][k], acc[ai][bj][m][n], 0, 0, 0); __builtin_amdgcn_s_setprio(0); } while (0)
#define PG8_WAIT_V(n) asm volatile("s_waitcnt vmcnt(" #n ")" ::: "memory")
#define PG8_WAIT_L(n) asm volatile("s_waitcnt lgkmcnt(" #n ")" ::: "memory")
#define PG8_BAR __builtin_amdgcn_s_barrier()
#define PG8_SCHED __builtin_amdgcn_sched_barrier(0)
    Unit cur, nxt; int ui = 0;
    if (!S.next(0, cur)) return;
    f32x4 acc[2][2][4][2];
#pragma unroll
    for (int a = 0; a < 2; ++a)
#pragma unroll
        for (int b = 0; b < 2; ++b)
#pragma unroll
            for (int m = 0; m < 4; ++m)
#pragma unroll
                for (int n = 0; n < 2; ++n) acc[a][b][m][n] = (f32x4){0.f, 0.f, 0.f, 0.f};
    bf16x8 At[4][2], B0[2][2], B1[2][2];
    const char* cA = (const char*)g.A + (size_t)cur.pm * tstepA; const char* cB = (const char*)g.Bt + (size_t)cur.pn * tstepB;
    S.a_ready(cur);
    if constexpr (SP2) {
        PG8_STAGE(PG8_SB(0, 0), cB, voffB); PG8_STAGE(PG8_SB(0, 1), cB + hstepB, voffB); PG8_STAGE(PG8_SA(0, 0), cA, voffA); PG8_STAGE(PG8_SA(0, 1), cA + hstepA, voffA);
        if (wr == 1) PG8_BAR;
        PG8_WAIT_V(2); PG8_BAR;
        PG8_STAGE(PG8_SB(1, 0), cB + kstep, voffB); PG8_STAGE(PG8_SA(1, 0), cA + kstep, voffA); PG8_STAGE(PG8_SB(1, 1), cB + hstepB + kstep, voffB);
        PG8_WAIT_V(6); PG8_BAR;
    } else {
        PG8_STAGE(PG8_SB(0, 0), cB, voffB); PG8_STAGE(PG8_SA(0, 0), cA, voffA); PG8_STAGE(PG8_SB(0, 1), cB + hstepB, voffB); PG8_STAGE(PG8_SA(0, 1), cA + hstepA, voffA);
        if (wr == 1) PG8_BAR;
        PG8_WAIT_V(4); PG8_BAR;
        PG8_STAGE(PG8_SB(1, 0), cB + kstep, voffB); PG8_STAGE(PG8_SA(1, 0), cA + kstep, voffA); PG8_STAGE(PG8_SB(1, 1), cB + hstepB + kstep, voffB);
        PG8_WAIT_V(6); PG8_BAR;
    }
    for (;;) {
        const bool has_next = S.next(ui + 1, nxt);
        const char* nA = has_next ? (const char*)g.A + (size_t)nxt.pm * tstepA : cA; const char* nB = has_next ? (const char*)g.Bt + (size_t)nxt.pn * tstepB : cB;
        PG8_LAS unsigned char* epi_lds = lds + EPI_LDS_OFF + (ui & 1) * EPI_LDS_HALF;
        E.prefetch(epi_lds, cur, wid, lane);
        for (int t = 0; t < nt; t += 2) {
            const bool last = (t == nt - 2);
            const char* a1 = cA + (size_t)(t + 1) * kstep;
            const char* a2 = last ? nA : cA + (size_t)(t + 2) * kstep; const char* b2 = last ? nB : cB + (size_t)(t + 2) * kstep;
            const char* a3 = a2 + kstep; const char* b3 = b2 + kstep;
            if (last && has_next) S.a_ready(nxt);
            if constexpr (SP2) {
            PG8_LDB(B0, 0, 0); PG8_LDB(B1, 0, 1); PG8_SCHED; PG8_LDA(At, 0, 0); PG8_STAGE(PG8_SA(1, 1), a1 + hstepA, voffA);
            PG8_WAIT_V(8); PG8_WAIT_L(0); PG8_BAR; PG8_MMA(0, 0, At, B0); PG8_MMA(0, 1, At, B1); PG8_BAR; PG8_SCHED;
            PG8_LDA(At, 0, 1); PG8_STAGE(PG8_SB(0, 0), b2, voffB); PG8_STAGE(PG8_SB(0, 1), b2 + hstepB, voffB); PG8_STAGE(PG8_SA(0, 0), a2, voffA);
            PG8_WAIT_V(8); PG8_WAIT_L(0); PG8_BAR; PG8_MMA(1, 0, At, B0); PG8_MMA(1, 1, At, B1); PG8_BAR; PG8_SCHED;
            PG8_LDB(B0, 1, 0); PG8_LDB(B1, 1, 1); PG8_SCHED; PG8_LDA(At, 1, 0); PG8_STAGE(PG8_SA(0, 1), a2 + hstepA, voffA);
            PG8_WAIT_V(8); PG8_WAIT_L(0); PG8_BAR; PG8_MMA(0, 0, At, B0); PG8_MMA(0, 1, At, B1); PG8_BAR; PG8_SCHED;
            PG8_LDA(At, 1, 1); PG8_STAGE(PG8_SB(1, 0), b3, voffB); PG8_STAGE(PG8_SB(1, 1), b3 + hstepB, voffB); PG8_STAGE(PG8_SA(1, 0), a3, voffA);
            PG8_WAIT_V(8); PG8_WAIT_L(0); PG8_BAR; PG8_MMA(1, 0, At, B0); PG8_MMA(1, 1, At, B1); PG8_BAR; PG8_SCHED;
            } else {
            PG8_LDB(B0, 0, 0); PG8_SCHED; PG8_LDA(At, 0, 0); PG8_STAGE(PG8_SA(1, 1), a1 + hstepA, voffA);
            PG8_WAIT_L(8); PG8_BAR; PG8_WAIT_L(0); PG8_MMA(0, 0, At, B0); PG8_BAR; PG8_SCHED;
            PG8_LDB(B1, 0, 1); PG8_STAGE(PG8_SB(0, 0), b2, voffB);
            PG8_BAR; PG8_WAIT_L(0); PG8_MMA(0, 1, At, B1); PG8_BAR;
            PG8_LDA(At, 0, 1); PG8_STAGE(PG8_SA(0, 0), a2, voffA);
            PG8_BAR; PG8_WAIT_L(0); PG8_MMA(1, 0, At, B0); PG8_BAR; PG8_SCHED;
            PG8_STAGE(PG8_SB(0, 1), b2 + hstepB, voffB);
            PG8_WAIT_V(6); PG8_BAR; PG8_MMA(1, 1, At, B1); PG8_BAR;
            PG8_LDB(B0, 1, 0); PG8_SCHED; PG8_LDA(At, 1, 0); PG8_STAGE(PG8_SA(0, 1), a2 + hstepA, voffA);
            PG8_WAIT_L(8); PG8_BAR; PG8_WAIT_L(0); PG8_MMA(0, 0, At, B0); PG8_BAR; PG8_SCHED;
            PG8_LDB(B1, 1, 1); PG8_STAGE(PG8_SB(1, 0), b3, voffB);
            PG8_BAR; PG8_WAIT_L(0); PG8_MMA(0, 1, At, B1); PG8_BAR;
            PG8_LDA(At, 1, 1); PG8_STAGE(PG8_SA(1, 0), a3, voffA);
            PG8_BAR; PG8_WAIT_L(0); PG8_MMA(1, 0, At, B0); PG8_BAR; PG8_SCHED;
            PG8_STAGE(PG8_SB(1, 1), b3 + hstepB, voffB);
            PG8_WAIT_V(6); PG8_BAR; PG8_MMA(1, 1, At, B1); PG8_BAR;
            }
        }
        if constexpr (ALIGN_EPI) { if (wr == 0) PG8_BAR; }
        if constexpr (!Epi::AFTER_DRAIN) { int ln_; asm volatile("v_mbcnt_lo_u32_b32 %0, -1, 0\n\tv_mbcnt_hi_u32_b32 %0, -1, %0" : "=v"(ln_));
            E(acc, cur, wr, wc, ln_ & 15, ln_ >> 4, epi_lds); S.done(cur); }
        if (!has_next) break;
#pragma unroll
        for (int a = 0; a < 2; ++a)
#pragma unroll
            for (int b = 0; b < 2; ++b)
#pragma unroll
                for (int m = 0; m < 4; ++m)
#pragma unroll
                    for (int n = 0; n < 2; ++n) acc[a][b][m][n] = (f32x4){0.f, 0.f, 0.f, 0.f};
        cur = nxt; cA = nA; cB = nB; ++ui;
        if constexpr (ALIGN_EPI) { if (wr == 1) PG8_BAR; }
    }
    PG8_WAIT_V(0);
    if constexpr (!ALIGN_EPI) { if (wr == 0) PG8_BAR; }
    PG8_BAR;
    if constexpr (Epi::AFTER_DRAIN) { E.fused(acc, cur, wr, wc, fr, fq, lds, wid, lane); S.done(cur); }
#undef PG8_SA
#undef PG8_SB
#undef PG8_STAGE
#undef PG8_LDA
#undef PG8_LDB
#undef PG8_MMA
#undef PG8_WAIT_V
#undef PG8_WAIT_L
#undef PG8_BAR
#undef PG8_SCHED
}
}
#undef LAS
#define LAS __attribute__((address_space(3)))
#define XB_TMO      128
#define XB_XCNT(j)  (256  + 64 * (j))
#define XB_XSUB(j)  (1280 + 64 * (j))
#define XB_XGEN(j)  (2304 + 64 * (j))
#define XB_TOP      3328
#define XB_TOPGEN   3392
#define XCD_BAR_WORDS 3456
#define XB_SPIN_CAP (1u << 22)

__device__ __forceinline__ unsigned xb_ld(unsigned* p)              { return __hip_atomic_load(p, __ATOMIC_RELAXED, __HIP_MEMORY_SCOPE_AGENT); }
__device__ __forceinline__ unsigned xb_add(unsigned* p, unsigned v) { return __hip_atomic_fetch_add(p, v, __ATOMIC_RELAXED, __HIP_MEMORY_SCOPE_AGENT); }
__device__ __forceinline__ unsigned xb_xcc_id() { return (unsigned)__builtin_amdgcn_s_getreg((3 << 11) | 20) & 0xFu; }
#define XB_SPIN(cond, bar) do { unsigned _sp = 0; while (cond) { __builtin_amdgcn_s_sleep(1); \
    if ((++_sp & 255u) == 0u) { if (xb_ld(&(bar)[XB_TMO])) break; if (_sp > XB_SPIN_CAP) { atomicAdd(&(bar)[XB_TMO], 1u); break; } } } } while (0)

struct XcdBarrier {
    unsigned* bar; unsigned x;
    volatile LAS unsigned* st;
};

__device__ __forceinline__ XcdBarrier xcd_barrier_post(unsigned* bar, volatile LAS unsigned* st) {
    XcdBarrier b; b.bar = bar; b.x = xb_xcc_id(); b.st = st;
    if (threadIdx.x == 0) (void)xb_add(&bar[XB_XCNT(b.x)], 1u);
    return b;
}
__device__ __forceinline__ void xcd_barrier_complete(unsigned* bar, unsigned x, unsigned& nloc, unsigned& nx) {
    const unsigned G = gridDim.x * gridDim.y * gridDim.z;
    unsigned sum, cnt, mine, sp = 0u;
    for (;;) {
        sum = 0u; cnt = 0u; mine = 0u;
#pragma unroll
        for (unsigned j = 0; j < 16; ++j) { const unsigned c = xb_ld(&bar[XB_XCNT(j)]); sum += c; cnt += (c > 0u) ? 1u : 0u; mine = (j == x) ? c : mine; }
        if (sum == G) break;
        __builtin_amdgcn_s_sleep(1);
        if ((++sp & 255u) == 0u) { if (xb_ld(&bar[XB_TMO])) break; if (sp > XB_SPIN_CAP) { atomicAdd(&bar[XB_TMO], 1u); break; } }
    }
    nloc = mine > 0u ? mine : 1u; nx = cnt > 0u ? cnt : 1u;
}

__device__ __forceinline__ void xcd_barrier(const XcdBarrier& b) {
    asm volatile("s_waitcnt vmcnt(0)" ::: "memory");
    __syncthreads();
    if (threadIdx.x == 0) {
        unsigned* bar = b.bar;
        __builtin_amdgcn_s_waitcnt(0);
        unsigned nloc = b.st[0], nx = b.st[1];
        if (nloc == 0u) { xcd_barrier_complete(bar, b.x, nloc, nx); b.st[0] = nloc; b.st[1] = nx; }
        const unsigned old = xb_add(&bar[XB_XSUB(b.x)], 1u);
        const unsigned gen = old / nloc;
        if (old + 1u == (gen + 1u) * nloc) {
            __builtin_amdgcn_fence(__ATOMIC_RELEASE, "agent");
            asm volatile("s_waitcnt vmcnt(0)" ::: "memory");
            const unsigned og = xb_add(&bar[XB_TOP], 1u);
            const unsigned tg = og / nx;
            if (og + 1u == (tg + 1u) * nx) xb_add(&bar[XB_TOPGEN], 1u);
            else XB_SPIN(xb_ld(&bar[XB_TOPGEN]) == tg, bar);
            __builtin_amdgcn_fence(__ATOMIC_ACQUIRE, "agent");
            xb_add(&bar[XB_XGEN(b.x)], 1u);
            asm volatile("s_waitcnt vmcnt(0)" ::: "memory");
        } else {
            XB_SPIN(xb_ld(&bar[XB_XGEN(b.x)]) == gen, bar);
            __builtin_amdgcn_fence(__ATOMIC_ACQUIRE, "agent");
            asm volatile("s_waitcnt vmcnt(0)" ::: "memory");
        }
    }
    __syncthreads();
}
namespace att {
typedef short s16x4 __attribute__((ext_vector_type(4)));
typedef float f32x16 __attribute__((ext_vector_type(16)));
constexpr int SHM_V = 16384, SHM_K = 16384;
constexpr int OFF_V = 0, OFF_K = 2 * SHM_V, OFF_WS = OFF_K + 2 * SHM_K, OFF_TB = OFF_WS + 8 * 64 * 4;
constexpr float SCALE = 0.088388347648318440f, LOG2E = 1.4426950408889634f, CS = SCALE * LOG2E;
constexpr float THR2 = 8.0f * LOG2E;
#define KSWZ(row, colB) ((row) * 256 + ((colB) ^ (((row) & 7) << 4)))
#define SBAR() __builtin_amdgcn_sched_barrier(0)
__device__ __forceinline__ int crow(int r, int hi) { return (r & 3) + 8 * (r >> 2) + 4 * hi; }
__device__ __forceinline__ unsigned cvtpk(float lo, float hi) { unsigned r; asm volatile("v_cvt_pk_bf16_f32 %0, %1, %2" : "=v"(r) : "v"(lo), "v"(hi)); return r; }
__device__ __forceinline__ void qkt(f32x16& p0, f32x16& p1, const char* Ks, const bf16x8* qr, int r32, int hi) {
  p0 = f32x16{}; p1 = f32x16{};
#pragma unroll
  for (int d0 = 0; d0 < 8; ++d0) { const int cb = (d0 * 16 + hi * 8) * 2;
    const bf16x8 b0 = *reinterpret_cast<const bf16x8*>(Ks + KSWZ(r32, cb));
    const bf16x8 b1 = *reinterpret_cast<const bf16x8*>(Ks + KSWZ(32 + r32, cb));
    p0 = __builtin_amdgcn_mfma_f32_32x32x16_bf16(b0, qr[d0], p0, 0, 0, 0);
    p1 = __builtin_amdgcn_mfma_f32_32x32x16_bf16(b1, qr[d0], p1, 0, 0, 0); }
}
__device__ __forceinline__ int v_st(int k, int c) { const int kk = (k & ~0xC) | ((k & 4) << 1) | ((k & 8) >> 1); return ((kk >> 3) * 4 + (c >> 5)) * 512 + ((kk & 7) * 32 + (c & 31)) * 2; }
__device__ __forceinline__ int v_rd_base(int lane) { return ((lane & 3) << 3) | (((lane >> 2) & 3) << 6) | (((lane >> 4) & 1) << 5) | (((lane >> 5) & 1) << 8); }
constexpr int v_rd_off(int d0, int ks, int half) { return d0 * 512 + ks * 4096 + half * 2048; }
template <int OFF> __device__ __forceinline__ s16x4 tr_read(int vb) { s16x4 r; asm volatile("ds_read_b64_tr_b16 %0, %1 offset:%2" : "=&v"(r) : "v"(vb), "i"(OFF) : "memory"); return r; }
template <int D0> __device__ __forceinline__ void pv_one(f32x16& od, int vb, bf16x8 pa0, bf16x8 pa1, bf16x8 pa2, bf16x8 pa3) {
  const s16x4 l0 = tr_read<v_rd_off(D0, 0, 0)>(vb), h0 = tr_read<v_rd_off(D0, 0, 1)>(vb), l1 = tr_read<v_rd_off(D0, 1, 0)>(vb), h1 = tr_read<v_rd_off(D0, 1, 1)>(vb);
  const s16x4 l2 = tr_read<v_rd_off(D0, 2, 0)>(vb), h2 = tr_read<v_rd_off(D0, 2, 1)>(vb), l3 = tr_read<v_rd_off(D0, 3, 0)>(vb), h3 = tr_read<v_rd_off(D0, 3, 1)>(vb);
  asm volatile("s_waitcnt lgkmcnt(0)" ::: "memory"); SBAR();
#define PK(L, H) (bf16x8){L[0], L[1], L[2], L[3], H[0], H[1], H[2], H[3]}
  od = __builtin_amdgcn_mfma_f32_32x32x16_bf16(pa0, PK(l0, h0), od, 0, 0, 0);
  od = __builtin_amdgcn_mfma_f32_32x32x16_bf16(pa1, PK(l1, h1), od, 0, 0, 0);
  od = __builtin_amdgcn_mfma_f32_32x32x16_bf16(pa2, PK(l2, h2), od, 0, 0, 0);
  od = __builtin_amdgcn_mfma_f32_32x32x16_bf16(pa3, PK(l3, h3), od, 0, 0, 0);
#undef PK
}
__device__ __forceinline__ void band_unit(const bf16_t* __restrict__ Qb, bf16_t* __restrict__ Ob, const bf16_t* __restrict__ Kh, const bf16_t* __restrict__ Vh, const float* __restrict__ relb, int h, int c0, int nw, char* lds, int tid_in) {
  int tid = tid_in; asm volatile("" : "+v"(tid));
  const int wid = __builtin_amdgcn_readfirstlane(tid >> 6), lane = tid & 63, r32 = lane & 31, hi = lane >> 5;
  char* V_lds = lds + OFF_V; char* K_lds = lds + OFF_K;
  float* wsf = (float*)(lds + OFF_WS) + wid * 64; float* li_l = wsf; float* al_l = wsf + 32; float* tb = (float*)(lds + OFF_TB);
  const bool won = wid < nw; const int cw = c0 + (wid >> 1);
  const int t_lo = c0 > 8 ? c0 - 8 : 0, t_hi = c0 + ((nw + 1) >> 1) - 1;
  if (tid < 257) tb[tid] = relb[tid * NH + h] * LOG2E;
  float m_reg = -1e30f, l_reg = 0.f; f32x16 o[4] = {}; bf16x8 qr[8];
  { const bf16_t* Qw = Qb + (size_t)((won ? wid : 0) * 32 + r32) * D + hi * 8;
#pragma unroll
    for (int d0 = 0; d0 < 8; ++d0) qr[d0] = *reinterpret_cast<const bf16x8*>(Qw + d0 * 16); }
  const int sr = tid >> 4, sc = (tid & 15) * 8, vst0 = v_st(sr, sc), vst1 = v_st(32 + sr, sc);
  const int vb0 = (int)(uintptr_t)V_lds + v_rd_base(lane);
  bf16x8 vs0, vs1, ks0, ks1;
#define SLOAD(k0) do { vs0 = *reinterpret_cast<const bf16x8*>(&Vh[(size_t)((k0) + sr) * D + sc]); vs1 = *reinterpret_cast<const bf16x8*>(&Vh[(size_t)((k0) + 32 + sr) * D + sc]); \
    ks0 = *reinterpret_cast<const bf16x8*>(&Kh[(size_t)((k0) + sr) * D + sc]); ks1 = *reinterpret_cast<const bf16x8*>(&Kh[(size_t)((k0) + 32 + sr) * D + sc]); } while (0)
#define SWRITE(b) do { *(bf16x8*)(V_lds + (b) * SHM_V + vst0) = vs0; *(bf16x8*)(V_lds + (b) * SHM_V + vst1) = vs1; const int kc = sc * 2; \
    *(bf16x8*)(K_lds + (b) * SHM_K + KSWZ(sr, kc)) = ks0; *(bf16x8*)(K_lds + (b) * SHM_K + KSWZ(32 + sr, kc)) = ks1; } while (0)
  SLOAD(t_lo * 64); asm volatile("s_waitcnt vmcnt(0)" ::: "memory"); SWRITE(0); __syncthreads();
  for (int t = t_lo; t <= t_hi; ++t) {
    const int buf = (t - t_lo) & 1;
    if (t < t_hi) SLOAD((t + 1) * 64);
    const int dch = cw - t;
    if (won && dch >= 0 && dch <= 8) {
      f32x16 p0, p1;
      qkt(p0, p1, K_lds + buf * SHM_K, qr, r32, hi);
      if (dch >= 3) { const float bc = tb[256];
#pragma unroll
        for (int r = 0; r < 16; ++r) { p0[r] = fmaf(p0[r], CS, bc); p1[r] = fmaf(p1[r], CS, bc); } }
      else { const int base = 64 * dch + 32 * (wid & 1) + r32 - 4 * hi;
#pragma unroll
        for (int r = 0; r < 16; ++r) { const int j0 = (r & 3) + 8 * (r >> 2); int i0 = base - j0, i1 = base - 32 - j0; i0 = (i0 > 128 ? 128 : i0) + 128; i1 = (i1 > 128 ? 128 : i1) + 128;
          p0[r] = fmaf(p0[r], CS, tb[i0]); p1[r] = fmaf(p1[r], CS, tb[i1]); } }
      float pmax = p0[0];
#pragma unroll
      for (int r = 1; r < 16; ++r) pmax = fmaxf(pmax, p0[r]);
#pragma unroll
      for (int r = 0; r < 16; ++r) pmax = fmaxf(pmax, p1[r]);
      { auto rr = __builtin_amdgcn_permlane32_swap(__float_as_uint(pmax), __float_as_uint(pmax), false, false); pmax = fmaxf(__uint_as_float(rr[0]), __uint_as_float(rr[1])); }
      float mn, alpha;
      if (__all(pmax - m_reg <= THR2)) { mn = m_reg; alpha = 1.f; } else { mn = fmaxf(m_reg, pmax); alpha = __builtin_amdgcn_exp2f(m_reg - mn); m_reg = mn; }
      float ps = 0.f;
#pragma unroll
      for (int r = 0; r < 16; ++r) { p0[r] = __builtin_amdgcn_exp2f(p0[r] - mn); p1[r] = __builtin_amdgcn_exp2f(p1[r] - mn); ps += p0[r] + p1[r]; }
      { auto rr = __builtin_amdgcn_permlane32_swap(__float_as_uint(ps), __float_as_uint(ps), false, false); ps = __uint_as_float(rr[0]) + __uint_as_float(rr[1]); }
      l_reg = l_reg * alpha + ps;
      if (__any(alpha < 1.f)) { if (hi == 0) al_l[r32] = alpha; asm volatile("s_waitcnt lgkmcnt(0)" ::: "memory");
#pragma unroll
        for (int d = 0; d < 4; ++d)
#pragma unroll
          for (int r = 0; r < 16; ++r) o[d][r] *= al_l[crow(r, hi)]; }
      bf16x8 pa0, pa1, pa2, pa3;
#define PK4(P, BASE, OUT) do { unsigned a0 = cvtpk(P[BASE + 0], P[BASE + 1]), a1 = cvtpk(P[BASE + 2], P[BASE + 3]); unsigned b0 = cvtpk(P[BASE + 4], P[BASE + 5]), b1 = cvtpk(P[BASE + 6], P[BASE + 7]); \
    auto r0 = __builtin_amdgcn_permlane32_swap(a0, b0, false, false); auto r1 = __builtin_amdgcn_permlane32_swap(a1, b1, false, false); u32x4 w = {r0[0], r1[0], r0[1], r1[1]}; OUT = *reinterpret_cast<bf16x8*>(&w); } while (0)
      PK4(p0, 0, pa0); PK4(p0, 8, pa1); PK4(p1, 0, pa2); PK4(p1, 8, pa3);
#undef PK4
      const int vb = vb0 + buf * SHM_V;
      pv_one<0>(o[0], vb, pa0, pa1, pa2, pa3); pv_one<1>(o[1], vb, pa0, pa1, pa2, pa3); pv_one<2>(o[2], vb, pa0, pa1, pa2, pa3); pv_one<3>(o[3], vb, pa0, pa1, pa2, pa3);
    }
    if (t < t_hi) { asm volatile("s_waitcnt vmcnt(0)" ::: "memory"); SWRITE(buf ^ 1); }
    __syncthreads();
  }
  if (hi == 0) li_l[r32] = l_reg; asm volatile("s_waitcnt lgkmcnt(0)" ::: "memory");
  if (won) {
    char* ost = lds + wid * 8192;
#pragma unroll
    for (int r = 0; r < 16; ++r) { const int orow = crow(r, hi); const float rl = __builtin_amdgcn_rcpf(li_l[orow]);
#pragma unroll
      for (int d0 = 0; d0 < 4; ++d0) *(bf16_t*)(ost + orow * 256 + (d0 * 32 + r32) * 2) = (bf16_t)f2bf(o[d0][r] * rl); }
    asm volatile("s_waitcnt lgkmcnt(0)" ::: "memory");
    bf16_t* Ow = Ob + (size_t)(wid * 32) * D;
#pragma unroll
    for (int k = 0; k < 8; ++k) { const int row = (lane >> 4) + 4 * k, c16 = lane & 15; const u32x4 v = *(const u32x4*)(ost + row * 256 + c16 * 16); *(u32x4*)(Ow + (size_t)row * D + c16 * 8) = v; }
  }
  __syncthreads();
#undef SLOAD
#undef SWRITE
}
#undef KSWZ
#undef SBAR

__device__ __forceinline__ void attn_phase(char* lds, const bf16_t* Q, bf16_t* O, const bf16_t* Kp, const bf16_t* Vp, const bf16_t* Ks, const bf16_t* Vs, const float* relb, int vcu, int G, int tid) {
  for (int bh = vcu; bh < PB * NH; bh += G) { const int b = bh >> 4, h = bh & 15;
    const bf16_t* Kh = Kp + (size_t)b * PS * D + h * HD; const bf16_t* Vh = Vp + (size_t)b * PS * D + h * HD;
    for (int qb = 0; qb < 8; ++qb) band_unit(Q + ((size_t)b * PS + qb * 256) * D + h * HD, O + ((size_t)b * PS + qb * 256) * D + h * HD, Kh, Vh, relb, h, 4 * qb, 8, lds, tid); }
  for (int u = vcu; u < SB * NH; u += G) { const int b = u >> 4, h = u & 15;
    band_unit(Q + ((size_t)TP + (size_t)b * SS) * D + h * HD, O + ((size_t)TP + (size_t)b * SS) * D + h * HD, Ks + (size_t)b * BAND * D + h * HD, Vs + (size_t)b * BAND * D + h * HD, relb, h, 8, 2, lds, tid); }
}
}

namespace rg {
constexpr int XP = 264, GP = 136;
constexpr int OFF_XB = 0, OFF_XC = 35840, OFF_GT = 69632, OFF_CW = 87040;
constexpr float LOG2E = 1.4426950408889634f;
__device__ __forceinline__ float softplus_neg(float l) {
    const float y = __expf(-fabsf(l)); const float lp = y < 0.02f ? y * (1.f - y * (0.5f - y * (0.33333334f - 0.25f * y))) : __logf(1.f + y); return (l > 0.f ? 0.f : -l) + lp; }
__device__ __forceinline__ float neg_expm1(float x) {
    const float s = -x * (1.f + x * (0.5f + x * (0.16666667f + x * (0.041666668f + x * (0.0083333338f + x * 0.0013888889f))))); const float e = 1.f - __expf(x); return x > -0.3f ? s : e; }
__device__ __forceinline__ float neg_expm1_series(float x) { return -x * (1.f + x * (0.5f + x * (0.16666667f + x * (0.041666668f + x * (0.0083333338f + x * 0.0013888889f))))); }
__device__ __forceinline__ float bperm(float v, int addr) { return __int_as_float(__builtin_amdgcn_ds_bpermute(addr, __float_as_int(v))); }
__device__ __forceinline__ bf16x8 cvt8(const float* p) { const f32x4 a = *(const f32x4*)p, b = *(const f32x4*)(p + 4); u32x4 w; w.x = pk2(a[0], a[1]); w.y = pk2(a[2], a[3]); w.z = pk2(b[0], b[1]); w.w = pk2(b[2], b[3]); return *reinterpret_cast<bf16x8*>(&w); }

__device__ __forceinline__ void rg_unit(char* lds, const bf16_t* __restrict__ xb, const bf16_t* __restrict__ gin, bf16_t* __restrict__ hgo, const bf16_t* __restrict__ wai, const float* __restrict__ cw, const float* __restrict__ cb,
                                        const float* __restrict__ b_a, const float* __restrict__ b_i, const float* __restrict__ lam, const float* __restrict__ sconv, const float* __restrict__ h0p, float* __restrict__ rnn_out,
                                        size_t m0, int nchunks, int cbase, int hf, bool pos0, int tid_in) {
    int tid = tid_in; asm volatile("" : "+v"(tid));
    const int wid = __builtin_amdgcn_readfirstlane(tid >> 6), lane = tid & 63, fr = lane & 15, fq = lane >> 4;
    bf16_t* XB = (bf16_t*)(lds + OFF_XB); bf16_t* XC = (bf16_t*)(lds + OFF_XC); bf16_t* GT = (bf16_t*)(lds + OFF_GT); float* CW = (float*)(lds + OFF_CW);
    const int chl = hf * 128 + 16 * wid + fr, ch = cbase + chl, gcol = cbase + hf * 128;
    bf16x8 Bf[2][8];
#pragma unroll
    for (int nt = 0; nt < 2; ++nt)
#pragma unroll
        for (int ks = 0; ks < 8; ++ks) Bf[nt][ks] = *reinterpret_cast<const bf16x8*>(wai + (size_t)(2 * chl + nt) * 256 + 32 * ks + 8 * fq);
    if (tid < 256) {
#pragma unroll
        for (int k = 0; k < 4; ++k) CW[k * 256 + tid] = cw[k * D + cbase + tid];
        CW[4 * 256 + tid] = cb[cbase + tid]; }
    const float ba = b_a[ch], bi = b_i[ch], sp = softplus_neg(lam[ch]), c8l = -8.f * sp * LOG2E, c2 = -16.f * sp;
    float H = h0p ? h0p[ch] : 0.f;
    const bool small_x = __all(c2 > -0.3f);
#pragma unroll
    for (int i = 0; i < 5; ++i) { const int p = tid + 512 * i; if (p < 67 * 32) { const int row = p >> 5, pc = p & 31; bf16x8 v;
        if (row >= 3) v = *reinterpret_cast<const bf16x8*>(xb + (m0 + row - 3) * D + cbase + 8 * pc);
        else if (sconv) v = cvt8(sconv + (size_t)row * D + cbase + 8 * pc); else v = (bf16x8){0, 0, 0, 0, 0, 0, 0, 0};
        *reinterpret_cast<bf16x8*>(XB + row * XP + 8 * pc) = v; } }
#pragma unroll
    for (int i = 0; i < 2; ++i) { const int p = tid + 512 * i, row = p >> 4, pc = p & 15; *reinterpret_cast<bf16x8*>(GT + row * GP + 8 * pc) = *reinterpret_cast<const bf16x8*>(gin + (m0 + row) * D + gcol + 8 * pc); }
    __syncthreads();
    const int a16 = (lane >= 16 ? lane - 16 : lane) << 2, a32 = (lane >= 32 ? lane - 32 : lane) << 2, a48 = (fr + 48) << 2;
    for (int c = 0; c < nchunks; ++c) {
        const size_t mc = m0 + (size_t)c * 64; const bool more = c + 1 < nchunks;
        { const int pc = tid & 31, r4 = (tid >> 5) * 4; f32x2 y[4][4], wk[4][4];
          { const f32x4 b0 = *(const f32x4*)(CW + 4 * 256 + 8 * pc), b1 = *(const f32x4*)(CW + 4 * 256 + 8 * pc + 4);
#pragma unroll
            for (int o = 0; o < 4; ++o) { y[o][0] = (f32x2){b0[0], b0[1]}; y[o][1] = (f32x2){b0[2], b0[3]}; y[o][2] = (f32x2){b1[0], b1[1]}; y[o][3] = (f32x2){b1[2], b1[3]}; } }
#pragma unroll
          for (int k = 0; k < 4; ++k) { const f32x4 w0 = *(const f32x4*)(CW + k * 256 + 8 * pc), w1 = *(const f32x4*)(CW + k * 256 + 8 * pc + 4);
              wk[k][0] = (f32x2){w0[0], w0[1]}; wk[k][1] = (f32x2){w0[2], w0[3]}; wk[k][2] = (f32x2){w1[0], w1[1]}; wk[k][3] = (f32x2){w1[2], w1[3]}; }
#pragma unroll
          for (int j = 0; j < 7; ++j) { const u32x4 xr = *reinterpret_cast<const u32x4*>(XB + (r4 + j) * XP + 8 * pc); f32x2 xv[4];
              xv[0] = (f32x2){__uint_as_float(xr.x << 16), __uint_as_float(xr.x & 0xffff0000u)}; xv[1] = (f32x2){__uint_as_float(xr.y << 16), __uint_as_float(xr.y & 0xffff0000u)};
              xv[2] = (f32x2){__uint_as_float(xr.z << 16), __uint_as_float(xr.z & 0xffff0000u)}; xv[3] = (f32x2){__uint_as_float(xr.w << 16), __uint_as_float(xr.w & 0xffff0000u)};
#pragma unroll
              for (int o = 0; o < 4; ++o) { const int k = j - o; if (k >= 0 && k < 4) {
#pragma unroll
                  for (int p = 0; p < 4; ++p) y[o][p] = wk[k][p] * xv[p] + y[o][p]; } } }
#pragma unroll
          for (int o = 0; o < 4; ++o) { u32x4 w; w.x = pk2(y[o][0][0], y[o][0][1]); w.y = pk2(y[o][1][0], y[o][1][1]); w.z = pk2(y[o][2][0], y[o][2][1]); w.w = pk2(y[o][3][0], y[o][3][1]); *(u32x4*)(XC + (r4 + o) * XP + 8 * pc) = w; } }
        __syncthreads();
        bf16x8 px[5], pg[2]; int t2 = tid; asm volatile("" : "+v"(t2));
        if (more) {
#pragma unroll
            for (int i = 0; i < 5; ++i) { const int p = t2 + 512 * i; if (p < 67 * 32) px[i] = *reinterpret_cast<const bf16x8*>(xb + (mc + 61 + (p >> 5)) * D + cbase + 8 * (p & 31)); }
#pragma unroll
            for (int i = 0; i < 2; ++i) { const int p = t2 + 512 * i; pg[i] = *reinterpret_cast<const bf16x8*>(gin + (mc + 64 + (p >> 4)) * D + gcol + 8 * (p & 15)); } }
        f32x4 acc[4][2];
#pragma unroll
        for (int m = 0; m < 4; ++m) { acc[m][0] = (f32x4){0.f, 0.f, 0.f, 0.f}; acc[m][1] = (f32x4){0.f, 0.f, 0.f, 0.f}; }
#pragma unroll
        for (int ks = 0; ks < 8; ++ks) { bf16x8 af[4];
#pragma unroll
            for (int m = 0; m < 4; ++m) af[m] = *reinterpret_cast<const bf16x8*>(XC + (16 * m + fr) * XP + 32 * ks + 8 * fq);
#pragma unroll
            for (int m = 0; m < 4; ++m) { acc[m][0] = __builtin_amdgcn_mfma_f32_16x16x32_bf16(af[m], Bf[0][ks], acc[m][0], 0, 0, 0); acc[m][1] = __builtin_amdgcn_mfma_f32_16x16x32_bf16(af[m], Bf[1][ks], acc[m][1], 0, 0, 0); } }
#pragma unroll
        for (int m = 0; m < 4; ++m)
#pragma unroll
            for (int rgi = 0; rgi < 4; ++rgi) { const int tok = 16 * m + 4 * fq + rgi;
                const float xcv = bf2f(XC[tok * XP + chl]);
                const float r = __builtin_amdgcn_rcpf(1.f + __expf(-(acc[m][0][rgi] + ba))), ig = __builtin_amdgcn_rcpf(1.f + __expf(-(acc[m][1][rgi] + bi)));
                const float av = __builtin_amdgcn_exp2f(r * c8l); const float x2 = r * c2;
                float mult = __builtin_amdgcn_sqrtf(small_x ? neg_expm1_series(x2) : neg_expm1(x2)); if (pos0 && c == 0 && tok == 0) mult = 1.f;
                acc[m][0][rgi] = av; acc[m][1][rgi] = mult * ig * xcv; }
#pragma unroll
        for (int m = 0; m < 4; ++m) {
            float A = 1.f, B = 0.f;
#pragma unroll
            for (int rgi = 0; rgi < 4; ++rgi) { B = acc[m][0][rgi] * B + acc[m][1][rgi]; A *= acc[m][0][rgi]; }
            { const float Ap = bperm(A, a16), Bp = bperm(B, a16); if (fq >= 1) { B = A * Bp + B; A = A * Ap; } }
            { const float Ap = bperm(A, a32), Bp = bperm(B, a32); if (fq >= 2) { B = A * Bp + B; A = A * Ap; } }
            float Ae = bperm(A, a16), Be = bperm(B, a16); if (fq == 0) { Ae = 1.f; Be = 0.f; }
            const float At = bperm(A, a48), Bt = bperm(B, a48);
            float h = Ae * H + Be; H = At * H + Bt;
#pragma unroll
            for (int rgi = 0; rgi < 4; ++rgi) { h = acc[m][0][rgi] * h + acc[m][1][rgi]; acc[m][1][rgi] = h; } }
#pragma unroll
        for (int m = 0; m < 4; ++m)
#pragma unroll
            for (int rgi = 0; rgi < 4; ++rgi) { bf16_t* gp = GT + (16 * m + 4 * fq + rgi) * GP + 16 * wid + fr; *gp = (bf16_t)f2bf(acc[m][1][rgi] * bf2f(*gp)); }
        if (!more && fq == 0) rnn_out[ch] = H;
        __syncthreads();
#pragma unroll
        for (int i = 0; i < 2; ++i) { const int p = tid + 512 * i, row = p >> 4, pc = p & 15; *(u32x4*)(hgo + (mc + row) * D + gcol + 8 * pc) = *(const u32x4*)(GT + row * GP + 8 * pc); }
        __syncthreads();
        if (more) {
#pragma unroll
            for (int i = 0; i < 5; ++i) { const int p = t2 + 512 * i; if (p < 67 * 32) *reinterpret_cast<bf16x8*>(XB + (p >> 5) * XP + 8 * (p & 31)) = px[i]; }
#pragma unroll
            for (int i = 0; i < 2; ++i) { const int p = t2 + 512 * i; *reinterpret_cast<bf16x8*>(GT + (p >> 4) * GP + 8 * (p & 15)) = pg[i]; }
            __syncthreads(); }
    }
    __syncthreads();
}

__device__ __forceinline__ void rglru_phase(char* lds, const bf16_t* xb, const bf16_t* gin, bf16_t* hgo, const bf16_t* wai, const float* cw, const float* cb, const float* b_a, const float* b_i, const float* lam,
                                            const float* sconv, const float* srnn, float* rnnp, float* rnns, int vcu, int G, int tid) {
    for (int uu = vcu; uu < (PB + SB) * 16; uu += G) { const bool samp = uu >= PB * 16; const int u = samp ? uu - PB * 16 : uu; const int b = u >> 4, n = (u >> 1) & 7, hf = u & 1;
        rg_unit(lds, xb, gin, hgo, wai + (size_t)n * 512 * 256, cw, cb, b_a, b_i, lam, samp ? sconv + (size_t)b * 3 * D : nullptr, samp ? srnn + (size_t)b * D : nullptr, (samp ? rnns : rnnp) + (size_t)b * D,
                samp ? (size_t)TP + (size_t)b * SS : (size_t)b * PS, samp ? 1 : PS / 64, n * 256, hf, !samp, tid); }
}
}

constexpr int NWAVES = 8;
constexpr int RING_BYTES = 139264;
constexpr int MISC_OFF = RING_BYTES + 320;
constexpr int LDS_BYTES = 159744;
static_assert(EPI_LDS_OFF >= MISC_OFF + 256 && EPI_LDS_OFF + 2 * EPI_LDS_HALF <= LDS_BYTES, "epilogue prefetch area inside the LDS allocation");
using pg8::bf16_t;

__device__ __forceinline__ float lane_xor_f(float v, int lane4) { return __int_as_float(__builtin_amdgcn_ds_bpermute(lane4, __float_as_int(v))); }
__device__ __forceinline__ float wave_sum(float v, int lane) {
#pragma unroll
    for (int o = 1; o < 64; o <<= 1) v += lane_xor_f(v, (lane ^ o) << 2);
    return v;
}
__device__ __forceinline__ float wave_max(float v, int lane) {
#pragma unroll
    for (int o = 1; o < 64; o <<= 1) v = fmaxf(v, lane_xor_f(v, (lane ^ o) << 2));
    return v;
}

struct Args { const float* in[32]; float* out; unsigned char* ws; };
typedef const __attribute__((address_space(4))) unsigned char* kaptr_t;
__device__ __forceinline__ kaptr_t ka_fresh() { kaptr_t ka = (kaptr_t)__builtin_amdgcn_kernarg_segment_ptr(); asm volatile("" : "+s"(ka)); return ka; }
__device__ __forceinline__ const float* arg_in(kaptr_t ka, int i) { return *(const float* const __attribute__((address_space(4)))*)(ka + 8 * i); }
__device__ __forceinline__ float* arg_out(kaptr_t ka) { return *(float* const __attribute__((address_space(4)))*)(ka + 8 * 32); }
__device__ __forceinline__ unsigned char* arg_ws(kaptr_t ka) { return *(unsigned char* const __attribute__((address_space(4)))*)(ka + 8 * 33); }
#define GAS __attribute__((address_space(1)))
struct TItem { const GAS float* W; GAS bf16_t* WT; const GAS float* kscale  ; int K, N, mode, off, item; };
__device__ __forceinline__ void t_load(const TItem& t, float (&v)[32], int lane) {
    const int nblk = t.N / 32, kb = t.item / nblk, nb = t.item % nblk; const GAS float* p = t.W + (size_t)(64 * kb + (lane >> 5)) * t.N + 32 * nb + (lane & 31);
#pragma unroll
    for (int i = 0; i < 32; ++i) v[i] = p[(size_t)(2 * i) * t.N];
    if (t.kscale) { const GAS float* ks = t.kscale + 64 * kb + (lane >> 5);
#pragma unroll
        for (int i = 0; i < 32; ++i) v[i] *= ks[2 * i]; }
}
__device__ __forceinline__ void t_finish(const TItem& t, const float (&v)[32], LAS float* scr, int lane) {
    const int nblk = t.N / 32, kb = t.item / nblk, nb = t.item % nblk, k0 = 64 * kb, n0 = 32 * nb;
#pragma unroll
    for (int i = 0; i < 32; ++i) scr[(2 * i + (lane >> 5)) * 33 + (lane & 31)] = v[i];
    LDS_WAIT(); asm volatile("" ::: "memory");
    const int c = lane & 7;
#pragma unroll
    for (int j = 0; j < 4; ++j) { const int n = (lane >> 3) + 8 * j; const LAS float* s = scr + (8 * c) * 33 + n;
        u32x4 o; o.x = pk2(s[0 * 33], s[1 * 33]); o.y = pk2(s[2 * 33], s[3 * 33]); o.z = pk2(s[4 * 33], s[5 * 33]); o.w = pk2(s[6 * 33], s[7 * 33]);
        const int nc = n0 + n; const int drow = t.mode == 0 ? t.off + nc : (t.mode == 1 ? ((nc >> 7) * 256 + (nc & 127) + t.off) : (2 * nc + t.off));
        *(GAS u32x4*)(t.WT + (size_t)drow * t.K + k0 + 8 * c) = o; }
}
constexpr int T_IB = 2048;
constexpr int T_I13 = 32 * (DFF / 32);
constexpr int T_I2 = (DFF / 64) * 64;
constexpr int T_S0 = 6 * T_IB, T_S1 = T_S0 + 4 * T_IB, T_S2 = T_S1 + 2 * T_IB, T_S3 = T_S2 + 32 * 32, T_S4 = T_S3 + 8 * T_I13, T_S5 = T_S4 + 4 * T_I2;
__device__ __forceinline__ TItem t_decode(kaptr_t ka, int it) {
    unsigned char* ws = arg_ws(ka); TItem t; t.kscale = nullptr;
    if (it < T_S0) { const int mi = it / T_IB, l = mi / 3, ty = mi % 3;
        t.W = (const GAS float*)((ty == 0 ? arg_in(ka, 13) : (ty == 1 ? arg_in(ka, 12) : arg_in(ka, 21))) + (size_t)l * D * D); t.WT = (GAS bf16_t*)(ty == 2 ? (bf16_t*)(ws + WS_WRGO) + (size_t)l * D * D : (bf16_t*)(ws + WS_WGI) + (size_t)l * 2 * D * D);
        t.K = D; t.N = D; t.mode = 0; t.off = ty == 1 ? D : 0; t.item = it % T_IB; }
    else if (it < T_S1) { const int q = it - T_S0, mi = q / T_IB, l = mi >> 1, ty = mi & 1;
        t.W = (const GAS float*)((ty == 0 ? arg_in(ka, 25) : arg_in(ka, 26)) + (size_t)l * D * D); t.WT = (GAS bf16_t*)((bf16_t*)(ws + (ty == 0 ? WS_WQ : WS_WO)) + (size_t)l * D * D); t.K = D; t.N = D; t.mode = 0; t.off = 0; t.item = q % T_IB; }
    else if (it < T_S2) { const int q = it - T_S1, ty = q / T_IB;
        t.W = (const GAS float*)(ty == 0 ? arg_in(ka, 23) : arg_in(ka, 24)); t.WT = (GAS bf16_t*)((bf16_t*)(ws + WS_WKV)); t.kscale = (const GAS float*)arg_in(ka, 22);     t.K = D; t.N = D; t.mode = 0; t.off = ty == 0 ? 0 : D; t.item = q % T_IB; }
    else if (it < T_S3) { const int q = it - T_S2, mi = q / 32, ln = mi >> 1, ty = mi & 1;
        t.W = (const GAS float*)((ty == 0 ? arg_in(ka, 16) : arg_in(ka, 18)) + (size_t)ln * 256 * 256); t.WT = (GAS bf16_t*)((bf16_t*)(ws + WS_WAI) + (size_t)ln * 512 * 256); t.K = 256; t.N = 256; t.mode = 2; t.off = ty; t.item = q % 32; }
    else if (it < T_S4) { const int q = it - T_S3, mi = q / T_I13, l = mi >> 1, ty = mi & 1;
        t.W = (const GAS float*)((ty == 0 ? arg_in(ka, 28) : arg_in(ka, 29)) + (size_t)l * D * DFF); t.WT = (GAS bf16_t*)((bf16_t*)(ws + WS_W13) + (size_t)l * 2 * DFF * D); t.K = D; t.N = DFF; t.mode = 1; t.off = ty * 128; t.item = q % T_I13; }
    else { const int q = it - T_S4, l = q / T_I2;
        t.W = (const GAS float*)(arg_in(ka, 30) + (size_t)l * DFF * D); t.WT = (GAS bf16_t*)((bf16_t*)(ws + WS_W2) + (size_t)l * D * DFF); t.K = DFF; t.N = D; t.mode = 0; t.off = 0; t.item = q % T_I2; }
    return t;
}
__device__ __forceinline__ void p0_weights(kaptr_t ka, LAS unsigned char* lds, int gw, int NGW, int wave, int lane) {
    LAS float* scr0 = (LAS float*)(lds + wave * 16896); LAS float* scr1 = scr0 + 64 * 33;
    for (int it = 2 * gw; it < T_S5; it += 2 * NGW) {
        const TItem t0 = t_decode(ka, it), t1 = t_decode(ka, it + 1);
        float v0[32], v1[32];
        t_load(t0, v0, lane); t_load(t1, v1, lane);
        t_finish(t0, v0, scr0, lane); t_finish(t1, v1, scr1, lane);
        LDS_WAIT(); asm volatile("" ::: "memory");
    }
}

__device__ __forceinline__ void p0_cache(const float* __restrict__ ck, const float* __restrict__ cv, bf16_t* __restrict__ KS, bf16_t* __restrict__ VS, int gw, int NGW, int lane) {
    constexpr int STEPS = SB * LEFT * D / 512;
    for (int it0 = 4 * gw; it0 < 2 * STEPS; it0 += 4 * NGW) {
        f32x4 x0[4], x1[4];
#pragma unroll
        for (int u = 0; u < 4; ++u) { const int it = it0 + u; const bool isv = it >= STEPS; const size_t e = (size_t)(isv ? it - STEPS : it) * 512 + lane * 8; const float* src = (isv ? cv : ck) + e; x0[u] = *(const f32x4*)src; x1[u] = *(const f32x4*)(src + 4); }
#pragma unroll
        for (int u = 0; u < 4; ++u) { const int it = it0 + u; const bool isv = it >= STEPS; const size_t e = (size_t)(isv ? it - STEPS : it) * 512 + lane * 8;
            const size_t bj = e >> 11, col = e & (D - 1), b = bj >> 9, j = bj & (LEFT - 1);
            u32x4 w; w.x = pk2(x0[u][0], x0[u][1]); w.y = pk2(x0[u][2], x0[u][3]); w.z = pk2(x1[u][0], x1[u][1]); w.w = pk2(x1[u][2], x1[u][3]);
            *(u32x4*)((isv ? VS : KS) + (b * BAND + j) * D + col) = w; }
    }
}

#define WG_BAR() do { asm volatile("s_waitcnt lgkmcnt(0)" ::: "memory"); __builtin_amdgcn_s_barrier(); asm volatile("" ::: "memory"); } while (0)
__device__ __forceinline__ void p0_mod(const float* __restrict__ c_p, const float* __restrict__ c_s, const float* __restrict__ ada_w, const float* __restrict__ ada_b, float* __restrict__ mod, LAS unsigned char* lds, int vcu, int G, int tid) {
    constexpr int AP = 264;
    LAS unsigned short* Ahi = (LAS unsigned short*)lds; LAS unsigned short* Alo = Ahi + 64 * AP;
    LAS float* red = (LAS float*)lds;
    const int lane = tid & 63, wv = tid >> 6, n32 = lane & 31, kg = lane >> 5, sb = tid >> 5, sk = (tid & 31) * 8;
    const int wv_s = __builtin_amdgcn_readfirstlane(wv); const int voff = (8 * kg * MODW + n32) * 4;
    for (int item = vcu; item < 4 * 192; item += G) {
        const int l = item / 192, j0 = (item % 192) * 64;
        att::f32x16 acc[2][2];
#pragma unroll
        for (int nb = 0; nb < 2; ++nb)
#pragma unroll
            for (int mb = 0; mb < 2; ++mb) acc[nb][mb] = att::f32x16{};
        const __amdgpu_buffer_rsrc_t wrs = __builtin_amdgcn_make_buffer_rsrc((void*)(ada_w + (size_t)l * D * MODW), (short)0, D * MODW * 4, 0x00020000);
        const int soff0 = (32 * wv_s * MODW + j0) * 4;
        const float* cb0 = c_p + sb * D + sk; const float* cb1 = c_s + sb * D + sk; const float* cb2 = c_s + (16 + sb) * D + sk;
        f32x4 cr[3][2]; float wa[32], wb[32];
#define MOD_LOADC(kc) do { cr[0][0] = *(const f32x4*)(cb0 + (kc) * 256); cr[0][1] = *(const f32x4*)(cb0 + (kc) * 256 + 4); cr[1][0] = *(const f32x4*)(cb1 + (kc) * 256); cr[1][1] = *(const f32x4*)(cb1 + (kc) * 256 + 4); \
                           cr[2][0] = *(const f32x4*)(cb2 + (kc) * 256); cr[2][1] = *(const f32x4*)(cb2 + (kc) * 256 + 4); } while (0)
#define MOD_LOADW(dst, kc) do { _Pragma("unroll") for (int q = 0; q < 4; ++q) { _Pragma("unroll") for (int i = 0; i < 8; ++i) dst[q * 8 + i] = __uint_as_float((unsigned)__builtin_amdgcn_raw_buffer_load_b32(wrs, voff, soff0 + (((kc) * 256 + 16 * (q >> 1) + i) * MODW + 32 * (q & 1)) * 4, 0)); } } while (0)
#define MOD_STAGE() do { WG_BAR(); __builtin_amdgcn_sched_barrier(0); \
            _Pragma("unroll") for (int g = 0; g < 3; ++g) { u32x4 h4, l4; \
                _Pragma("unroll") for (int p = 0; p < 4; ++p) { const float x0 = cr[g][p >> 1][2 * (p & 1)], x1 = cr[g][p >> 1][2 * (p & 1) + 1]; \
                    const float s0 = x0 * __builtin_amdgcn_rcpf(1.0f + __expf(-x0)), s1 = x1 * __builtin_amdgcn_rcpf(1.0f + __expf(-x1)); \
                    const unsigned u0 = __float_as_uint(s0) & 0xffff0000u, u1 = __float_as_uint(s1) & 0xffff0000u; \
                    h4[p] = (u0 >> 16) | u1; l4[p] = pk2(s0 - __uint_as_float(u0), s1 - __uint_as_float(u1)); } \
                *(LAS u32x4*)(Ahi + (sb + 16 * g) * AP + sk) = h4; *(LAS u32x4*)(Alo + (sb + 16 * g) * AP + sk) = l4; } \
            *(LAS u32x4*)(Ahi + (sb + 48) * AP + sk) = (u32x4){0u, 0u, 0u, 0u}; *(LAS u32x4*)(Alo + (sb + 48) * AP + sk) = (u32x4){0u, 0u, 0u, 0u}; \
            WG_BAR(); } while (0)
#define MOD_COMPUTE(w) do { _Pragma("unroll") for (int ks2 = 0; ks2 < 2; ++ks2) { bf16x8 ah[2], al[2]; \
                _Pragma("unroll") for (int mb = 0; mb < 2; ++mb) { const int off = (32 * mb + n32) * AP + 32 * wv + 16 * ks2 + 8 * kg; ah[mb] = *(const LAS bf16x8*)(Ahi + off); al[mb] = *(const LAS bf16x8*)(Alo + off); } \
                _Pragma("unroll") for (int nb = 0; nb < 2; ++nb) { u32x4 bh4, bl4; \
                    _Pragma("unroll") for (int p = 0; p < 4; ++p) { const float w0 = w[(ks2 * 2 + nb) * 8 + 2 * p], w1 = w[(ks2 * 2 + nb) * 8 + 2 * p + 1]; \
                        const unsigned u0 = __float_as_uint(w0) & 0xffff0000u, u1 = __float_as_uint(w1) & 0xffff0000u; bh4[p] = (u0 >> 16) | u1; bl4[p] = pk2(w0 - __uint_as_float(u0), w1 - __uint_as_float(u1)); } \
                    const bf16x8 bh = *reinterpret_cast<const bf16x8*>(&bh4), bl = *reinterpret_cast<const bf16x8*>(&bl4); \
                    _Pragma("unroll") for (int mb = 0; mb < 2; ++mb) { acc[nb][mb] = __builtin_amdgcn_mfma_f32_32x32x16_bf16(ah[mb], bh, acc[nb][mb], 0, 0, 0); \
                        acc[nb][mb] = __builtin_amdgcn_mfma_f32_32x32x16_bf16(ah[mb], bl, acc[nb][mb], 0, 0, 0); acc[nb][mb] = __builtin_amdgcn_mfma_f32_32x32x16_bf16(al[mb], bh, acc[nb][mb], 0, 0, 0); } } } } while (0)
        MOD_LOADC(0); __builtin_amdgcn_sched_barrier(0); MOD_LOADW(wa, 0); __builtin_amdgcn_sched_barrier(0);
#pragma unroll
        for (int kc2 = 0; kc2 < 4; ++kc2) {
            MOD_STAGE(); __builtin_amdgcn_sched_barrier(0); MOD_LOADC(2 * kc2 + 1); __builtin_amdgcn_sched_barrier(0); MOD_LOADW(wb, 2 * kc2 + 1); __builtin_amdgcn_sched_barrier(0); MOD_COMPUTE(wa); __builtin_amdgcn_sched_barrier(0);
            MOD_STAGE(); __builtin_amdgcn_sched_barrier(0); if (kc2 < 3) { MOD_LOADC(2 * kc2 + 2); __builtin_amdgcn_sched_barrier(0); MOD_LOADW(wa, 2 * kc2 + 2); } __builtin_amdgcn_sched_barrier(0); MOD_COMPUTE(wb); __builtin_amdgcn_sched_barrier(0);
        }
#undef MOD_LOADC
#undef MOD_LOADW
#undef MOD_STAGE
#undef MOD_COMPUTE
        WG_BAR();
#pragma unroll
        for (int nb = 0; nb < 2; ++nb)
#pragma unroll
            for (int mb = 0; mb < 2; ++mb)
#pragma unroll
                for (int r = 0; r < (mb ? 8 : 16); ++r) { const int m = 32 * mb + (r & 3) + 8 * (r >> 2) + 4 * kg; red[(wv * NBB + m) * 64 + 32 * nb + n32] = acc[nb][mb][r]; }
        WG_BAR();
#pragma unroll
        for (int i = 0; i < 6; ++i) { const int o = tid + 512 * i, bb = o >> 6, col = o & 63; float s = ada_b[l * MODW + j0 + col];
#pragma unroll
            for (int w = 0; w < 8; ++w) s += red[(w * NBB + bb) * 64 + col];
            mod[((size_t)l * NBB + bb) * MODW + j0 + col] = s; }
    }
    __syncthreads();
}

__device__ __forceinline__ void gm_tables(const float* __restrict__ g_mix, const float* __restrict__ g_ffn, const float* __restrict__ mod, float* __restrict__ gm, int gtid, int nthreads) {
    for (int e = gtid; e < 8 * NBB * (D / 4); e += nthreads) { const int k4 = e % (D / 4), b = (e / (D / 4)) % NBB, i = e / ((D / 4) * NBB), l = i >> 1;
        const f32x4 g = *(const f32x4*)((i & 1 ? g_ffn : g_mix) + (size_t)l * D + 4 * k4), sc = *(const f32x4*)(mod + ((size_t)l * NBB + b) * MODW + (i & 1 ? 4 * D : D) + 4 * k4);
        *(f32x4*)(gm + ((size_t)i * NBB + b) * D + 4 * k4) = g * (sc + 1.0f); }
}
__device__ __forceinline__ void norm0_pass(const float* __restrict__ xp_, const float* __restrict__ xs_, bf16_t* __restrict__ X, bf16_t* __restrict__ xg, const float* __restrict__ g, const float* __restrict__ mod0, pg8::ssq_t* __restrict__ ssq0, int gw, int NGW, int lane) {
    for (int m0 = gw; m0 < T; m0 += 2 * NGW) {
        const int m1 = m0 + NGW; const bool two = m1 < T; const int mb = two ? m1 : m0;
        const f32x4* xr0 = (const f32x4*)(m0 < TP ? xp_ + (size_t)m0 * D : xs_ + (size_t)(m0 - TP) * D) + lane;
        const f32x4* xr1 = (const f32x4*)(mb < TP ? xp_ + (size_t)mb * D : xs_ + (size_t)(mb - TP) * D) + lane;
        f32x4 v0[8], v1[8];
#pragma unroll
        for (int j = 0; j < 8; ++j) { v0[j] = xr0[64 * j]; v1[j] = xr1[64 * j]; }
#pragma unroll
        for (int r = 0; r < 2; ++r) { if (r == 1 && !two) break; const int m = r ? m1 : m0; const f32x4* v = r ? v1 : v0; float ss = 0.f;
#pragma unroll
            for (int j = 0; j < 8; ++j) ss += (v[j][0] * v[j][0] + v[j][1] * v[j][1]) + (v[j][2] * v[j][2] + v[j][3] * v[j][3]);
            ss = wave_sum(ss, lane); if (lane == 0) ssq0[m] = pg8::ssq_fix(ss);
            const int bb = row_bb(m); const f32x4* gp = (const f32x4*)g + lane; const f32x4* sc = (const f32x4*)(mod0 + (size_t)bb * MODW + D) + lane;
            u32x2* xc = (u32x2*)(X + (size_t)m * XPITCH) + lane; u32x2* o = (u32x2*)(xg + (size_t)m * D) + lane;
#pragma unroll
            for (int j = 0; j < 8; ++j) { { u32x2 w; w.x = pk2(v[j][0], v[j][1]); w.y = pk2(v[j][2], v[j][3]); xc[64 * j] = w; } const f32x4 z = v[j] * (gp[64 * j] * (sc[64 * j] + 1.0f)); u32x2 w; w.x = pk2(z[0], z[1]); w.y = pk2(z[2], z[3]); o[64 * j] = w; } }
    }
}
__device__ __forceinline__ void shw_tile(const float* __restrict__ sh, const bf16_t* __restrict__ Wt, float* __restrict__ dst, int N, int n0, int lane) {
    const int fr = lane & 15, fq = lane >> 4;
    f32x4 acc[3][4];
#pragma unroll
    for (int m = 0; m < 3; ++m)
#pragma unroll
        for (int j = 0; j < 4; ++j) acc[m][j] = (f32x4){0.f, 0.f, 0.f, 0.f};
    const float* ap = sh + (size_t)fr * MODW + 8 * fq; const bf16_t* bp = Wt + (size_t)(n0 + fr) * D + 8 * fq;
#pragma unroll 4
    for (int k0 = 0; k0 < D; k0 += 32) { bf16x8 af[3], bfr[4];
#pragma unroll
        for (int m = 0; m < 3; ++m) { const f32x4 x0 = *(const f32x4*)(ap + (size_t)(16 * m) * MODW + k0), x1 = *(const f32x4*)(ap + (size_t)(16 * m) * MODW + k0 + 4); u32x4 w; w.x = pk2(x0[0], x0[1]); w.y = pk2(x0[2], x0[3]); w.z = pk2(x1[0], x1[1]); w.w = pk2(x1[2], x1[3]); af[m] = *reinterpret_cast<bf16x8*>(&w); }
#pragma unroll
        for (int j = 0; j < 4; ++j) bfr[j] = *reinterpret_cast<const bf16x8*>(bp + (size_t)(16 * j) * D + k0);
#pragma unroll
        for (int m = 0; m < 3; ++m)
#pragma unroll
            for (int j = 0; j < 4; ++j) acc[m][j] = __builtin_amdgcn_mfma_f32_16x16x32_bf16(af[m], bfr[j], acc[m][j], 0, 0, 0); }
#pragma unroll
    for (int m = 0; m < 3; ++m)
#pragma unroll
        for (int j = 0; j < 4; ++j)
#pragma unroll
            for (int r = 0; r < 4; ++r) dst[(size_t)(16 * m + 4 * fq + r) * N + n0 + 16 * j + fr] = acc[m][j][r];
}
__device__ __forceinline__ void shw_phase(const float* __restrict__ mod, unsigned char* ws, int vcu, int G, int wave, int lane) {
    float* shw = (float*)(ws + WS_SHW);
    for (int t = vcu + G * wave; t < 896; t += G * NWAVES) {
        if (t < 128) { const int l = t >> 6, n0 = (t & 63) * 64; shw_tile(mod + (size_t)l * NBB * MODW, (const bf16_t*)(ws + WS_WGI) + (size_t)l * 2 * D * D, shw + SHW_GI + (size_t)l * NBB * 2 * D, 2 * D, n0, lane); }
        else if (t < 192) { const int bl = (t - 128) >> 5, n0 = ((t - 128) & 31) * 64; shw_tile(mod + (size_t)(2 + bl) * NBB * MODW, (const bf16_t*)(ws + WS_WQ) + (size_t)bl * D * D, shw + SHW_Q + (size_t)bl * NBB * D, D, n0, lane); }
        else { const int q = t - 192, l = q / 176, n0 = (q % 176) * 64; shw_tile(mod + (size_t)l * NBB * MODW + 3 * D, (const bf16_t*)(ws + WS_W13) + (size_t)l * 2 * DFF * D, shw + SHW_13 + (size_t)l * NBB * 2 * DFF, 2 * DFF, n0, lane); }
    }
}
__device__ __forceinline__ void final_pass(float* Y, const float* __restrict__ g, const pg8::ssq_t* __restrict__ ssq, int gw, int NGW, int lane) {
    for (int m0 = gw; m0 < T; m0 += 2 * NGW) {
        const int m1 = m0 + NGW; const bool two = m1 < T; const int mb = two ? m1 : m0;
        const u32x2* x0 = (const u32x2*)((const bf16_t*)(Y + (size_t)m0 * D) + D) + lane; const u32x2* x1 = (const u32x2*)((const bf16_t*)(Y + (size_t)mb * D) + D) + lane; const f32x4* gp = (const f32x4*)g + lane;
        u32x2 v0[8], v1[8];
#pragma unroll
        for (int j = 0; j < 8; ++j) { v0[j] = x0[64 * j]; v1[j] = x1[64 * j]; }
        const float r0 = pg8::rstd_of(ssq[m0]), r1 = pg8::rstd_of(ssq[mb]);
        asm volatile("s_waitcnt vmcnt(0)" ::: "memory");
        f32x4* y0 = (f32x4*)(Y + (size_t)m0 * D) + lane; f32x4* y1 = (f32x4*)(Y + (size_t)mb * D) + lane;
#pragma unroll
        for (int j = 0; j < 8; ++j) { const f32x4 xv = {__uint_as_float(v0[j].x << 16), __uint_as_float(v0[j].x & 0xffff0000u), __uint_as_float(v0[j].y << 16), __uint_as_float(v0[j].y & 0xffff0000u)}; y0[64 * j] = (xv * r0) * gp[64 * j]; }
        if (two) {
#pragma unroll
            for (int j = 0; j < 8; ++j) { const f32x4 xv = {__uint_as_float(v1[j].x << 16), __uint_as_float(v1[j].x & 0xffff0000u), __uint_as_float(v1[j].y << 16), __uint_as_float(v1[j].y & 0xffff0000u)}; y1[64 * j] = (xv * r1) * gp[64 * j]; } }
    }
}

#define fresh_tid() ({ int l_; asm volatile("v_mbcnt_lo_u32_b32 %0, -1, 0\n\tv_mbcnt_hi_u32_b32 %0, -1, %0" : "=v"(l_)); (wave_s_ << 6) | l_; })
__device__ __forceinline__ int fresh_s(int v) { asm volatile("" : "+s"(v)); return v; }
#define WSP(off) ((bf16_t*)(arg_ws(ka) + (off)))

__global__ void __launch_bounds__(NWAVES * 64, 2) mega_fwd(Args a_unused) {
    extern __shared__ __attribute__((aligned(16))) unsigned char lds_raw[];
    LAS unsigned char* lds = (LAS unsigned char*)lds_raw;
    const int G_ = gridDim.x, bx_ = blockIdx.x; const int wave_s_ = __builtin_amdgcn_readfirstlane((int)threadIdx.x >> 6);
#define G (fresh_s(G_))
#define bx (fresh_s(bx_))
#define TID (fresh_tid())
#define LANE (fresh_tid() & 63)
#define WAVE (__builtin_amdgcn_readfirstlane(fresh_tid() >> 6))
#define VCU ((G % 8 == 0) ? (bx % 8) * (G / 8) + bx / 8 : bx)
#define GW (VCU * NWAVES + WAVE)
#define NGW (G * NWAVES)
    for (int u = TID; u < (LDS_BYTES - RING_BYTES) / 4; u += NWAVES * 64) ((LAS unsigned*)(lds + RING_BYTES))[u] = 0u;
    __syncthreads();
    XcdBarrier bar;
    { kaptr_t ka = ka_fresh(); bar = xcd_barrier_post((unsigned*)(arg_ws(ka) + WS_CTL) + CW_BAR, (volatile LAS unsigned*)(lds + MISC_OFF) + 8); }
#define GRID_BAR() do { XcdBarrier b2_ = bar; __attribute__((address_space(1))) unsigned* gb_ = (__attribute__((address_space(1))) unsigned*)bar.bar; asm volatile("" : "+s"(gb_), "+s"(b2_.x)); b2_.bar = (unsigned*)gb_; xcd_barrier(b2_); } while (0)

    { kaptr_t ka = ka_fresh(); pg8::ssq_t* sq = (pg8::ssq_t*)(arg_ws(ka) + WS_SSQ);
      for (int i = VCU * (NWAVES * 64) + TID; i < 9 * T; i += G * NWAVES * 64) sq[i] = 0ull; }
    { kaptr_t ka = ka_fresh(); p0_weights(ka, lds, GW, NGW, WAVE, LANE); }
    { kaptr_t ka = ka_fresh(); p0_cache(arg_in(ka, 6), arg_in(ka, 7), WSP(WS_KS), WSP(WS_VS), GW, NGW, LANE); }
    __syncthreads();
    { kaptr_t ka = ka_fresh(); p0_mod(arg_in(ka, 2), arg_in(ka, 3), arg_in(ka, 8), arg_in(ka, 9), (float*)(arg_ws(ka) + WS_MOD), lds, VCU, G, TID); }
    GRID_BAR();

    { kaptr_t ka = ka_fresh(); const float* mod = (const float*)(arg_ws(ka) + WS_MOD);
      gm_tables(arg_in(ka, 10), arg_in(ka, 11), mod, (float*)(arg_ws(ka) + WS_GM), VCU * (NWAVES * 64) + TID, G * NWAVES * 64); }
    { kaptr_t ka = ka_fresh(); shw_phase((const float*)(arg_ws(ka) + WS_MOD), arg_ws(ka), VCU, G, WAVE, LANE); }
    { kaptr_t ka = ka_fresh();
      norm0_pass(arg_in(ka, 0), arg_in(ka, 1), (bf16_t*)(arg_out(ka) + O_Y) + D, WSP(WS_HN), arg_in(ka, 10), (const float*)(arg_ws(ka) + WS_MOD), (pg8::ssq_t*)(arg_ws(ka) + WS_SSQ), GW, NGW, LANE); }
    GRID_BAR();

#define SSQP(i) ((pg8::ssq_t*)(arg_ws(ka) + WS_SSQ) + (size_t)(i) * T)
#define GMP(i) ((const float*)(arg_ws(ka) + WS_GM) + (size_t)(i) * NBB * D)
#define MODL(l) ((const float*)(arg_ws(ka) + WS_MOD) + (size_t)(l) * NBB * MODW)
#define SHWP(off) ((const float*)(arg_ws(ka) + WS_SHW) + (off))
#pragma unroll 1
    for (int l = 0; l < 4; ++l) {
        if (l < 2) {
            { kaptr_t ka = ka_fresh(); float* out = arg_out(ka);
              pg8::Gemm g{WSP(WS_HN), WSP(WS_WGI) + (size_t)l * 2 * D * D, T, 2 * D, D}; pg8::ORD_GI S; S.init(T, 2 * D, G, bx);
              pg8::EpiGateInP E{WSP(WS_BA), WSP(WS_BB), out + O_CONVP + (size_t)l * PB * 3 * D, out + O_CONVS + (size_t)l * SB * 3 * D, SSQP(2 * l), SHWP(SHW_GI + (size_t)l * NBB * 2 * D)};
              pg8::gemm_phase<pg8::EpiGateInP, pg8::ORD_GI, true, true>(lds, g, S, E, TID); }
            GRID_BAR();
            { kaptr_t ka = ka_fresh(); float* out = arg_out(ka);
              rg::rglru_phase((char*)lds_raw, WSP(WS_BB), WSP(WS_BA), WSP(WS_HN), WSP(WS_WAI) + (size_t)l * 8 * 512 * 256, arg_in(ka, 14) + (size_t)l * 4 * D, arg_in(ka, 15) + (size_t)l * D, arg_in(ka, 17) + (size_t)l * D, arg_in(ka, 19) + (size_t)l * D,
                              arg_in(ka, 20) + (size_t)l * D, arg_in(ka, 4) + (size_t)l * SB * 3 * D, arg_in(ka, 5) + (size_t)l * SB * D, out + O_RNNP + (size_t)l * PB * D, out + O_RNNS + (size_t)l * SB * D, VCU, G, TID); }
            GRID_BAR();
            { kaptr_t ka = ka_fresh();
              pg8::Gemm g{WSP(WS_HN), WSP(WS_WRGO) + (size_t)l * D * D, T, D, D}; pg8::ORD_R S; S.init(T, D, G, bx);
              pg8::EpiResidP E{(bf16_t*)(arg_out(ka) + O_Y) + D, MODL(l) + 2 * D, WSP(WS_BA), GMP(2 * l + 1), SSQP(2 * l + 1)};
              pg8::gemm_phase<pg8::EpiResidP, pg8::ORD_R, true, true>(lds, g, S, E, TID); }
        } else {
            if (l == 2) { kaptr_t ka = ka_fresh();
              pg8::Gemm g{(bf16_t*)(arg_out(ka) + O_Y) + D, WSP(WS_WKV), T, 2 * D, D, XPITCH}; pg8::ORD_KV S; S.init(T, 2 * D, G, bx);
              pg8::EpiKVP E{WSP(WS_BB), WSP(WS_BC), WSP(WS_KS), WSP(WS_VS), arg_out(ka), SSQP(4)};
              pg8::gemm_phase<pg8::EpiKVP, pg8::ORD_KV, true, true>(lds, g, S, E, TID); }
            { kaptr_t ka = ka_fresh();
              pg8::Gemm g{WSP(WS_HN), WSP(WS_WQ) + (size_t)(l - 2) * D * D, T, D, D}; pg8::ORD_Q S; S.init(T, D, G, bx);
              pg8::EpiQP E{WSP(WS_HID), SSQP(2 * l), SHWP(SHW_Q + (size_t)(l - 2) * NBB * D)};
              pg8::gemm_phase<pg8::EpiQP, pg8::ORD_Q, true, true>(lds, g, S, E, TID); }
            GRID_BAR();
            { kaptr_t ka = ka_fresh();
              att::attn_phase((char*)lds_raw, WSP(WS_HID), WSP(WS_HN), WSP(WS_BB), WSP(WS_BC), WSP(WS_KS), WSP(WS_VS), arg_in(ka, 27) + (size_t)(l - 2) * (2 * RELC + 1) * NH, VCU, G, TID); }
            GRID_BAR();
            { kaptr_t ka = ka_fresh();
              pg8::Gemm g{WSP(WS_HN), WSP(WS_WO) + (size_t)(l - 2) * D * D, T, D, D}; pg8::ORD_R S; S.init(T, D, G, bx);
              pg8::EpiResidP E{(bf16_t*)(arg_out(ka) + O_Y) + D, MODL(l) + 2 * D, WSP(WS_BA), GMP(2 * l + 1), SSQP(2 * l + 1)};
              pg8::gemm_phase<pg8::EpiResidP, pg8::ORD_R, true, true>(lds, g, S, E, TID); }
        }
        GRID_BAR();
        { kaptr_t ka = ka_fresh();
          pg8::Gemm g{WSP(WS_BA), WSP(WS_W13) + (size_t)l * 2 * DFF * D, T, 2 * DFF, D}; pg8::ORD_F13 S; S.init(T, 2 * DFF, G, bx);
          pg8::EpiFfn13P E{WSP(WS_HID), SSQP(2 * l + 1), SHWP(SHW_13 + (size_t)l * NBB * 2 * DFF)};
          pg8::gemm_phase<pg8::EpiFfn13P, pg8::ORD_F13, true, true>(lds, g, S, E, TID);
          }
        GRID_BAR();
        { kaptr_t ka = ka_fresh();
          pg8::Gemm g{WSP(WS_HID), WSP(WS_W2) + (size_t)l * D * DFF, T, D, DFF}; pg8::ORD_F2 S; S.init(T, D, G, bx);
          pg8::EpiResidP E{(bf16_t*)(arg_out(ka) + O_Y) + D, MODL(l) + 5 * D, WSP(WS_HN), GMP(l < 3 ? 2 * l + 2 : 0), SSQP(2 * l + 2)};
          pg8::gemm_phase<pg8::EpiResidP, pg8::ORD_F2, true, true>(lds, g, S, E, TID); }
        GRID_BAR();
    }
    { kaptr_t ka = ka_fresh(); final_pass(arg_out(ka) + O_Y, arg_in(ka, 31), SSQP(8), GW, NGW, LANE); }
}

extern "C" void kernel_launch(void* const* d_in, const int* in_sizes, int n_in, void* d_out, int out_size, void* d_ws, size_t ws_size, hipStream_t stream) {
    (void)in_sizes; (void)out_size;
    static int grid = 0;
    if (grid == 0) {
        if (n_in != 32 || ws_size < WS_END) { fprintf(stderr, "kernel_launch: unexpected n_in %d / ws %zu\n", n_in, ws_size); grid = -1; return; }
        int dev = 0, cus = 0, per_cu = 0;
        if (hipGetDevice(&dev) != hipSuccess || hipDeviceGetAttribute(&cus, hipDeviceAttributeMultiprocessorCount, dev) != hipSuccess) { grid = -1; return; }
        if (hipFuncSetAttribute((const void*)mega_fwd, hipFuncAttributeMaxDynamicSharedMemorySize, LDS_BYTES) != hipSuccess) { fprintf(stderr, "kernel_launch: hipFuncSetAttribute failed\n"); grid = -1; return; }
        if (hipOccupancyMaxActiveBlocksPerMultiprocessor(&per_cu, (const void*)mega_fwd, NWAVES * 64, LDS_BYTES) != hipSuccess || per_cu < 1) fprintf(stderr, "kernel_launch: occupancy query says %d\n", per_cu);
        (void)hipGetLastError();
        grid = cus;
    }
    if (grid < 0) return;
    if (hipMemsetAsync((char*)d_ws + WS_CTL, 0, CTL_ZERO_BYTES, stream) != hipSuccess) return;
    Args a{};
    for (int i = 0; i < 32; ++i) a.in[i] = (const float*)d_in[i];
    a.out = (float*)d_out; a.ws = (unsigned char*)d_ws;
    hipLaunchKernelGGL(mega_fwd, dim3(grid), dim3(NWAVES * 64), LDS_BYTES, stream, a);
}
```
